# Optimizing an MI355X kernel written in HIP

```python
import math
import jax, jax.numpy as jnp
from jax import lax
import numpy as np

D_MODEL = 1024
BATCH = 32
SEQ = 2048
DEPTH = 4

HEAD_DIM = 64
Q_BLOCK = 128
A_HEADS = 8
A_KV = 1
A_WINDOW = 128
B_HEADS = 4
B_KV = 1
CMP_LEN = 32
CMP_STRIDE = 16
CMP_HIDDEN = 128
SLC_LEN = 64
SLC_TOP = 8
B_WINDOW = 512
C_HEADS = 4
A_Q = A_HEADS * HEAD_DIM
A_KVW = A_KV * HEAD_DIM
B_Q = B_HEADS * HEAD_DIM
B_KVW = B_KV * HEAD_DIM
C_W = C_HEADS * HEAD_DIM
MIX_WIDTH = A_Q + B_Q + C_W
D_FF = -(-8 * D_MODEL // (3 * 256)) * 256
SPLIT_SIZES = (A_Q, A_KVW, A_KVW, B_Q, B_KVW, B_KVW, B_KVW, B_KVW, B_KVW, B_KVW, B_HEADS * 3, C_W, C_W, C_W)
IN_WIDTH = sum(SPLIT_SIZES)
NEG_INF = -1e30
FORCE = 1e4
EPS = 1e-6

kernel_name = "hymba_style_swa_nsa_stickbreaking_hybrid"


def rmsnorm(x, g):
    xf = x.astype(jnp.float32)
    y = xf * lax.rsqrt(jnp.mean(xf * xf, axis=-1, keepdims=True) + EPS)
    return (y * g.astype(jnp.float32)).astype(x.dtype)


def alibi_slopes():
    n = A_HEADS + B_HEADS
    sl = 2.0 ** (-8.0 * np.arange(1, n + 1) / n)
    return jnp.asarray(sl[:A_HEADS], jnp.float32), jnp.asarray(sl[A_HEADS:], jnp.float32)


def unblock(o):
    o = jnp.moveaxis(o, 0, 1)
    return o.reshape((o.shape[0], o.shape[1] * o.shape[2]) + o.shape[3:])


def banded_attention(q, k, v, window, slopes, sinks=None):
    b, s, kv, g, hd = q.shape
    nblk = s // Q_BLOCK
    span = Q_BLOCK + window
    kp = jnp.pad(k, ((0, 0), (window, 0), (0, 0), (0, 0)))
    vp = jnp.pad(v, ((0, 0), (window, 0), (0, 0), (0, 0)))
    scale = HEAD_DIM ** -0.5

    def block(i):
        start = i * Q_BLOCK
        qb = lax.dynamic_slice_in_dim(q, start, Q_BLOCK, axis=1)
        kb = lax.dynamic_slice_in_dim(kp, start, span, axis=1)
        vb = lax.dynamic_slice_in_dim(vp, start, span, axis=1)
        t = start + jnp.arange(Q_BLOCK)
        sp = start - window + jnp.arange(span)
        dist = t[:, None] - sp[None, :]
        valid = (dist >= 0) & (dist < window) & (sp[None, :] >= 0)
        sc = jnp.einsum('bqkgd,bskd->bkgqs', qb, kb, preferred_element_type=jnp.float32) * scale
        sc = sc - slopes[:, :, None, None] * dist.astype(jnp.float32)
        sc = jnp.where(valid, sc, NEG_INF)
        if sinks is not None:
            sink_col = jnp.broadcast_to(sinks.astype(jnp.float32)[:, :, None, None], sc.shape[:-1] + (1,))
            p = jax.nn.softmax(jnp.concatenate([sc, sink_col], axis=-1), axis=-1)[..., :-1]
        else:
            p = jax.nn.softmax(sc, axis=-1)
        return jnp.einsum('bkgqs,bskd->bqkgd', p.astype(v.dtype), vb)

    return unblock(lax.map(block, jnp.arange(nblk)))


def compress(x_raw, pos_emb, w1, w2):
    b, s, kv, hd = x_raw.shape
    chunks = x_raw.reshape(b, s // CMP_STRIDE, CMP_STRIDE, kv, hd)
    blocks = jnp.concatenate([chunks[:, :-1], chunks[:, 1:]], axis=2)
    blocks = blocks + pos_emb[None, None, :, None, :]
    h = jax.nn.gelu(jnp.einsum('bnlkd,ldf->bnkf', blocks, w1))
    return jnp.einsum('bnkf,fd->bnkd', h, w2)


def overlap_matrix(n_cmp, n_slc):
    cs = np.arange(n_cmp)[:, None] * CMP_STRIDE
    ss = np.arange(n_slc)[None, :] * SLC_LEN
    ov = np.maximum(0, np.minimum(cs + CMP_LEN, ss + SLC_LEN) - np.maximum(cs, ss))
    return jnp.asarray(ov / CMP_STRIDE, jnp.float32)


def nsa_compressed_selected(q, k_cmp, v_cmp, k_slc, v_slc, slopes):
    b, s, kv, g, hd = q.shape
    nblk = s // Q_BLOCK
    n_cmp = k_cmp.shape[1]
    n_slc = s // SLC_LEN
    top = min(SLC_TOP, n_slc)
    scale = HEAD_DIM ** -0.5
    m_map = overlap_matrix(n_cmp, n_slc)
    cmp_end = jnp.arange(n_cmp) * CMP_STRIDE + CMP_LEN - 1
    kb_all = k_slc.reshape(b, n_slc, SLC_LEN, kv, hd).transpose(0, 3, 1, 2, 4)
    vb_all = v_slc.reshape(b, n_slc, SLC_LEN, kv, hd).transpose(0, 3, 1, 2, 4)
    bi = jnp.arange(b)[:, None, None, None]
    ki = jnp.arange(kv)[None, None, :, None]
    blk = jnp.arange(n_slc)
    sl = slopes[None, None, :, :, None]

    def block(i):
        start = i * Q_BLOCK
        qb = lax.dynamic_slice_in_dim(q, start, Q_BLOCK, axis=1)
        t = start + jnp.arange(Q_BLOCK)
        dist_c = t[:, None] - cmp_end[None, :]
        vis_c = dist_c >= 0
        any_vis = jnp.any(vis_c, axis=-1).astype(jnp.float32)
        sc = jnp.einsum('bqkgd,bnkd->bqkgn', qb, k_cmp, preferred_element_type=jnp.float32) * scale
        sc = sc - sl * dist_c.astype(jnp.float32)[None, :, None, None, :]
        sc = jnp.where(vis_c[None, :, None, None, :], sc, NEG_INF)
        p_c = jax.nn.softmax(sc, axis=-1) * any_vis[None, :, None, None, None]
        o_c = jnp.einsum('bqkgn,bnkd->bqkgd', p_c.astype(v_cmp.dtype), v_cmp)
        imp = jnp.einsum('bqkgn,nj->bqkj', p_c, m_map)
        cur = t // SLC_LEN
        valid_b = blk[None, :] * SLC_LEN <= t[:, None]
        forced = (blk[None, :] == 0) | (blk[None, :] == cur[:, None]) | (blk[None, :] == cur[:, None] - 1)
        imp = jnp.where(forced[None, :, None, :], FORCE, jnp.where(valid_b[None, :, None, :], imp, -FORCE))
        _, idx = lax.top_k(imp, top)
        ks = kb_all[bi, ki, idx].reshape(b, Q_BLOCK, kv, top * SLC_LEN, hd)
        vs = vb_all[bi, ki, idx].reshape(b, Q_BLOCK, kv, top * SLC_LEN, hd)
        pos = (idx[..., None] * SLC_LEN + jnp.arange(SLC_LEN)).reshape(b, Q_BLOCK, kv, top * SLC_LEN)
        dist_s = t[None, :, None, None] - pos
        sc_s = jnp.einsum('bqkgd,bqksd->bqkgs', qb, ks, preferred_element_type=jnp.float32) * scale
        sc_s = sc_s - sl * dist_s.astype(jnp.float32)[:, :, :, None, :]
        sc_s = jnp.where((dist_s >= 0)[:, :, :, None, :], sc_s, NEG_INF)
        p_s = jax.nn.softmax(sc_s, axis=-1)
        o_s = jnp.einsum('bqkgs,bqksd->bqkgd', p_s.astype(vs.dtype), vs)
        return o_c, o_s

    o_c, o_s = lax.map(block, jnp.arange(nblk))
    return unblock(o_c), unblock(o_s)


def stick_breaking_attention(q, k, v):
    b, s, h, hd = q.shape
    nblk = s // Q_BLOCK
    scale = HEAD_DIM ** -0.5
    kpos = jnp.arange(s)

    def block(i):
        start = i * Q_BLOCK
        qb = lax.dynamic_slice_in_dim(q, start, Q_BLOCK, axis=1)
        t = start + jnp.arange(Q_BLOCK)
        z = jnp.einsum('bqhd,bshd->bhqs', qb, k, preferred_element_type=jnp.float32) * scale
        past = kpos[None, :] < t[:, None]
        log_keep = jnp.where(past, jax.nn.log_sigmoid(-z), 0.0)
        shifted = jnp.concatenate([log_keep[..., 1:], jnp.zeros_like(log_keep[..., :1])], axis=-1)
        tail = lax.cumsum(shifted, axis=3, reverse=True)
        w = jnp.where(past, jnp.exp(jax.nn.log_sigmoid(z) + tail), 0.0)
        return jnp.einsum('bhqs,bshd->bqhd', w.astype(v.dtype), v)

    return unblock(lax.map(block, jnp.arange(nblk)))


def hybrid_layer(x, w_in, w_out, g_attn, g_ffn, g_out_a, g_out_b, g_out_c, sinks,
                 cmp_pos, cmp_w1, cmp_w2, w_gate, w_up, w_down):
    b, s, _ = x.shape
    hd = HEAD_DIM
    slopes_a, slopes_b = alibi_slopes()
    h = rmsnorm(x, g_attn)
    proj = h @ w_in
    splits = np.cumsum(SPLIT_SIZES)[:-1].tolist()
    (qa, ka, va, qb, kcb, vcb, ksb, vsb, kwb, vwb, gb, qc, kc, vc) = jnp.split(proj, splits, axis=-1)

    ga = A_HEADS // A_KV
    oa = banded_attention(qa.reshape(b, s, A_KV, ga, hd), ka.reshape(b, s, A_KV, hd), va.reshape(b, s, A_KV, hd),
                          A_WINDOW, slopes_a.reshape(A_KV, ga), sinks.reshape(A_KV, ga)).reshape(b, s, A_Q)

    gB = B_HEADS // B_KV
    qb4 = qb.reshape(b, s, B_KV, gB, hd)
    sl_b = slopes_b.reshape(B_KV, gB)
    k_cmp = compress(kcb.reshape(b, s, B_KV, hd), cmp_pos[0], cmp_w1[0], cmp_w2[0])
    v_cmp = compress(vcb.reshape(b, s, B_KV, hd), cmp_pos[1], cmp_w1[1], cmp_w2[1])
    o_cmp, o_slc = nsa_compressed_selected(qb4, k_cmp, v_cmp, ksb.reshape(b, s, B_KV, hd),
                                           vsb.reshape(b, s, B_KV, hd), sl_b)
    o_win = banded_attention(qb4, kwb.reshape(b, s, B_KV, hd), vwb.reshape(b, s, B_KV, hd), B_WINDOW, sl_b)
    gates = jax.nn.sigmoid(gb.reshape(b, s, B_KV, gB, 3))[..., None]
    ob = (gates[..., 0, :] * o_cmp + gates[..., 1, :] * o_slc + gates[..., 2, :] * o_win).reshape(b, s, B_Q)

    oc = stick_breaking_attention(qc.reshape(b, s, C_HEADS, hd), kc.reshape(b, s, C_HEADS, hd),
                                  vc.reshape(b, s, C_HEADS, hd)).reshape(b, s, C_W)

    mix = jnp.concatenate([rmsnorm(oa, g_out_a), rmsnorm(ob, g_out_b), rmsnorm(oc, g_out_c)], axis=-1)
    x = x + mix @ w_out
    h = rmsnorm(x, g_ffn)
    x = x + (jax.nn.silu(h @ w_gate) * (h @ w_up)) @ w_down
    return x


def setup_inputs(seed: int = 0) -> dict:
    key = jax.random.key(seed)
    ks = jax.random.split(key, 17)
    f32 = jnp.float32
    nrm = lambda k, shape, scale: jax.random.normal(k, shape, f32) * scale
    return {
        "x": jax.random.normal(ks[0], (BATCH, SEQ, D_MODEL), f32),
        "w_in": nrm(ks[1], (DEPTH, D_MODEL, IN_WIDTH), D_MODEL ** -0.5),
        "w_out": nrm(ks[2], (DEPTH, MIX_WIDTH, D_MODEL), MIX_WIDTH ** -0.5),
        "g_attn": 1.0 + nrm(ks[3], (DEPTH, D_MODEL), 0.02),
        "g_ffn": 1.0 + nrm(ks[4], (DEPTH, D_MODEL), 0.02),
        "g_out_a": 1.0 + nrm(ks[5], (DEPTH, A_Q), 0.02),
        "g_out_b": 1.0 + nrm(ks[6], (DEPTH, B_Q), 0.02),
        "g_out_c": 1.0 + nrm(ks[7], (DEPTH, C_W), 0.02),
        "sinks": nrm(ks[8], (DEPTH, A_HEADS), 0.5),
        "cmp_pos": nrm(ks[9], (DEPTH, 2, CMP_LEN, HEAD_DIM), 0.1),
        "cmp_w1": nrm(ks[10], (DEPTH, 2, CMP_LEN, HEAD_DIM, CMP_HIDDEN), (CMP_LEN * HEAD_DIM) ** -0.5),
        "cmp_w2": nrm(ks[11], (DEPTH, 2, CMP_HIDDEN, HEAD_DIM), CMP_HIDDEN ** -0.5),
        "w_gate": nrm(ks[12], (DEPTH, D_MODEL, D_FF), D_MODEL ** -0.5),
        "w_up": nrm(ks[13], (DEPTH, D_MODEL, D_FF), D_MODEL ** -0.5),
        "w_down": nrm(ks[14], (DEPTH, D_FF, D_MODEL), D_FF ** -0.5),
        "g_final": 1.0 + nrm(ks[15], (D_MODEL,), 0.02),
    }


def reference(x, w_in, w_out, g_attn, g_ffn, g_out_a, g_out_b, g_out_c, sinks,
              cmp_pos, cmp_w1, cmp_w2, w_gate, w_up, w_down, g_final):
    for l in range(DEPTH):
        x = hybrid_layer(x, w_in[l], w_out[l], g_attn[l], g_ffn[l], g_out_a[l], g_out_b[l], g_out_c[l],
                         sinks[l], cmp_pos[l], cmp_w1[l], cmp_w2[l], w_gate[l], w_up[l], w_down[l])
    return rmsnorm(x, g_final)
```

```cpp
#include <hip/hip_runtime.h>
#include <hip/hip_cooperative_groups.h>
#include <cstdio>
#include <cstdint>
namespace cg = cooperative_groups;
namespace pg8 {
#define PG8_LAS __attribute__((address_space(3)))
typedef unsigned short bf16_t;
typedef short bf16x8 __attribute__((ext_vector_type(8)));
typedef float f32x4 __attribute__((ext_vector_type(4)));
typedef unsigned u32x4 __attribute__((ext_vector_type(4)));
constexpr int BM = 256, BK = 64, HALF = 128, HTB = HALF * BK * 2  , STAGE_BYTES = 8 * HTB, NXCD = 8, WGM = 8;

__host__ __device__ __forceinline__ int lds_byte(int r, int c) { const int st = (r >> 4) * 2 + (c >> 5), rr = r & 15, cc = c & 31, ob = rr * 64 + cc * 2; return st * 1024 + (ob ^ (((ob >> 9) & 1) << 5)); }
__host__ __device__ __forceinline__ void stage_rc(int b, int& R, int& C) { const int st = b / 1024, sb = b % 1024, swz = sb ^ (((sb >> 9) & 1) << 5); R = (st >> 1) * 16 + swz / 64; C = (st & 1) * 32 + (swz % 64) / 2; }
__host__ __device__ __forceinline__ int perm32(int rho) { const int n = rho >> 4, i = rho & 15; return 8 * (i >> 2) + 4 * n + (i & 3); }

struct Unit { int pm, pn; };
struct Gemm { const bf16_t* A; const bf16_t* Bt; int M, N, K; };

struct StaticOrder {
    int nM, nN, nwg, G, c;
    __host__ __device__ void init(int M, int N, int G_, int c_) { nM = M / BM; nN = N / BM; nwg = nM * nN; G = G_; c = c_; }
    __host__ __device__ bool next(int i, Unit& u) const {
        const long L = (long)i * G + c; if (L >= nwg) return false;
        int wgid = (int)L; { const int q = nwg / NXCD, r = nwg % NXCD, xcd = wgid % NXCD, off = wgid / NXCD; wgid = (xcd < r ? xcd * (q + 1) : r * (q + 1) + (xcd - r) * q) + off; }
        const int nig = WGM * nN, gid = wgid / nig, fm = gid * WGM, gsz = (nM - fm) < WGM ? (nM - fm) : WGM;
        u.pm = fm + ((wgid % nig) % gsz); u.pn = (wgid % nig) / gsz; return true;
    }
    __device__ __forceinline__ void a_ready(const Unit&) const {}
    __device__ __forceinline__ void done(const Unit&) const {}
};

__device__ __forceinline__ unsigned cvt_pk_bf16(float lo, float hi) { unsigned r; asm volatile("v_cvt_pk_bf16_f32 %0, %1, %2" : "=v"(r) : "v"(lo), "v"(hi)); return r; }
typedef float f32x2 __attribute__((ext_vector_type(2)));
typedef unsigned u32x2 __attribute__((ext_vector_type(2)));
__device__ __forceinline__ float row_rstd(const float* ss, int row, int fq) {
    const f32x4 v = *(const f32x4*)(ss + (size_t)row * 16 + 4 * fq);
    float s = (v[0] + v[1]) + (v[2] + v[3]);
    s += __shfl_xor(s, 16); s += __shfl_xor(s, 32);
    return __builtin_amdgcn_rsqf(s * (1.0f / 1024.0f) + 1e-6f);
}
struct EpiProj {
    static constexpr bool PERM = true, AFTER_DRAIN = false;
    bf16_t* O; int ldc; const float* ss;
    __device__ __forceinline__ void operator()(const f32x4 (&acc)[2][2][4][2], const Unit& u, int wr, int wc, int fr, int fq) const {
        const int row0 = u.pm * BM + wr * 64 + fr, col0 = u.pn * BM + wc * 32 + 8 * fq;
#pragma unroll
        for (int ai = 0; ai < 2; ++ai)
#pragma unroll
            for (int m = 0; m < 4; ++m) { const int row = row0 + ai * HALF + m * 16; const float rs = row_rstd(ss, row, fq); bf16_t* rowp = O + (size_t)row * ldc + col0;
#pragma unroll
                for (int bj = 0; bj < 2; ++bj) { const f32x4 v0 = acc[ai][bj][m][0] * rs, v1 = acc[ai][bj][m][1] * rs;
                    u32x4 w; w.x = cvt_pk_bf16(v0[0], v0[1]); w.y = cvt_pk_bf16(v0[2], v0[3]); w.z = cvt_pk_bf16(v1[0], v1[1]); w.w = cvt_pk_bf16(v1[2], v1[3]);
                    *(u32x4*)(rowp + bj * HALF) = w; }
                if (m & 1) asm volatile("" ::: "memory"); }
    }
};
__device__ __forceinline__ float silu_mul(float g, float u) { return g * __builtin_amdgcn_rcpf(1.0f + __expf(-g)) * u; }
struct EpiGU {
    static constexpr bool PERM = true, AFTER_DRAIN = false;
    bf16_t* O; int ldc; const float* ss;
    __device__ __forceinline__ void operator()(const f32x4 (&acc)[2][2][4][2], const Unit& u, int wr, int wc, int fr, int fq) const {
        const int row0 = u.pm * BM + wr * 64 + fr, col0 = u.pn * HALF + wc * 32 + 8 * fq;
#pragma unroll
        for (int ai = 0; ai < 2; ++ai)
#pragma unroll
            for (int m = 0; m < 4; ++m) { const int row = row0 + ai * HALF + m * 16; const float rs = row_rstd(ss, row, fq);
                const f32x4 g0 = acc[ai][0][m][0] * rs, g1 = acc[ai][0][m][1] * rs, u0 = acc[ai][1][m][0] * rs, u1 = acc[ai][1][m][1] * rs;
                u32x4 w; w.x = cvt_pk_bf16(silu_mul(g0[0], u0[0]), silu_mul(g0[1], u0[1])); w.y = cvt_pk_bf16(silu_mul(g0[2], u0[2]), silu_mul(g0[3], u0[3]));
                w.z = cvt_pk_bf16(silu_mul(g1[0], u1[0]), silu_mul(g1[1], u1[1])); w.w = cvt_pk_bf16(silu_mul(g1[2], u1[2]), silu_mul(g1[3], u1[3]));
                *(u32x4*)(O + (size_t)row * ldc + col0) = w;
                if (m & 1) asm volatile("" ::: "memory"); }
    }
};
struct EpiRes {
    static constexpr bool PERM = false, AFTER_DRAIN = false;
    const float* xin; float* xout; bf16_t* xb; float* ss;
    __device__ __forceinline__ void operator()(const f32x4 (&acc)[2][2][4][2], const Unit& u, int wr, int wc, int fr, int fq) const {
        const int row0 = u.pm * BM + wr * 64 + fr, col0 = u.pn * BM + wc * 32 + 4 * fq;
#pragma unroll
        for (int ai = 0; ai < 2; ++ai)
#pragma unroll
            for (int m = 0; m < 4; ++m) { const int row = row0 + ai * HALF + m * 16; const size_t off = (size_t)row * 1024 + col0; float s = 0.f;
#pragma unroll
                for (int bj = 0; bj < 2; ++bj)
#pragma unroll
                    for (int n = 0; n < 2; ++n) { const int c = bj * HALF + n * 16; const f32x4 xo = *(const f32x4*)(xin + off + c) + acc[ai][bj][m][n];
                        *(f32x4*)(xout + off + c) = xo; u32x2 w; w.x = cvt_pk_bf16(xo[0], xo[1]); w.y = cvt_pk_bf16(xo[2], xo[3]); *(u32x2*)(xb + off + c) = w;
                        s += (xo[0] * xo[0] + xo[1] * xo[1]) + (xo[2] * xo[2] + xo[3] * xo[3]); }
                s += __shfl_xor(s, 16); s += __shfl_xor(s, 32);
                if (fq == 0) ss[(size_t)row * 16 + u.pn * 4 + wc] = s;
                asm volatile("" ::: "memory"); }
    }
};
template <class Epi, class Sched, bool ALIGN_EPI = false, bool SP2 = false>
__device__ __forceinline__ void gemm_phase(PG8_LAS unsigned char* lds, const Gemm g, const Sched& S, const Epi& E) {
    int tid_ = threadIdx.x; asm volatile("" : "+v"(tid_)); const int tid = tid_, wid = __builtin_amdgcn_readfirstlane(tid >> 6), lane = tid & 63, wr = wid >> 2, wc = wid & 3, fr = lane & 15, fq = lane >> 4;
    const int K = g.K, nt = K / BK;
    unsigned voffA[2], voffB[2];
#pragma unroll
    for (int i = 0; i < 2; ++i) { int R, C; stage_rc(tid * 16 + i * 8192, R, C); const int Rb = Epi::PERM ? ((R & ~31) + perm32(R & 31)) : R;
        voffA[i] = (unsigned)(R * K + C) * 2u; voffB[i] = (unsigned)(Rb * K + C) * 2u; }
    const size_t kstep = (size_t)(BK * 2);
    const size_t hstep = (size_t)HALF * K * 2;
    const size_t tstep = 2 * hstep;
    const unsigned ldsw = (unsigned)wid * 1024u;
    const int aoff = lds_byte(wr * 64 + fr, fq * 8), boff = lds_byte(wc * 32 + fr, fq * 8);
#define PG8_SA(b, h) (((b) * 2 + (h)) * HTB)
#define PG8_SB(b, h) ((4 + (b) * 2 + (h)) * HTB)
#define PG8_STAGE(bufoff, gbase, voff) do { _Pragma("unroll") for (int _i = 0; _i < 2; ++_i) \
        __builtin_amdgcn_global_load_lds((const unsigned*)((const char*)(gbase) + (voff)[_i]), (PG8_LAS unsigned*)(lds + (bufoff) + ldsw + _i * 8192), 16, 0, 0); } while (0)
#define PG8_LDA(dst, b, h) do { _Pragma("unroll") for (int m = 0; m < 4; ++m) _Pragma("unroll") for (int k = 0; k < 2; ++k) dst[m][k] = *(const PG8_LAS bf16x8*)(lds + PG8_SA(b, h) + aoff + m * 2048 + k * 1024); } while (0)
#define PG8_LDB(dst, b, h) do { _Pragma("unroll") for (int n = 0; n < 2; ++n) _Pragma("unroll") for (int k = 0; k < 2; ++k) dst[n][k] = *(const PG8_LAS bf16x8*)(lds + PG8_SB(b, h) + boff + n * 2048 + k * 1024); } while (0)
#define PG8_MMA(ai, bj, At, Bt) do { __builtin_amdgcn_s_setprio(1); _Pragma("unroll") for (int m = 0; m < 4; ++m) _Pragma("unroll") for (int n = 0; n < 2; ++n) _Pragma("unroll") for (int k = 0; k < 2; ++k) \
        acc[ai][bj][m][n] = __builtin_amdgcn_mfma_f32_16x16x32_bf16(Bt[n][k], At[m][k], acc[ai][bj][m][n], 0, 0, 0); __builtin_amdgcn_s_setprio(0); } while (0)
#define PG8_WAIT_V(n) asm volatile("s_waitcnt vmcnt(" #n ")" ::: "memory")
#define PG8_WAIT_L(n) asm volatile("s_waitcnt lgkmcnt(" #n ")" ::: "memory")
#define PG8_BAR __builtin_amdgcn_s_barrier()
#define PG8_SCHED __builtin_amdgcn_sched_barrier(0)
    Unit cur, nxt; int ui = 0;
    if (!S.next(0, cur)) return;
    f32x4 acc[2][2][4][2];
#pragma unroll
    for (int a = 0; a < 2; ++a)
#pragma unroll
        for (int b = 0; b < 2; ++b)
#pragma unroll
            for (int m = 0; m < 4; ++m)
#pragma unroll
                for (int n = 0; n < 2; ++n) acc[a][b][m][n] = (f32x4){0.f, 0.f, 0.f, 0.f};
    bf16x8 At[4][2], B0[2][2], B1[2][2];
    const char* cA = (const char*)g.A + (size_t)cur.pm * tstep; const char* cB = (const char*)g.Bt + (size_t)cur.pn * tstep;
    S.a_ready(cur);
    if constexpr (SP2) {
        PG8_STAGE(PG8_SB(0, 0), cB, voffB); PG8_STAGE(PG8_SB(0, 1), cB + hstep, voffB); PG8_STAGE(PG8_SA(0, 0), cA, voffA); PG8_STAGE(PG8_SA(0, 1), cA + hstep, voffA);
        if (wr == 1) PG8_BAR;
        PG8_WAIT_V(2); PG8_BAR;
        PG8_STAGE(PG8_SB(1, 0), cB + kstep, voffB); PG8_STAGE(PG8_SA(1, 0), cA + kstep, voffA); PG8_STAGE(PG8_SB(1, 1), cB + hstep + kstep, voffB);
        PG8_WAIT_V(6); PG8_BAR;
    } else {
        PG8_STAGE(PG8_SB(0, 0), cB, voffB); PG8_STAGE(PG8_SA(0, 0), cA, voffA); PG8_STAGE(PG8_SB(0, 1), cB + hstep, voffB); PG8_STAGE(PG8_SA(0, 1), cA + hstep, voffA);
        if (wr == 1) PG8_BAR;
        PG8_WAIT_V(4); PG8_BAR;
        PG8_STAGE(PG8_SB(1, 0), cB + kstep, voffB); PG8_STAGE(PG8_SA(1, 0), cA + kstep, voffA); PG8_STAGE(PG8_SB(1, 1), cB + hstep + kstep, voffB);
        PG8_WAIT_V(6); PG8_BAR;
    }
    for (;;) {
        const bool has_next = S.next(ui + 1, nxt);
        const char* nA = has_next ? (const char*)g.A + (size_t)nxt.pm * tstep : cA; const char* nB = has_next ? (const char*)g.Bt + (size_t)nxt.pn * tstep : cB;
        for (int t = 0; t < nt; t += 2) {
            const bool last = (t == nt - 2);
            const char* a1 = cA + (size_t)(t + 1) * kstep;
            const char* a2 = last ? nA : cA + (size_t)(t + 2) * kstep; const char* b2 = last ? nB : cB + (size_t)(t + 2) * kstep;
            const char* a3 = a2 + kstep; const char* b3 = b2 + kstep;
            if (last && has_next) S.a_ready(nxt);
            if constexpr (SP2) {
            PG8_LDB(B0, 0, 0); PG8_LDB(B1, 0, 1); PG8_SCHED; PG8_LDA(At, 0, 0); PG8_STAGE(PG8_SA(1, 1), a1 + hstep, voffA);
            PG8_WAIT_V(8); PG8_WAIT_L(0); PG8_BAR; PG8_MMA(0, 0, At, B0); PG8_MMA(0, 1, At, B1); PG8_BAR; PG8_SCHED;
            PG8_LDA(At, 0, 1); PG8_STAGE(PG8_SB(0, 0), b2, voffB); PG8_STAGE(PG8_SB(0, 1), b2 + hstep, voffB); PG8_STAGE(PG8_SA(0, 0), a2, voffA);
            PG8_WAIT_V(8); PG8_WAIT_L(0); PG8_BAR; PG8_MMA(1, 0, At, B0); PG8_MMA(1, 1, At, B1); PG8_BAR; PG8_SCHED;
            PG8_LDB(B0, 1, 0); PG8_LDB(B1, 1, 1); PG8_SCHED; PG8_LDA(At, 1, 0); PG8_STAGE(PG8_SA(0, 1), a2 + hstep, voffA);
            PG8_WAIT_V(8); PG8_WAIT_L(0); PG8_BAR; PG8_MMA(0, 0, At, B0); PG8_MMA(0, 1, At, B1); PG8_BAR; PG8_SCHED;
            PG8_LDA(At, 1, 1); PG8_STAGE(PG8_SB(1, 0), b3, voffB); PG8_STAGE(PG8_SB(1, 1), b3 + hstep, voffB); PG8_STAGE(PG8_SA(1, 0), a3, voffA);
            PG8_WAIT_V(8); PG8_WAIT_L(0); PG8_BAR; PG8_MMA(1, 0, At, B0); PG8_MMA(1, 1, At, B1); PG8_BAR; PG8_SCHED;
            } else {
            PG8_LDB(B0, 0, 0); PG8_SCHED; PG8_LDA(At, 0, 0); PG8_STAGE(PG8_SA(1, 1), a1 + hstep, voffA);
            PG8_WAIT_L(8); PG8_BAR; PG8_WAIT_L(0); PG8_MMA(0, 0, At, B0); PG8_BAR; PG8_SCHED;
            PG8_LDB(B1, 0, 1); PG8_STAGE(PG8_SB(0, 0), b2, voffB);
            PG8_BAR; PG8_WAIT_L(0); PG8_MMA(0, 1, At, B1); PG8_BAR;
            PG8_LDA(At, 0, 1); PG8_STAGE(PG8_SA(0, 0), a2, voffA);
            PG8_BAR; PG8_WAIT_L(0); PG8_MMA(1, 0, At, B0); PG8_BAR; PG8_SCHED;
            PG8_STAGE(PG8_SB(0, 1), b2 + hstep, voffB);
            PG8_WAIT_V(6); PG8_BAR; PG8_MMA(1, 1, At, B1); PG8_BAR;
            PG8_LDB(B0, 1, 0); PG8_SCHED; PG8_LDA(At, 1, 0); PG8_STAGE(PG8_SA(0, 1), a2 + hstep, voffA);
            PG8_WAIT_L(8); PG8_BAR; PG8_WAIT_L(0); PG8_MMA(0, 0, At, B0); PG8_BAR; PG8_SCHED;
            PG8_LDB(B1, 1, 1); PG8_STAGE(PG8_SB(1, 0), b3, voffB);
            PG8_BAR; PG8_WAIT_L(0); PG8_MMA(0, 1, At, B1); PG8_BAR;
            PG8_LDA(At, 1, 1); PG8_STAGE(PG8_SA(1, 0), a3, voffA);
            PG8_BAR; PG8_WAIT_L(0); PG8_MMA(1, 0, At, B0); PG8_BAR; PG8_SCHED;
            PG8_STAGE(PG8_SB(1, 1), b3 + hstep, voffB);
            PG8_WAIT_V(6); PG8_BAR; PG8_MMA(1, 1, At, B1); PG8_BAR;
            }
        }
        if constexpr (ALIGN_EPI) { if (wr == 0) PG8_BAR; }
        if constexpr (!Epi::AFTER_DRAIN) { E(acc, cur, wr, wc, fr, fq); S.done(cur); }
        if (!has_next) break;
#pragma unroll
        for (int a = 0; a < 2; ++a)
#pragma unroll
            for (int b = 0; b < 2; ++b)
#pragma unroll
                for (int m = 0; m < 4; ++m)
#pragma unroll
                    for (int n = 0; n < 2; ++n) acc[a][b][m][n] = (f32x4){0.f, 0.f, 0.f, 0.f};
        cur = nxt; cA = nA; cB = nB; ++ui;
        if constexpr (ALIGN_EPI) { if (wr == 1) PG8_BAR; }
    }
    PG8_WAIT_V(0);
    if constexpr (!ALIGN_EPI) { if (wr == 0) PG8_BAR; }
    PG8_BAR;
    if constexpr (Epi::AFTER_DRAIN) { E.fused(acc, cur, wr, wc, fr, fq, lds, wid, lane); S.done(cur); }
#undef PG8_SA
#undef PG8_SB
#undef PG8_STAGE
#undef PG8_LDA
#undef PG8_LDB
#undef PG8_MMA
#undef PG8_WAIT_V
#undef PG8_WAIT_L
#undef PG8_BAR
#undef PG8_SCHED
}
}
namespace mx {
#define LAS __attribute__((address_space(3)))
typedef unsigned short bf16_t;
typedef short bf16x8 __attribute__((ext_vector_type(8)));
typedef short s16x4 __attribute__((ext_vector_type(4)));
typedef float f32x16 __attribute__((ext_vector_type(16)));
typedef float f32x2v __attribute__((ext_vector_type(2)));
typedef __bf16 bf16x2v __attribute__((ext_vector_type(2)));
typedef unsigned u32x4 __attribute__((ext_vector_type(4)));
typedef unsigned u32x2 __attribute__((ext_vector_type(2)));
typedef LAS unsigned char* ldsp;
constexpr int TP = 144, TILE_B = 64 * TP;
constexpr int LDP = 2304, SEQ = 2048, DM = 1024;
constexpr float LOG2E = 1.4426950408889634f, KSC2 = 0.125f * 1.4426950408889634f, NEG = -1e30f;
constexpr int C_QA = 0, C_KA = 512, C_VA = 576, C_QB = 640, C_KCB = 896, C_VCB = 960, C_KSB = 1024, C_VSB = 1088, C_KWB = 1152, C_VWB = 1216, C_QC = 1280, C_KC = 1536, C_VC = 1792, C_GB = 2048;

__device__ __forceinline__ unsigned pk2(float lo, float hi) { f32x2v v = {lo, hi}; bf16x2v b = __builtin_convertvector(v, bf16x2v); return __builtin_bit_cast(unsigned, b); }
__device__ __forceinline__ float ex2(float x) { return __builtin_amdgcn_exp2f(x); }
__device__ __forceinline__ float bf2f(bf16_t v) { return __uint_as_float((unsigned)v << 16); }
__device__ __forceinline__ f32x16 zero16() { f32x16 z;
#pragma unroll
    for (int i = 0; i < 16; ++i) z[i] = 0.f; return z; }

__device__ __forceinline__ u32x4 tile_ld(const bf16_t* row0, size_t pitch, int tid) { return *(const u32x4*)(row0 + (size_t)(tid >> 3) * pitch + (tid & 7) * 8); }
__device__ __forceinline__ void tile_st(ldsp tile, int tid, u32x4 v) { *(LAS u32x4*)(tile + (tid >> 3) * TP + (tid & 7) * 16) = v; }

__device__ __forceinline__ void qk_tile(ldsp Kt, const bf16x8 (&qf)[4], int lane, f32x16& p0, f32x16& p1) {
    const int rho = lane & 31, h = lane >> 5;
    const int krow = 16 * ((rho >> 2) & 1) + (rho & 3) + 4 * (rho >> 3);
    ldsp kb = Kt + krow * TP + h * 16;
    p0 = zero16(); p1 = zero16();
#pragma unroll
    for (int s = 0; s < 4; ++s) {
        const bf16x8 a0 = *(const LAS bf16x8*)(kb + s * 32);
        const bf16x8 a1 = *(const LAS bf16x8*)(kb + 32 * TP + s * 32);
        p0 = __builtin_amdgcn_mfma_f32_32x32x16_bf16(a0, qf[s], p0, 0, 0, 0);
        p1 = __builtin_amdgcn_mfma_f32_32x32x16_bf16(a1, qf[s], p1, 0, 0, 0);
    }
}
__device__ __forceinline__ s16x4 vtr(ldsp p) { return __builtin_bit_cast(s16x4, __builtin_amdgcn_ds_read_tr16_b64_v4i16((LAS s16x4*)p)); }
__device__ __forceinline__ void pv_tile(ldsp Vt, const f32x16& w0, const f32x16& w1, int lane, f32x16& o0, f32x16& o1) {
    const int i = lane & 15, g16 = lane >> 4, D0 = 16 * (g16 & 1), h = g16 >> 1;
    ldsp vb = Vt + (16 * h + (i >> 2)) * TP + (D0 + 4 * (i & 3)) * 2;
#pragma unroll
    for (int sp = 0; sp < 4; ++sp) {
        u32x4 pw;
        if (sp < 2) { const int rb = (sp & 1) * 8; pw.x = pk2(w0[rb], w0[rb + 1]); pw.y = pk2(w0[rb + 2], w0[rb + 3]); pw.z = pk2(w0[rb + 4], w0[rb + 5]); pw.w = pk2(w0[rb + 6], w0[rb + 7]); }
        else        { const int rb = (sp & 1) * 8; pw.x = pk2(w1[rb], w1[rb + 1]); pw.y = pk2(w1[rb + 2], w1[rb + 3]); pw.z = pk2(w1[rb + 4], w1[rb + 5]); pw.w = pk2(w1[rb + 6], w1[rb + 7]); }
        const bf16x8 pb = __builtin_bit_cast(bf16x8, pw);
        const int key0 = 32 * (sp >> 1) + 8 * (sp & 1);
        {   const s16x4 lo = vtr(vb + key0 * TP), hi = vtr(vb + (key0 + 4) * TP);
            const bf16x8 a = {lo[0], lo[1], lo[2], lo[3], hi[0], hi[1], hi[2], hi[3]};
            o0 = __builtin_amdgcn_mfma_f32_32x32x16_bf16(a, pb, o0, 0, 0, 0); }
        {   const s16x4 lo = vtr(vb + key0 * TP + 64), hi = vtr(vb + (key0 + 4) * TP + 64);
            const bf16x8 a = {lo[0], lo[1], lo[2], lo[3], hi[0], hi[1], hi[2], hi[3]};
            o1 = __builtin_amdgcn_mfma_f32_32x32x16_bf16(a, pb, o1, 0, 0, 0); }
    }
}
__device__ __forceinline__ void softmax_step(f32x16& p0, f32x16& p1, float& m, float& l, f32x16& o0, f32x16& o1) {
    float mx = fmaxf(p0[0], p1[0]);
#pragma unroll
    for (int r = 1; r < 16; ++r) mx = fmaxf(mx, fmaxf(p0[r], p1[r]));
    mx = fmaxf(mx, __shfl_xor(mx, 32));
    const float mn = fmaxf(m, mx), alpha = ex2(m - mn);
    float ls = 0.f;
#pragma unroll
    for (int r = 0; r < 16; ++r) { p0[r] = p0[r] > -1e29f ? ex2(p0[r] - mn) : 0.f; p1[r] = p1[r] > -1e29f ? ex2(p1[r] - mn) : 0.f; ls += p0[r] + p1[r]; }
    ls += __shfl_xor(ls, 32);
    l = l * alpha + ls; m = mn; o0 *= alpha; o1 *= alpha;
}
__device__ __forceinline__ void prep_band(f32x16& p0, f32x16& p1, int tq, int tk0, int h, float slope2, int window, bool sel) {
#pragma unroll
    for (int r = 0; r < 16; ++r) {
        const int d0 = tq - (tk0 + 16 * h + r), d1 = d0 - 32;
        p0[r] = (sel && d0 >= 0 && d0 < window) ? p0[r] * KSC2 - slope2 * (float)d0 : NEG;
        p1[r] = (sel && d1 >= 0 && d1 < window) ? p1[r] * KSC2 - slope2 * (float)d1 : NEG;
    }
}
__device__ __forceinline__ void store_o(bf16_t* dst, const f32x16& o0, const f32x16& o1, float sc, int h) {
#pragma unroll
    for (int g = 0; g < 4; ++g) {
        u32x2 a; a.x = pk2(o0[4 * g] * sc, o0[4 * g + 1] * sc); a.y = pk2(o0[4 * g + 2] * sc, o0[4 * g + 3] * sc);
        u32x2 b; b.x = pk2(o1[4 * g] * sc, o1[4 * g + 1] * sc); b.y = pk2(o1[4 * g + 2] * sc, o1[4 * g + 3] * sc);
        *(u32x2*)(dst + 8 * g + 4 * h) = a; *(u32x2*)(dst + 32 + 8 * g + 4 * h) = b;
    }
}
__device__ __forceinline__ float sumsq(const f32x16& o0, const f32x16& o1) { float s = 0.f;
#pragma unroll
    for (int r = 0; r < 16; ++r) s += o0[r] * o0[r] + o1[r] * o1[r]; return s; }

__device__ __forceinline__ void unitA(ldsp lds, const bf16_t* proj, bf16_t* mixn, const float* sinks, int b, int T, int tid) {
    const int lane = tid & 63, w = tid >> 6, c = lane & 31, h = lane >> 5, head = c & 7;
    const float slope2 = exp2f(-8.0f * (float)(head + 1) / 12.0f) * LOG2E, sink2 = sinks[head] * LOG2E;
    const bf16_t* P = proj + (size_t)b * SEQ * LDP;
    const int t0 = 64 * T;
    ldsp Kt = lds, Vt = lds + TILE_B;
#pragma unroll 1
    for (int k = 0; k < 2; ++k) {
        const int tq = t0 + 8 * w + 4 * k + (c >> 3);
        bf16x8 qf[4];
        { const bf16_t* qp = P + (size_t)tq * LDP + C_QA + head * 64 + 8 * h;
#pragma unroll
          for (int s = 0; s < 4; ++s) qf[s] = *(const bf16x8*)(qp + 16 * s); }
        float m = sink2, l = 1.0f; f32x16 o0 = zero16(), o1 = zero16();
        const int j0 = T >= 2 ? T - 2 : 0;
        u32x4 rk = tile_ld(P + (size_t)(64 * j0) * LDP + C_KA, LDP, tid), rv = tile_ld(P + (size_t)(64 * j0) * LDP + C_VA, LDP, tid);
        for (int jt = j0; jt <= T; ++jt) {
            __syncthreads();
            tile_st(Kt, tid, rk); tile_st(Vt, tid, rv);
            __syncthreads();
            if (jt < T) { rk = tile_ld(P + (size_t)(64 * (jt + 1)) * LDP + C_KA, LDP, tid); rv = tile_ld(P + (size_t)(64 * (jt + 1)) * LDP + C_VA, LDP, tid); }
            f32x16 p0, p1; qk_tile(Kt, qf, lane, p0, p1); prep_band(p0, p1, tq, 64 * jt, h, slope2, 128, true);
            softmax_step(p0, p1, m, l, o0, o1); pv_tile(Vt, p0, p1, lane, o0, o1);
        }
        const float inv = 1.0f / l; float ss = sumsq(o0, o1) * inv * inv;
        ss += __shfl_xor(ss, 32); ss += __shfl_xor(ss, 1); ss += __shfl_xor(ss, 2); ss += __shfl_xor(ss, 4);
        const float sc = inv * __builtin_amdgcn_rsqf(ss * (1.0f / 512.0f) + 1e-6f);
        store_o(mixn + (size_t)(b * SEQ + tq) * DM + head * 64, o0, o1, sc, h);
    }
}

__device__ __forceinline__ float neg_softplus(float z) { const float az = fabsf(z); return -(fmaxf(z, 0.f) + 0.6931471805599453f * __builtin_amdgcn_logf(1.0f + ex2(-az * LOG2E))); }
__device__ __forceinline__ void stick_step(f32x16& p0, f32x16& p1, int tq, int tk0, int h, float& carry) {
    float run1 = 0.f, run0 = 0.f;
#pragma unroll
    for (int r = 15; r >= 0; --r) { const bool past = (tk0 + 32 + 16 * h + r) < tq; const float z = p1[r] * 0.125f; run1 += past ? neg_softplus(z) : 0.f; p1[r] = past ? z + run1 : NEG; }
#pragma unroll
    for (int r = 15; r >= 0; --r) { const bool past = (tk0 + 16 * h + r) < tq; const float z = p0[r] * 0.125f; run0 += past ? neg_softplus(z) : 0.f; p0[r] = past ? z + run0 : NEG; }
    const float ot1 = __shfl_xor(run1, 32), ot0 = __shfl_xor(run0, 32);
    const float off1 = carry + (h == 0 ? ot1 : 0.f);
    const float off0 = carry + run1 + ot1 + (h == 0 ? ot0 : 0.f);
    carry += (run0 + ot0) + (run1 + ot1);
#pragma unroll
    for (int r = 0; r < 16; ++r) { p1[r] = p1[r] > -1e29f ? ex2((p1[r] + off1) * LOG2E) : 0.f; p0[r] = p0[r] > -1e29f ? ex2((p0[r] + off0) * LOG2E) : 0.f; }
}
constexpr int C_SS_OFF = 8 * TILE_B;
__device__ __forceinline__ void unitC(ldsp lds, const bf16_t* proj, bf16_t* mixn, int b, int T, int tid) {
    const int lane = tid & 63, w = tid >> 6, c = lane & 31, h = lane >> 5, hd = w >> 1, ql = 32 * (w & 1) + c, tq = 64 * T + ql;
    const bf16_t* P = proj + (size_t)b * SEQ * LDP;
    bf16x8 qf[4];
    { const bf16_t* qp = P + (size_t)tq * LDP + C_QC + hd * 64 + 8 * h;
#pragma unroll
      for (int s = 0; s < 4; ++s) qf[s] = *(const bf16x8*)(qp + 16 * s); }
    f32x16 o0 = zero16(), o1 = zero16(); float carry = 0.f;
    u32x4 rg[8];
#pragma unroll
    for (int i = 0; i < 8; ++i) rg[i] = tile_ld(P + (size_t)(64 * T) * LDP + (i < 4 ? C_KC + i * 64 : C_VC + (i - 4) * 64), LDP, tid);
    for (int jt = T; jt >= 0; --jt) {
        __syncthreads();
#pragma unroll
        for (int i = 0; i < 8; ++i) tile_st(lds + ((i & 3) * 2 + (i >> 2)) * TILE_B, tid, rg[i]);
        __syncthreads();
        if (jt > 0) {
#pragma unroll
            for (int i = 0; i < 8; ++i) rg[i] = tile_ld(P + (size_t)(64 * (jt - 1)) * LDP + (i < 4 ? C_KC + i * 64 : C_VC + (i - 4) * 64), LDP, tid); }
        f32x16 p0, p1; qk_tile(lds + hd * 2 * TILE_B, qf, lane, p0, p1);
        stick_step(p0, p1, tq, 64 * jt, h, carry);
        pv_tile(lds + hd * 2 * TILE_B + TILE_B, p0, p1, lane, o0, o1);
    }
    float ss = sumsq(o0, o1); ss += __shfl_xor(ss, 32);
    LAS float* SS = (LAS float*)(lds + C_SS_OFF);
    if (h == 0) SS[ql * 4 + hd] = ss;
    __syncthreads();
    const float tot = (SS[ql * 4 + 0] + SS[ql * 4 + 1]) + (SS[ql * 4 + 2] + SS[ql * 4 + 3]);
    const float sc = __builtin_amdgcn_rsqf(tot * (1.0f / 256.0f) + 1e-6f);
    store_o(mixn + (size_t)(b * SEQ + tq) * DM + 768 + hd * 64, o0, o1, sc, h);
}

template <int MODE>
__device__ __forceinline__ void kv_loop(ldsp Kt, ldsp Vt, const bf16_t* Kg, const bf16_t* Vg, int jlo, int jhi, const bf16x8 (&qf)[4], int tq, float slope2, unsigned sel,
                                        int tid, int lane, int h, float& m, float& l, f32x16& o0, f32x16& o1) {
    u32x4 rk = tile_ld(Kg + (size_t)(64 * jlo) * LDP, LDP, tid), rv = tile_ld(Vg + (size_t)(64 * jlo) * LDP, LDP, tid);
    for (int jt = jlo; jt <= jhi; ++jt) {
        __syncthreads();
        tile_st(Kt, tid, rk); tile_st(Vt, tid, rv);
        __syncthreads();
        if (jt < jhi) { rk = tile_ld(Kg + (size_t)(64 * (jt + 1)) * LDP, LDP, tid); rv = tile_ld(Vg + (size_t)(64 * (jt + 1)) * LDP, LDP, tid); }
        const bool mine = MODE == 0 ? ((sel >> jt) & 1u) != 0u : true;
        if (MODE == 1 || __any(mine ? 1 : 0)) {
            f32x16 p0, p1; qk_tile(Kt, qf, lane, p0, p1);
            prep_band(p0, p1, tq, 64 * jt, h, slope2, MODE == 0 ? 4096 : 512, mine);
            softmax_step(p0, p1, m, l, o0, o1); pv_tile(Vt, p0, p1, lane, o0, o1);
        }
    }
}
constexpr int B_CK = 2 * TILE_B, B_CV = 4 * TILE_B, B_IMP = 6 * TILE_B, B_MASK = B_IMP + 16384;
__device__ __forceinline__ void unitB(ldsp lds, const bf16_t* proj, const bf16_t* kc, const bf16_t* vc, bf16_t* mixn, int b, int T, int tid) {
    const int lane = tid & 63, w = tid >> 6, c = lane & 31, h = lane >> 5, hd = c & 3, qloc = c >> 2, tq = 64 * T + 8 * w + qloc;
    const float slope2 = exp2f(-8.0f * (float)(hd + 9) / 12.0f) * LOG2E;
    const bf16_t* P = proj + (size_t)b * SEQ * LDP;
    bf16x8 qf[4];
    { const bf16_t* qp = P + (size_t)tq * LDP + C_QB + hd * 64 + 8 * h;
#pragma unroll
      for (int s = 0; s < 4; ++s) qf[s] = *(const bf16x8*)(qp + 16 * s); }
    float gate[3];
#pragma unroll
    for (int i = 0; i < 3; ++i) { const float gv = bf2f(P[(size_t)tq * LDP + C_GB + hd * 3 + i]); gate[i] = 1.0f / (1.0f + __expf(-gv)); }
    f32x16 ob0 = zero16(), ob1 = zero16();
    const int ntc = T >= 16 ? 2 : 1;
    __syncthreads();
#pragma unroll
    for (int t = 0; t < 2; ++t) { int n = 64 * t + (tid >> 3); n = n > 126 ? 126 : n;
        const size_t off = ((size_t)b * 128 + n) * 64 + (tid & 7) * 8;
        tile_st(lds + B_CK + t * TILE_B, tid, *(const u32x4*)(kc + off)); tile_st(lds + B_CV + t * TILE_B, tid, *(const u32x4*)(vc + off)); }
    __syncthreads();
    unsigned sel;
    {
        f32x16 pa0, pa1, pb0, pb1;
        qk_tile(lds + B_CK, qf, lane, pa0, pa1);
        if (ntc == 2) qk_tile(lds + B_CK + TILE_B, qf, lane, pb0, pb1); else { pb0 = zero16(); pb1 = zero16(); }
        float mxv = NEG;
#pragma unroll
        for (int r = 0; r < 16; ++r) {
            const int n0 = 16 * h + r; const int d0 = tq - (16 * n0 + 31), d1 = d0 - 512, d2 = d0 - 1024, d3 = d0 - 1536;
            pa0[r] = d0 >= 0 ? pa0[r] * KSC2 - slope2 * (float)d0 : NEG; pa1[r] = d1 >= 0 ? pa1[r] * KSC2 - slope2 * (float)d1 : NEG;
            pb0[r] = d2 >= 0 ? pb0[r] * KSC2 - slope2 * (float)d2 : NEG; pb1[r] = d3 >= 0 ? pb1[r] * KSC2 - slope2 * (float)d3 : NEG;
            mxv = fmaxf(fmaxf(mxv, fmaxf(pa0[r], pa1[r])), fmaxf(pb0[r], pb1[r]));
        }
        mxv = fmaxf(mxv, __shfl_xor(mxv, 32));
        float ls = 0.f;
#pragma unroll
        for (int r = 0; r < 16; ++r) {
            pa0[r] = pa0[r] > -1e29f ? ex2(pa0[r] - mxv) : 0.f; pa1[r] = pa1[r] > -1e29f ? ex2(pa1[r] - mxv) : 0.f;
            pb0[r] = pb0[r] > -1e29f ? ex2(pb0[r] - mxv) : 0.f; pb1[r] = pb1[r] > -1e29f ? ex2(pb1[r] - mxv) : 0.f;
            ls += (pa0[r] + pa1[r]) + (pb0[r] + pb1[r]);
        }
        ls += __shfl_xor(ls, 32);
        const float inv = ls > 0.f ? 1.0f / ls : 0.f;
        f32x16 oc0 = zero16(), oc1 = zero16();
        pv_tile(lds + B_CV, pa0, pa1, lane, oc0, oc1);
        if (ntc == 2) pv_tile(lds + B_CV + TILE_B, pb0, pb1, lane, oc0, oc1);
        const float gs = gate[0] * inv;
        ob0 += oc0 * gs; ob1 += oc1 * gs;
        LAS float* IA = (LAS float*)(lds + B_IMP) + w * 512 + qloc * 32;
        LAS float* IB = IA + 256;
#pragma unroll
        for (int g = 0; g < 4; ++g) {
            float a0 = (2.0f * (pa0[4 * g] + pa0[4 * g + 1] + pa0[4 * g + 2]) + pa0[4 * g + 3]) * inv, b0 = pa0[4 * g + 3] * inv;
            float a1 = (2.0f * (pa1[4 * g] + pa1[4 * g + 1] + pa1[4 * g + 2]) + pa1[4 * g + 3]) * inv, b1 = pa1[4 * g + 3] * inv;
            float a2 = (2.0f * (pb0[4 * g] + pb0[4 * g + 1] + pb0[4 * g + 2]) + pb0[4 * g + 3]) * inv, b2 = pb0[4 * g + 3] * inv;
            float a3 = (2.0f * (pb1[4 * g] + pb1[4 * g + 1] + pb1[4 * g + 2]) + pb1[4 * g + 3]) * inv, b3 = pb1[4 * g + 3] * inv;
            a0 += __shfl_xor(a0, 1); a0 += __shfl_xor(a0, 2); b0 += __shfl_xor(b0, 1); b0 += __shfl_xor(b0, 2);
            a1 += __shfl_xor(a1, 1); a1 += __shfl_xor(a1, 2); b1 += __shfl_xor(b1, 1); b1 += __shfl_xor(b1, 2);
            a2 += __shfl_xor(a2, 1); a2 += __shfl_xor(a2, 2); b2 += __shfl_xor(b2, 1); b2 += __shfl_xor(b2, 2);
            a3 += __shfl_xor(a3, 1); a3 += __shfl_xor(a3, 2); b3 += __shfl_xor(b3, 1); b3 += __shfl_xor(b3, 2);
            if (hd == 0) { const int j = 4 * h + g; IA[j] = a0; IB[j] = b0; IA[8 + j] = a1; IB[8 + j] = b1; IA[16 + j] = a2; IB[16 + j] = b2; IA[24 + j] = a3; IB[24 + j] = b3; }
        }
        asm volatile("s_waitcnt lgkmcnt(0)" ::: "memory"); __builtin_amdgcn_wave_barrier();
        LAS unsigned* MK = (LAS unsigned*)(lds + B_MASK) + w * 8;
        if (lane < 8) {
            const LAS float* SA = (const LAS float*)(lds + B_IMP) + w * 512 + lane * 32; const LAS float* SB = SA + 256;
            unsigned mk = 1u | (1u << T) | (T >= 1 ? (1u << (T - 1)) : 0u);
            int need = 8 - __popc(mk);
            for (int it = 0; it < need; ++it) {
                int best = -1; float bv = -1.0f;
                for (int j = 1; j <= T; ++j) { if ((mk >> j) & 1u) continue; const float v = SA[j] + SB[j - 1]; if (v > bv) { bv = v; best = j; } }
                if (best < 0) break;
                mk |= 1u << best;
            }
            MK[lane] = mk;
        }
        asm volatile("s_waitcnt lgkmcnt(0)" ::: "memory"); __builtin_amdgcn_wave_barrier();
        sel = MK[qloc];
    }
    { float m = NEG, l = 0.f; f32x16 o0 = zero16(), o1 = zero16();
      kv_loop<0>(lds, lds + TILE_B, P + C_KSB, P + C_VSB, 0, T, qf, tq, slope2, sel, tid, lane, h, m, l, o0, o1);
      const float gs = gate[1] / l; ob0 += o0 * gs; ob1 += o1 * gs; }
    { float m = NEG, l = 0.f; f32x16 o0 = zero16(), o1 = zero16();
      kv_loop<1>(lds, lds + TILE_B, P + C_KWB, P + C_VWB, T >= 8 ? T - 8 : 0, T, qf, tq, slope2, 0u, tid, lane, h, m, l, o0, o1);
      const float gs = gate[2] / l; ob0 += o0 * gs; ob1 += o1 * gs; }
    float ss = sumsq(ob0, ob1); ss += __shfl_xor(ss, 32); ss += __shfl_xor(ss, 1); ss += __shfl_xor(ss, 2);
    const float sc = __builtin_amdgcn_rsqf(ss * (1.0f / 256.0f) + 1e-6f);
    store_o(mixn + (size_t)(b * SEQ + tq) * DM + 512 + hd * 64, ob0, ob1, sc, h);
}

__device__ __forceinline__ float gelu_tanh(float x) { const float u = 0.7978845608028654f * (x + 0.044715f * x * x * x); const float e = __expf(2.0f * u); return 0.5f * x * (1.0f + (1.0f - 2.0f / (e + 1.0f))); }
__device__ __forceinline__ void unitCmp(const bf16_t* proj, const bf16_t* w1t, const bf16_t* w2t, const float* bias1, bf16_t* kc, bf16_t* vc, int b, int tid) {
    const int lane = tid & 63, w = tid >> 6, c = lane & 31, h = lane >> 5, g = w >> 1, kv = w & 1;
    const int n = 32 * g + c, nn = n > 126 ? 126 : n;
    const bf16_t* src = proj + ((size_t)b * SEQ + 16 * nn) * LDP + (kv ? C_VCB : C_KCB) + 8 * h;
    const bf16_t* wa = w1t + ((size_t)kv * 128 + c) * 2048 + 8 * h;
    f32x16 acc[4] = {zero16(), zero16(), zero16(), zero16()};
#pragma unroll 4
    for (int s = 0; s < 128; ++s) {
        const bf16x8 bq = *(const bf16x8*)(src + (size_t)(s >> 2) * LDP + (s & 3) * 16);
#pragma unroll
        for (int fb = 0; fb < 4; ++fb) { const bf16x8 a = *(const bf16x8*)(wa + (size_t)fb * 32 * 2048 + 16 * s); acc[fb] = __builtin_amdgcn_mfma_f32_32x32x16_bf16(a, bq, acc[fb], 0, 0, 0); }
    }
    f32x16 y0 = zero16(), y1 = zero16();
    const bf16_t* w2a = w2t + ((size_t)kv * 64 + c) * 128;
#pragma unroll
    for (int fb = 0; fb < 4; ++fb) {
#pragma unroll
        for (int r = 0; r < 16; ++r) acc[fb][r] = gelu_tanh(acc[fb][r] + bias1[kv * 128 + 32 * fb + (r & 3) + 8 * (r >> 2) + 4 * h]);
#pragma unroll
        for (int s2 = 0; s2 < 2; ++s2) {
            u32x4 pw; const int rb = 8 * s2; pw.x = pk2(acc[fb][rb], acc[fb][rb + 1]); pw.y = pk2(acc[fb][rb + 2], acc[fb][rb + 3]); pw.z = pk2(acc[fb][rb + 4], acc[fb][rb + 5]); pw.w = pk2(acc[fb][rb + 6], acc[fb][rb + 7]);
            const bf16x8 hb = __builtin_bit_cast(bf16x8, pw);
            const int f0 = 32 * fb + 16 * s2 + 4 * h;
            { const u32x2 lo = *(const u32x2*)(w2a + f0), hi = *(const u32x2*)(w2a + f0 + 8); u32x4 av; av.x = lo.x; av.y = lo.y; av.z = hi.x; av.w = hi.y;
              y0 = __builtin_amdgcn_mfma_f32_32x32x16_bf16(__builtin_bit_cast(bf16x8, av), hb, y0, 0, 0, 0); }
            { const u32x2 lo = *(const u32x2*)(w2a + 32 * 128 + f0), hi = *(const u32x2*)(w2a + 32 * 128 + f0 + 8); u32x4 av; av.x = lo.x; av.y = lo.y; av.z = hi.x; av.w = hi.y;
              y1 = __builtin_amdgcn_mfma_f32_32x32x16_bf16(__builtin_bit_cast(bf16x8, av), hb, y1, 0, 0, 0); }
        }
    }
    if (n < 127) store_o((kv ? vc : kc) + ((size_t)b * 128 + n) * 64, y0, y1, 1.0f, h);
}
}
using mx::ldsp; using mx::bf16_t;
typedef float f32x4 __attribute__((ext_vector_type(4)));
typedef unsigned u32x4 __attribute__((ext_vector_type(4)));
typedef unsigned u32x2 __attribute__((ext_vector_type(2)));
constexpr int BATCH = 32, SEQ = 2048, DM = 1024, DEPTH = 4, MTOK = BATCH * SEQ, NPROJ = 2304, INW = 2060, DFF = 2816, NGU = 2 * DFF;
constexpr size_t MiB = 1u << 20;
constexpr size_t WS_CTR = 0;
constexpr size_t WS_WIN = 1 * MiB, SZ_WIN = (size_t)NPROJ * DM * 2;
constexpr size_t WS_WOUT = 19 * MiB, SZ_WOUT = (size_t)DM * DM * 2;
constexpr size_t WS_WGU = 27 * MiB, SZ_WGU = (size_t)NGU * DM * 2;
constexpr size_t WS_WDN = 71 * MiB, SZ_WDN = (size_t)DM * DFF * 2;
constexpr size_t WS_W1T = 93 * MiB, SZ_W1T = (size_t)2 * 128 * 2048 * 2;
constexpr size_t WS_W2T = 97 * MiB, SZ_W2T = (size_t)2 * 64 * 128 * 2;
constexpr size_t WS_B1 = 97 * MiB + 512 * 1024, SZ_B1 = 2 * 128 * 4;
constexpr size_t WS_KC = 98 * MiB, WS_VC = 98 * MiB + 512 * 1024;
constexpr size_t WS_SS = 100 * MiB;
constexpr size_t WS_XB = 104 * MiB;
constexpr size_t WS_PROJ = 232 * MiB;
constexpr size_t WS_MIXN = 520 * MiB;
constexpr size_t WS_HID = 232 * MiB;
constexpr size_t WS_END = 648 * MiB;
static_assert(WS_WIN + 4 * SZ_WIN <= WS_WOUT && WS_WOUT + 4 * SZ_WOUT <= WS_WGU && WS_WGU + 4 * SZ_WGU <= WS_WDN && WS_WDN + 4 * SZ_WDN <= WS_W1T && WS_W1T + 4 * SZ_W1T <= WS_W2T, "ws map");
static_assert(WS_HID + (size_t)MTOK * DFF * 2 <= WS_END && WS_PROJ + (size_t)MTOK * NPROJ * 2 <= WS_MIXN && WS_XB + (size_t)MTOK * DM * 2 <= WS_PROJ, "ws map 2");
constexpr int LDS_BYTES = 143360, LDS_CTL = 131072;
constexpr int NPHASE = 2 + 6 * DEPTH;

struct Params { const float* in[16]; float* out; unsigned char* ws; int ph_lo, ph_hi; };

__device__ __forceinline__ float wave_sum(float v) {
#pragma unroll
    for (int o = 1; o < 64; o <<= 1) v += __shfl_xor(v, o);
    return v;
}
template <class RowMap>
__device__ __forceinline__ void transpose_item(const float* W, int K, int N, const float* gk0  , bf16_t* WT, RowMap rm, LAS float* scr, int kb, int nb, int lane) {
    const int k0 = 64 * kb, n0 = 32 * nb, nl = n0 + (lane & 31);
#pragma unroll 8
    for (int i = 0; i < 32; ++i) { const int kk = 2 * i + (lane >> 5); float v = nl < N ? W[(size_t)(k0 + kk) * N + nl] : 0.f; if (gk0) v *= gk0[kk]; scr[kk * 33 + (lane & 31)] = v; }
    asm volatile("s_waitcnt lgkmcnt(0)" ::: "memory"); __builtin_amdgcn_wave_barrier();
    const int c = lane & 7;
#pragma unroll
    for (int j = 0; j < 4; ++j) { const int n = (lane >> 3) + 8 * j; const LAS float* s = scr + (8 * c) * 33 + n;
        u32x4 o; o.x = mx::pk2(s[0 * 33], s[1 * 33]); o.y = mx::pk2(s[2 * 33], s[3 * 33]); o.z = mx::pk2(s[4 * 33], s[5 * 33]); o.w = mx::pk2(s[6 * 33], s[7 * 33]);
        if (n0 + n < N) *(u32x4*)(WT + (size_t)rm(n0 + n) * K + k0 + 8 * c) = o; }
    asm volatile("s_waitcnt lgkmcnt(0)" ::: "memory"); __builtin_amdgcn_wave_barrier();
}
struct RmId { __device__ int operator()(int n) const { return n; } };
struct RmIn { __device__ int operator()(int n) const { return n < 1280 ? n : (n < 1292 ? 2048 + (n - 1280) : n - 12); } };
struct RmGU { int up; __device__ int operator()(int n) const { return 256 * (n >> 7) + 128 * up + (n & 127); } };

__device__ __forceinline__ void prologue(const Params& p, ldsp lds, int tid) {
    const int lane = tid & 63, wave = tid >> 6, gw = blockIdx.x * 8 + wave, NGW = gridDim.x * 8;
    LAS float* scr = (LAS float*)(lds + wave * 16384);
    unsigned char* ws = p.ws;
    if (blockIdx.x == 0 && tid < 64) ((unsigned*)(ws + WS_CTR))[tid * 64] = 0u;
    const float *w_in = p.in[1], *w_out = p.in[2], *g_attn = p.in[3], *g_ffn = p.in[4], *g_oa = p.in[5], *g_ob = p.in[6], *g_oc = p.in[7];
    const float *cmp_pos = p.in[9], *cmp_w1 = p.in[10], *cmp_w2 = p.in[11], *w_gate = p.in[12], *w_up = p.in[13], *w_down = p.in[14];
    constexpr int I_IN = 16 * 65, I_OUT = 16 * 32, I_G = 16 * 88, I_DN = 44 * 32, I_W1 = 2 * 32 * 4, I_W2 = 2 * 2 * 2;
    constexpr int I_LAYER = I_IN + I_OUT + 2 * I_G + I_DN + I_W1 + I_W2;
    for (int it = gw; it < DEPTH * I_LAYER; it += NGW) {
        const int L = it / I_LAYER; int r = it % I_LAYER;
        if (r < I_IN) { const int kb = r / 65, nb = r % 65; transpose_item(w_in + (size_t)L * DM * INW, DM, INW, g_attn + L * DM + 64 * kb, (bf16_t*)(ws + WS_WIN + L * SZ_WIN), RmIn(), scr, kb, nb, lane); continue; } r -= I_IN;
        if (r < I_OUT) { const int kb = r / 32, nb = r % 32, k0 = 64 * kb;
            const float* g = k0 < 512 ? g_oa + L * 512 + k0 : (k0 < 768 ? g_ob + L * 256 + (k0 - 512) : g_oc + L * 256 + (k0 - 768));
            transpose_item(w_out + (size_t)L * DM * DM, DM, DM, g, (bf16_t*)(ws + WS_WOUT + L * SZ_WOUT), RmId(), scr, kb, nb, lane); continue; } r -= I_OUT;
        if (r < I_G) { const int kb = r / 88, nb = r % 88; transpose_item(w_gate + (size_t)L * DM * DFF, DM, DFF, g_ffn + L * DM + 64 * kb, (bf16_t*)(ws + WS_WGU + L * SZ_WGU), RmGU{0}, scr, kb, nb, lane); continue; } r -= I_G;
        if (r < I_G) { const int kb = r / 88, nb = r % 88; transpose_item(w_up + (size_t)L * DM * DFF, DM, DFF, g_ffn + L * DM + 64 * kb, (bf16_t*)(ws + WS_WGU + L * SZ_WGU), RmGU{1}, scr, kb, nb, lane); continue; } r -= I_G;
        if (r < I_DN) { const int kb = r / 32, nb = r % 32; transpose_item(w_down + (size_t)L * DFF * DM, DFF, DM, nullptr, (bf16_t*)(ws + WS_WDN + L * SZ_WDN), RmId(), scr, kb, nb, lane); continue; } r -= I_DN;
        if (r < I_W1) { const int kv = r / 128, r2 = r % 128, kb = r2 / 4, nb = r2 % 4;
            transpose_item(cmp_w1 + ((size_t)L * 2 + kv) * 2048 * 128, 2048, 128, nullptr, (bf16_t*)(ws + WS_W1T + L * SZ_W1T) + (size_t)kv * 128 * 2048, RmId(), scr, kb, nb, lane); continue; } r -= I_W1;
        { const int kv = r / 4, r2 = r % 4, kb = r2 / 2, nb = r2 % 2;
            transpose_item(cmp_w2 + ((size_t)L * 2 + kv) * 128 * 64, 128, 64, nullptr, (bf16_t*)(ws + WS_W2T + L * SZ_W2T) + (size_t)kv * 64 * 128, RmId(), scr, kb, nb, lane); }
    }
    { const int gt = blockIdx.x * 512 + tid, NGT = gridDim.x * 512; constexpr int PER = (NPROJ - INW) * DM * 2 / 16;
      for (int i = gt; i < DEPTH * PER; i += NGT) { const int L = i / PER, j = i % PER; ((u32x4*)(ws + WS_WIN + L * SZ_WIN + (size_t)INW * DM * 2))[j] = (u32x4){0u, 0u, 0u, 0u}; } }
    { const int gt = blockIdx.x * 512 + tid;
      if (gt < DEPTH * 256) { const int L = gt / 256, kv = (gt >> 7) & 1, f = gt & 127; const float* pos = cmp_pos + ((size_t)L * 2 + kv) * 2048; const float* w1 = cmp_w1 + ((size_t)L * 2 + kv) * 2048 * 128 + f;
          float s = 0.f; for (int k = 0; k < 2048; ++k) s += pos[k] * w1[(size_t)k * 128];
          ((float*)(ws + WS_B1 + L * SZ_B1))[kv * 128 + f] = s; } }
    { const float* x = p.in[0]; bf16_t* xb = (bf16_t*)(ws + WS_XB); float* ss = (float*)(ws + WS_SS);
      for (int row = gw; row < MTOK; row += NGW) { const f32x4* xr = (const f32x4*)(x + (size_t)row * DM) + lane; unsigned long long* o8 = (unsigned long long*)(xb + (size_t)row * DM) + lane; float s = 0.f;
#pragma unroll
          for (int j = 0; j < 4; ++j) { const f32x4 v = xr[64 * j]; s += (v[0] * v[0] + v[1] * v[1]) + (v[2] * v[2] + v[3] * v[3]);
              o8[64 * j] = (unsigned long long)mx::pk2(v[0], v[1]) | ((unsigned long long)mx::pk2(v[2], v[3]) << 32); }
          s = wave_sum(s);
          if (lane < 16) ss[(size_t)row * 16 + lane] = lane == 0 ? s : 0.f; } }
}
__device__ __forceinline__ void final_norm(const Params& p, int tid) {
    const int lane = tid & 63, wave = tid >> 6, gw = blockIdx.x * 8 + wave, NGW = gridDim.x * 8;
    const float* ss = (const float*)(p.ws + WS_SS); const float* g = p.in[15]; float* out = p.out;
    f32x4 gv[4];
#pragma unroll
    for (int j = 0; j < 4; ++j) gv[j] = ((const f32x4*)g)[lane + 64 * j];
    for (int row = gw; row < MTOK; row += NGW) {
        float s = lane < 16 ? ss[(size_t)row * 16 + lane] : 0.f; s = wave_sum(s);
        const float rs = 1.0f / sqrtf(s * (1.0f / 1024.0f) + 1e-6f);
        f32x4* xr = (f32x4*)(out + (size_t)row * DM) + lane;
#pragma unroll
        for (int j = 0; j < 4; ++j) { f32x4 v = xr[64 * j]; v = v * rs * gv[j]; xr[64 * j] = v; }
    }
}
__device__ __forceinline__ int q_next(unsigned* ctr, LAS unsigned* slot, int tid) {
    __syncthreads();
    if (tid == 0) *slot = atomicAdd(ctr, 1u);
    __syncthreads();
    return (int)*slot;
}

__global__ void __launch_bounds__(512, 2) mk_fwd(Params p) {
    extern __shared__ __attribute__((aligned(16))) unsigned char lds_raw[];
    ldsp lds = (ldsp)lds_raw;
    cg::grid_group grid = cg::this_grid();
    const int lo = p.ph_lo, hi = p.ph_hi;
#define OPAQUE_TID() int tid = threadIdx.x; asm volatile("" : "+v"(tid))
    unsigned char* ws = p.ws;
    LAS unsigned* slot = (LAS unsigned*)(lds + LDS_CTL);
    bf16_t* XB = (bf16_t*)(ws + WS_XB); bf16_t* PROJ = (bf16_t*)(ws + WS_PROJ); bf16_t* MIXN = (bf16_t*)(ws + WS_MIXN); bf16_t* HID = (bf16_t*)(ws + WS_HID);
    bf16_t* KC = (bf16_t*)(ws + WS_KC); bf16_t* VC = (bf16_t*)(ws + WS_VC); float* SS = (float*)(ws + WS_SS);
    int ph = 0;
#define RUN() (lo <= ph && ph < hi)
#define SEAM() do { if (RUN() && ph + 1 < hi) grid.sync(); ++ph; } while (0)
    #ifndef SKIP_P0
    if (RUN()) { OPAQUE_TID(); prologue(p, lds, tid); }
#endif
    SEAM();
    for (int L = 0; L < DEPTH; ++L) {
#ifndef SKIP_G1
        if (RUN()) { pg8::Gemm g{XB, (const bf16_t*)(ws + WS_WIN + L * SZ_WIN), MTOK, NPROJ, DM}; pg8::StaticOrder S; S.init(MTOK, NPROJ, (int)gridDim.x, (int)blockIdx.x);
            pg8::EpiProj E{PROJ, NPROJ, SS};
            pg8::gemm_phase<pg8::EpiProj, pg8::StaticOrder, true, true>((PG8_LAS unsigned char*)lds, g, S, E); }
#endif
        SEAM();
#ifndef SKIP_P2
        if (RUN()) { OPAQUE_TID(); unsigned* ctr = (unsigned*)(ws + WS_CTR) + 64 * ph;
            for (;;) { const int u = q_next(ctr, slot, tid); if (u >= 32 + 2048) break;
                if (u < 32) {
#ifndef SKIP_CMP
 mx::unitCmp(PROJ, (const bf16_t*)(ws + WS_W1T + L * SZ_W1T), (const bf16_t*)(ws + WS_W2T + L * SZ_W2T), (const float*)(ws + WS_B1 + L * SZ_B1), KC, VC, u, tid);
#endif
 }
                else if (u < 32 + 1024) {
#ifndef SKIP_C
 const int k = u - 32; mx::unitC(lds, PROJ, MIXN, k & 31, 31 - (k >> 5), tid);
#endif
 }
                else {
#ifndef SKIP_A
 const int k = u - 32 - 1024; mx::unitA(lds, PROJ, MIXN, p.in[8] + L * 8, k & 31, 31 - (k >> 5), tid);
#endif
 } } }
#endif
        SEAM();
#ifndef SKIP_P3
        if (RUN()) { OPAQUE_TID(); unsigned* ctr = (unsigned*)(ws + WS_CTR) + 64 * ph;
            for (;;) { const int u = q_next(ctr, slot, tid); if (u >= 1024) break; mx::unitB(lds, PROJ, KC, VC, MIXN, u & 31, 31 - (u >> 5), tid); } }
#endif
        SEAM();
#ifndef SKIP_G4
        if (RUN()) { pg8::Gemm g{MIXN, (const bf16_t*)(ws + WS_WOUT + L * SZ_WOUT), MTOK, DM, DM}; pg8::StaticOrder S; S.init(MTOK, DM, (int)gridDim.x, (int)blockIdx.x);
            pg8::EpiRes E{L == 0 ? p.in[0] : p.out, p.out, XB, SS};
            pg8::gemm_phase<pg8::EpiRes, pg8::StaticOrder, true, true>((PG8_LAS unsigned char*)lds, g, S, E); }
#endif
        SEAM();
#ifndef SKIP_G5
        if (RUN()) { pg8::Gemm g{XB, (const bf16_t*)(ws + WS_WGU + L * SZ_WGU), MTOK, NGU, DM}; pg8::StaticOrder S; S.init(MTOK, NGU, (int)gridDim.x, (int)blockIdx.x);
            pg8::EpiGU E{HID, DFF, SS};
            pg8::gemm_phase<pg8::EpiGU, pg8::StaticOrder, true, true>((PG8_LAS unsigned char*)lds, g, S, E); }
#endif
        SEAM();
#ifndef SKIP_G6
        if (RUN()) { pg8::Gemm g{HID, (const bf16_t*)(ws + WS_WDN + L * SZ_WDN), MTOK, DM, DFF}; pg8::StaticOrder S; S.init(MTOK, DM, (int)gridDim.x, (int)blockIdx.x);
            pg8::EpiRes E{p.out, p.out, XB, SS};
            pg8::gemm_phase<pg8::EpiRes, pg8::StaticOrder, true, true>((PG8_LAS unsigned char*)lds, g, S, E); }
#endif
        SEAM();
    }
    if (RUN()) { OPAQUE_TID(); final_norm(p, tid); }
#undef RUN
#undef SEAM
}

#ifndef MK_PER_PHASE
#define MK_PER_PHASE 0
#endif
extern "C" void kernel_launch(void* const* d_in, const int* in_sizes, int n_in, void* d_out, int out_size, void* d_ws, size_t ws_size, hipStream_t stream) {
    static int grid = 0;
    if (grid == 0) {
        if (n_in != 16 || out_size != MTOK * DM || ws_size < WS_END) { fprintf(stderr, "kernel_launch: unexpected shapes (n_in %d, out %d, ws %zu)\n", n_in, out_size, ws_size); grid = -1; return; }
        int dev = 0, cus = 0, per_cu = 0;
        hipGetDevice(&dev); hipDeviceGetAttribute(&cus, hipDeviceAttributeMultiprocessorCount, dev);
        if (hipFuncSetAttribute((const void*)mk_fwd, hipFuncAttributeMaxDynamicSharedMemorySize, LDS_BYTES) != hipSuccess) { fprintf(stderr, "kernel_launch: hipFuncSetAttribute failed\n"); grid = -1; return; }
        if (hipOccupancyMaxActiveBlocksPerMultiprocessor(&per_cu, (const void*)mk_fwd, 512, LDS_BYTES) != hipSuccess || per_cu < 1) { fprintf(stderr, "kernel_launch: occupancy query says %d\n", per_cu); per_cu = 1; }
        (void)hipGetLastError();
        grid = cus;
    }
    if (grid < 0) return;
    Params p{};
    for (int i = 0; i < 16; ++i) p.in[i] = (const float*)d_in[i];
    p.out = (float*)d_out; p.ws = (unsigned char*)d_ws;
#if MK_PER_PHASE
    for (int ph = 0; ph < NPHASE; ++ph) { p.ph_lo = ph; p.ph_hi = ph + 1; hipLaunchKernelGGL(mk_fwd, dim3(grid), dim3(512), LDS_BYTES, stream, p); }
#else
    p.ph_lo = 0; p.ph_hi = NPHASE;
    void* args[] = {&p};
    hipError_t e = hipLaunchCooperativeKernel((const void*)mk_fwd, dim3(grid), dim3(512), args, LDS_BYTES, stream);
    if (e != hipSuccess) fprintf(stderr, "kernel_launch: cooperative launch failed: %s (grid %d)\n", hipGetErrorString(e), grid);
#endif
}
```

```cpp
#include <hip/hip_runtime.h>
#include <hip/hip_cooperative_groups.h>
#include <cstdio>
#include <cstdint>
namespace cg = cooperative_groups;
namespace pg8 {
#define PG8_LAS __attribute__((address_space(3)))
typedef unsigned short bf16_t;
typedef short bf16x8 __attribute__((ext_vector_type(8)));
typedef float f32x4 __attribute__((ext_vector_type(4)));
typedef unsigned u32x4 __attribute__((ext_vector_type(4)));
constexpr int BM = 256, BK = 64, HALF = 128, HTB = HALF * BK * 2  , STAGE_BYTES = 8 * HTB, NXCD = 8, WGM = 8;

__host__ __device__ __forceinline__ int lds_byte(int r, int c) { const int st = (r >> 4) * 2 + (c >> 5), rr = r & 15, cc = c & 31, ob = rr * 64 + cc * 2; return st * 1024 + (ob ^ (((ob >> 9) & 1) << 5)); }
__host__ __device__ __forceinline__ void stage_rc(int b, int& R, int& C) { const int st = b / 1024, sb = b % 1024, swz = sb ^ (((sb >> 9) & 1) << 5); R = (st >> 1) * 16 + swz / 64; C = (st & 1) * 32 + (swz % 64) / 2; }
__host__ __device__ __forceinline__ int perm32(int rho) { const int n = rho >> 4, i = rho & 15; return 8 * (i >> 2) + 4 * n + (i & 3); }

struct Unit { int pm, pn; };
struct Gemm { const bf16_t* A; const bf16_t* Bt; int M, N, K; };

struct StaticOrder {
    int nM, nN, nwg, G, c;
    __host__ __device__ void init(int M, int N, int G_, int c_) { nM = M / BM; nN = N / BM; nwg = nM * nN; G = G_; c = c_; }
    __host__ __device__ bool next(int i, Unit& u) const {
        const long L = (long)i * G + c; if (L >= nwg) return false;
        int wgid = (int)L; { const int q = nwg / NXCD, r = nwg % NXCD, xcd = wgid % NXCD, off = wgid / NXCD; wgid = (xcd < r ? xcd * (q + 1) : r * (q + 1) + (xcd - r) * q) + off; }
        const int nig = WGM * nN, gid = wgid / nig, fm = gid * WGM, gsz = (nM - fm) < WGM ? (nM - fm) : WGM;
        u.pm = fm + ((wgid % nig) % gsz); u.pn = (wgid % nig) / gsz; return true;
    }
    __device__ __forceinline__ void a_ready(const Unit&) const {}
    __device__ __forceinline__ void done(const Unit&) const {}
};

__device__ __forceinline__ unsigned cvt_pk_bf16(float lo, float hi) { unsigned r; asm volatile("v_cvt_pk_bf16_f32 %0, %1, %2" : "=v"(r) : "v"(lo), "v"(hi)); return r; }
typedef float f32x2 __attribute__((ext_vector_type(2)));
typedef unsigned u32x2 __attribute__((ext_vector_type(2)));
__device__ __forceinline__ float row_rstd(const float* ss, int row, int fq) {
    const f32x4 v = *(const f32x4*)(ss + (size_t)row * 16 + 4 * fq);
    float s = (v[0] + v[1]) + (v[2] + v[3]);
    s += __shfl_xor(s, 16); s += __shfl_xor(s, 32);
    return __builtin_amdgcn_rsqf(s * (1.0f / 1024.0f) + 1e-6f);
}
__device__ __forceinline__ void row_rstd8(const float* ss, int row0, int fq, float (&rs)[2][4]) {
    f32x4 v[2][4];
#pragma unroll
    for (int ai = 0; ai < 2; ++ai)
#pragma unroll
        for (int m = 0; m < 4; ++m) v[ai][m] = *(const f32x4*)(ss + (size_t)(row0 + ai * HALF + m * 16) * 16 + 4 * fq);
#pragma unroll
    for (int ai = 0; ai < 2; ++ai)
#pragma unroll
        for (int m = 0; m < 4; ++m) { float s = (v[ai][m][0] + v[ai][m][1]) + (v[ai][m][2] + v[ai][m][3]); s += __shfl_xor(s, 16); s += __shfl_xor(s, 32);
            rs[ai][m] = __builtin_amdgcn_rsqf(s * (1.0f / 1024.0f) + 1e-6f); }
}
struct EpiProj {
    static constexpr bool PERM = true, AFTER_DRAIN = false;
    bf16_t* O; int ldc; const float* ss;
    __device__ __forceinline__ void operator()(const f32x4 (&acc)[2][2][4][2], const Unit& u, int wr, int wc, int fr, int fq) const {
        const int row0 = u.pm * BM + wr * 64 + fr, col0 = u.pn * BM + wc * 32 + 8 * fq;
        float rsv[2][4]; row_rstd8(ss, row0, fq, rsv);
#pragma unroll
        for (int ai = 0; ai < 2; ++ai)
#pragma unroll
            for (int m = 0; m < 4; ++m) { const int row = row0 + ai * HALF + m * 16; const float rs = rsv[ai][m]; bf16_t* rowp = O + (size_t)row * ldc + col0;
#pragma unroll
                for (int bj = 0; bj < 2; ++bj) { const f32x4 v0 = acc[ai][bj][m][0] * rs, v1 = acc[ai][bj][m][1] * rs;
                    u32x4 w; w.x = cvt_pk_bf16(v0[0], v0[1]); w.y = cvt_pk_bf16(v0[2], v0[3]); w.z = cvt_pk_bf16(v1[0], v1[1]); w.w = cvt_pk_bf16(v1[2], v1[3]);
                    __builtin_nontemporal_store(w, (u32x4*)(rowp + bj * HALF)); }
                if (m & 1) asm volatile("" ::: "memory"); }
    }
};
__device__ __forceinline__ float silu_mul(float g, float u) { return g * __builtin_amdgcn_rcpf(1.0f + __expf(-g)) * u; }
struct EpiGU {
    static constexpr bool PERM = true, AFTER_DRAIN = false;
    bf16_t* O; int ldc; const float* ss;
    __device__ __forceinline__ void operator()(const f32x4 (&acc)[2][2][4][2], const Unit& u, int wr, int wc, int fr, int fq) const {
        const int row0 = u.pm * BM + wr * 64 + fr, col0 = u.pn * HALF + wc * 32 + 8 * fq;
        float rsv[2][4]; row_rstd8(ss, row0, fq, rsv);
#pragma unroll
        for (int ai = 0; ai < 2; ++ai)
#pragma unroll
            for (int m = 0; m < 4; ++m) { const int row = row0 + ai * HALF + m * 16; const float rs = rsv[ai][m];
                const f32x4 g0 = acc[ai][0][m][0] * rs, g1 = acc[ai][0][m][1] * rs, u0 = acc[ai][1][m][0] * rs, u1 = acc[ai][1][m][1] * rs;
                u32x4 w; w.x = cvt_pk_bf16(silu_mul(g0[0], u0[0]), silu_mul(g0[1], u0[1])); w.y = cvt_pk_bf16(silu_mul(g0[2], u0[2]), silu_mul(g0[3], u0[3]));
                w.z = cvt_pk_bf16(silu_mul(g1[0], u1[0]), silu_mul(g1[1], u1[1])); w.w = cvt_pk_bf16(silu_mul(g1[2], u1[2]), silu_mul(g1[3], u1[3]));
                __builtin_nontemporal_store(w, (u32x4*)(O + (size_t)row * ldc + col0));
                if (m & 1) asm volatile("" ::: "memory"); }
    }
};
__device__ __forceinline__ float bflo(unsigned w) { return __uint_as_float(w << 16); }
__device__ __forceinline__ float bfhi(unsigned w) { return __uint_as_float(w & 0xffff0000u); }
struct EpiRes {
    static constexpr bool PERM = true, AFTER_DRAIN = false;
    bf16_t* xb; float* ss; bf16_t* xo_;
    __device__ __forceinline__ void operator()(const f32x4 (&acc)[2][2][4][2], const Unit& u, int wr, int wc, int fr, int fq) const {
        const int row0 = u.pm * BM + wr * 64 + fr, col0 = u.pn * BM + wc * 32 + 8 * fq;
#pragma unroll
        for (int ai = 0; ai < 2; ++ai) {
            u32x4 xi[4][2];
#pragma unroll
            for (int m = 0; m < 4; ++m)
#pragma unroll
                for (int bj = 0; bj < 2; ++bj) xi[m][bj] = *(const u32x4*)(xb + (size_t)(row0 + ai * HALF + m * 16) * 1024 + col0 + bj * HALF);
#pragma unroll
            for (int m = 0; m < 4; ++m) { const int row = row0 + ai * HALF + m * 16; float s = 0.f;
#pragma unroll
                for (int bj = 0; bj < 2; ++bj) { const u32x4 xw = xi[m][bj]; const f32x4 a0 = acc[ai][bj][m][0], a1 = acc[ai][bj][m][1];
                    const float v0 = bflo(xw.x) + a0[0], v1 = bfhi(xw.x) + a0[1], v2 = bflo(xw.y) + a0[2], v3 = bfhi(xw.y) + a0[3];
                    const float v4 = bflo(xw.z) + a1[0], v5 = bfhi(xw.z) + a1[1], v6 = bflo(xw.w) + a1[2], v7 = bfhi(xw.w) + a1[3];
                    u32x4 w; w.x = cvt_pk_bf16(v0, v1); w.y = cvt_pk_bf16(v2, v3); w.z = cvt_pk_bf16(v4, v5); w.w = cvt_pk_bf16(v6, v7);
                    *(u32x4*)(xo_ + (size_t)row * 1024 + col0 + bj * HALF) = w;
                    s += ((v0 * v0 + v1 * v1) + (v2 * v2 + v3 * v3)) + ((v4 * v4 + v5 * v5) + (v6 * v6 + v7 * v7)); }
                s += __shfl_xor(s, 16); s += __shfl_xor(s, 32);
                if (fq == 0) ss[(size_t)row * 16 + u.pn * 4 + wc] = s; }
            asm volatile("" ::: "memory"); }
    }
};
template <class Epi, class Sched, bool ALIGN_EPI = false, bool SP2 = false>
__device__ __forceinline__ void gemm_phase(PG8_LAS unsigned char* lds, const Gemm g, const Sched& S, const Epi& E) {
    int tid_ = threadIdx.x; asm volatile("" : "+v"(tid_)); const int tid = tid_, wid = __builtin_amdgcn_readfirstlane(tid >> 6), lane = tid & 63, wr = wid >> 2, wc = wid & 3, fr = lane & 15, fq = lane >> 4;
    const int K = g.K, nt = K / BK;
    unsigned voffA[2], voffB[2];
#pragma unroll
    for (int i = 0; i < 2; ++i) { int R, C; stage_rc(tid * 16 + i * 8192, R, C); const int Rb = Epi::PERM ? ((R & ~31) + perm32(R & 31)) : R;
        voffA[i] = (unsigned)(R * K + C) * 2u; voffB[i] = (unsigned)(Rb * K + C) * 2u; }
    const size_t kstep = (size_t)(BK * 2);
    const size_t hstep = (size_t)HALF * K * 2;
    const size_t tstep = 2 * hstep;
    const unsigned ldsw = (unsigned)wid * 1024u;
    const int aoff = lds_byte(wr * 64 + fr, fq * 8), boff = lds_byte(wc * 32 + fr, fq * 8);
#define PG8_SA(b, h) (((b) * 2 + (h)) * HTB)
#define PG8_SB(b, h) ((4 + (b) * 2 + (h)) * HTB)
#define PG8_STAGE(bufoff, gbase, voff) do { _Pragma("unroll") for (int _i = 0; _i < 2; ++_i) \
        __builtin_amdgcn_global_load_lds((const unsigned*)((const char*)(gbase) + (voff)[_i]), (PG8_LAS unsigned*)(lds + (bufoff) + ldsw + _i * 8192), 16, 0, 0); } while (0)
#define PG8_LDA(dst, b, h) do { _Pragma("unroll") for (int m = 0; m < 4; ++m) _Pragma("unroll") for (int k = 0; k < 2; ++k) dst[m][k] = *(const PG8_LAS bf16x8*)(lds + PG8_SA(b, h) + aoff + m * 2048 + k * 1024); } while (0)
#define PG8_LDB(dst, b, h) do { _Pragma("unroll") for (int n = 0; n < 2; ++n) _Pragma("unroll") for (int k = 0; k < 2; ++k) dst[n][k] = *(const PG8_LAS bf16x8*)(lds + PG8_SB(b, h) + boff + n * 2048 + k * 1024); } while (0)
#define PG8_MMA(ai, bj, At, Bt) do { __builtin_amdgcn_s_setprio(1); _Pragma("unroll") for (int m = 0; m < 4; ++m) _Pragma("unroll") for (int n = 0; n < 2; ++n) _Pragma("unroll") for (int k = 0; k < 2; ++k) \
        acc[ai][bj][m][n] = __builtin_amdgcn_mfma_f32_16x16x32_bf16(Bt[n][k], At[m][k], acc[ai][bj][m][n], 0, 0, 0); __builtin_amdgcn_s_setprio(0); } while (0)
#define PG8_WAIT_V(n) asm volatile("s_waitcnt vmcnt(" #n ")" ::: "memory")
#define PG8_WAIT_L(n) asm volatile("s_waitcnt lgkmcnt(" #n ")" ::: "memory")
#define PG8_BAR __builtin_amdgcn_s_barrier()
#define PG8_SCHED __builtin_amdgcn_sched_barrier(0)
    Unit cur, nxt; int ui = 0;
    if (!S.next(0, cur)) return;
    f32x4 acc[2][2][4][2];
#pragma unroll
    for (int a = 0; a < 2; ++a)
#pragma unroll
        for (int b = 0; b < 2; ++b)
#pragma unroll
            for (int m = 0; m < 4; ++m)
#pragma unroll
                for (int n = 0; n < 2; ++n) acc[a][b][m][n] = (f32x4){0.f, 0.f, 0.f, 0.f};
    bf16x8 At[4][2], B0[2][2], B1[2][2];
    const char* cA = (const char*)g.A + (size_t)cur.pm * tstep; const char* cB = (const char*)g.Bt + (size_t)cur.pn * tstep;
    S.a_ready(cur);
    if constexpr (SP2) {
        PG8_STAGE(PG8_SB(0, 0), cB, voffB); PG8_STAGE(PG8_SB(0, 1), cB + hstep, voffB); PG8_STAGE(PG8_SA(0, 0), cA, voffA); PG8_STAGE(PG8_SA(0, 1), cA + hstep, voffA);
        if (wr == 1) PG8_BAR;
        PG8_WAIT_V(2); PG8_BAR;
        PG8_STAGE(PG8_SB(1, 0), cB + kstep, voffB); PG8_STAGE(PG8_SA(1, 0), cA + kstep, voffA); PG8_STAGE(PG8_SB(1, 1), cB + hstep + kstep, voffB);
        PG8_WAIT_V(6); PG8_BAR;
    } else {
        PG8_STAGE(PG8_SB(0, 0), cB, voffB); PG8_STAGE(PG8_SA(0, 0), cA, voffA); PG8_STAGE(PG8_SB(0, 1), cB + hstep, voffB); PG8_STAGE(PG8_SA(0, 1), cA + hstep, voffA);
        if (wr == 1) PG8_BAR;
        PG8_WAIT_V(4); PG8_BAR;
        PG8_STAGE(PG8_SB(1, 0), cB + kstep, voffB); PG8_STAGE(PG8_SA(1, 0), cA + kstep, voffA); PG8_STAGE(PG8_SB(1, 1), cB + hstep + kstep, voffB);
        PG8_WAIT_V(6); PG8_BAR;
    }
    for (;;) {
        const bool has_next = S.next(ui + 1, nxt);
        const char* nA = has_next ? (const char*)g.A + (size_t)nxt.pm * tstep : cA; const char* nB = has_next ? (const char*)g.Bt + (size_t)nxt.pn * tstep : cB;
        for (int t = 0; t < nt; t += 2) {
            const bool last = (t == nt - 2);
            const char* a1 = cA + (size_t)(t + 1) * kstep;
            const char* a2 = last ? nA : cA + (size_t)(t + 2) * kstep; const char* b2 = last ? nB : cB + (size_t)(t + 2) * kstep;
            const char* a3 = a2 + kstep; const char* b3 = b2 + kstep;
            if (last && has_next) S.a_ready(nxt);
            if constexpr (SP2) {
            PG8_LDB(B0, 0, 0); PG8_LDB(B1, 0, 1); PG8_SCHED; PG8_LDA(At, 0, 0); PG8_STAGE(PG8_SA(1, 1), a1 + hstep, voffA);
            PG8_WAIT_V(8); PG8_WAIT_L(0); PG8_BAR; PG8_MMA(0, 0, At, B0); PG8_MMA(0, 1, At, B1); PG8_BAR; PG8_SCHED;
            PG8_LDA(At, 0, 1); PG8_STAGE(PG8_SB(0, 0), b2, voffB); PG8_STAGE(PG8_SB(0, 1), b2 + hstep, voffB); PG8_STAGE(PG8_SA(0, 0), a2, voffA);
            PG8_WAIT_V(8); PG8_WAIT_L(0); PG8_BAR; PG8_MMA(1, 0, At, B0); PG8_MMA(1, 1, At, B1); PG8_BAR; PG8_SCHED;
            PG8_LDB(B0, 1, 0); PG8_LDB(B1, 1, 1); PG8_SCHED; PG8_LDA(At, 1, 0); PG8_STAGE(PG8_SA(0, 1), a2 + hstep, voffA);
            PG8_WAIT_V(8); PG8_WAIT_L(0); PG8_BAR; PG8_MMA(0, 0, At, B0); PG8_MMA(0, 1, At, B1); PG8_BAR; PG8_SCHED;
            PG8_LDA(At, 1, 1); PG8_STAGE(PG8_SB(1, 0), b3, voffB); PG8_STAGE(PG8_SB(1, 1), b3 + hstep, voffB); PG8_STAGE(PG8_SA(1, 0), a3, voffA);
            PG8_WAIT_V(8); PG8_WAIT_L(0); PG8_BAR; PG8_MMA(1, 0, At, B0); PG8_MMA(1, 1, At, B1); PG8_BAR; PG8_SCHED;
            } else {
            PG8_LDB(B0, 0, 0); PG8_SCHED; PG8_LDA(At, 0, 0); PG8_STAGE(PG8_SA(1, 1), a1 + hstep, voffA);
            PG8_WAIT_L(8); PG8_BAR; PG8_WAIT_L(0); PG8_MMA(0, 0, At, B0); PG8_BAR; PG8_SCHED;
            PG8_LDB(B1, 0, 1); PG8_STAGE(PG8_SB(0, 0), b2, voffB);
            PG8_BAR; PG8_WAIT_L(0); PG8_MMA(0, 1, At, B1); PG8_BAR;
            PG8_LDA(At, 0, 1); PG8_STAGE(PG8_SA(0, 0), a2, voffA);
            PG8_BAR; PG8_WAIT_L(0); PG8_MMA(1, 0, At, B0); PG8_BAR; PG8_SCHED;
            PG8_STAGE(PG8_SB(0, 1), b2 + hstep, voffB);
            PG8_WAIT_V(6); PG8_BAR; PG8_MMA(1, 1, At, B1); PG8_BAR;
            PG8_LDB(B0, 1, 0); PG8_SCHED; PG8_LDA(At, 1, 0); PG8_STAGE(PG8_SA(0, 1), a2 + hstep, voffA);
            PG8_WAIT_L(8); PG8_BAR; PG8_WAIT_L(0); PG8_MMA(0, 0, At, B0); PG8_BAR; PG8_SCHED;
            PG8_LDB(B1, 1, 1); PG8_STAGE(PG8_SB(1, 0), b3, voffB);
            PG8_BAR; PG8_WAIT_L(0); PG8_MMA(0, 1, At, B1); PG8_BAR;
            PG8_LDA(At, 1, 1); PG8_STAGE(PG8_SA(1, 0), a3, voffA);
            PG8_BAR; PG8_WAIT_L(0); PG8_MMA(1, 0, At, B0); PG8_BAR; PG8_SCHED;
            PG8_STAGE(PG8_SB(1, 1), b3 + hstep, voffB);
            PG8_WAIT_V(6); PG8_BAR; PG8_MMA(1, 1, At, B1); PG8_BAR;
            }
        }
        if constexpr (ALIGN_EPI) { if (wr == 0) PG8_BAR; }
        if constexpr (!Epi::AFTER_DRAIN) { E(acc, cur, wr, wc, fr, fq); S.done(cur); }
        if (!has_next) break;
#pragma unroll
        for (int a = 0; a < 2; ++a)
#pragma unroll
            for (int b = 0; b < 2; ++b)
#pragma unroll
                for (int m = 0; m < 4; ++m)
#pragma unroll
                    for (int n = 0; n < 2; ++n) acc[a][b][m][n] = (f32x4){0.f, 0.f, 0.f, 0.f};
        cur = nxt; cA = nA; cB = nB; ++ui;
        if constexpr (ALIGN_EPI) { if (wr == 1) PG8_BAR; }
    }
    PG8_WAIT_V(0);
    if constexpr (!ALIGN_EPI) { if (wr == 0) PG8_BAR; }
    PG8_BAR;
    if constexpr (Epi::AFTER_DRAIN) { E.fused(acc, cur, wr, wc, fr, fq, lds, wid, lane); S.done(cur); }
#undef PG8_SA
#undef PG8_SB
#undef PG8_STAGE
#undef PG8_LDA
#undef PG8_LDB
#undef PG8_MMA
#undef PG8_WAIT_V
#undef PG8_WAIT_L
#undef PG8_BAR
#undef PG8_SCHED
}
}
namespace mx {
#define LAS __attribute__((address_space(3)))
typedef unsigned short bf16_t;
typedef short bf16x8 __attribute__((ext_vector_type(8)));
typedef short s16x4 __attribute__((ext_vector_type(4)));
typedef float f32x16 __attribute__((ext_vector_type(16)));
typedef float f32x2v __attribute__((ext_vector_type(2)));
typedef float f32x4v __attribute__((ext_vector_type(4)));
typedef __bf16 bf16x2v __attribute__((ext_vector_type(2)));
typedef unsigned u32x4 __attribute__((ext_vector_type(4)));
typedef unsigned u32x2 __attribute__((ext_vector_type(2)));
typedef LAS unsigned char* ldsp;
constexpr int TP = 144, TILE_B = 64 * TP;
constexpr int LDP = 2304, SEQ = 2048, DM = 1024;
constexpr float LOG2E = 1.4426950408889634f, KSC2 = 0.125f * 1.4426950408889634f, NEG = -1e30f;
constexpr int C_QA = 0, C_KA = 512, C_VA = 576, C_QB = 640, C_KCB = 896, C_VCB = 960, C_KSB = 1024, C_VSB = 1088, C_KWB = 1152, C_VWB = 1216, C_QC = 1280, C_KC = 1536, C_VC = 1792, C_GB = 2048;

__device__ __forceinline__ unsigned pk2(float lo, float hi) { f32x2v v = {lo, hi}; bf16x2v b = __builtin_convertvector(v, bf16x2v); return __builtin_bit_cast(unsigned, b); }
__device__ __forceinline__ float ex2(float x) { return __builtin_amdgcn_exp2f(x); }
__device__ __forceinline__ float bf2f(bf16_t v) { return __uint_as_float((unsigned)v << 16); }
__device__ __forceinline__ f32x16 zero16() { f32x16 z;
#pragma unroll
    for (int i = 0; i < 16; ++i) z[i] = 0.f; return z; }

__device__ __forceinline__ u32x4 tile_ld(const bf16_t* row0, size_t pitch, int tid) { return *(const u32x4*)(row0 + (size_t)(tid >> 3) * pitch + (tid & 7) * 8); }
__device__ __forceinline__ void tile_st(ldsp tile, int tid, u32x4 v) { *(LAS u32x4*)(tile + (tid >> 3) * TP + (tid & 7) * 16) = v; }

__device__ __forceinline__ void qk_tile(ldsp Kt, const bf16x8 (&qf)[4], int lane, f32x16& p0, f32x16& p1) {
    const int rho = lane & 31, h = lane >> 5;
    const int krow = 16 * ((rho >> 2) & 1) + (rho & 3) + 4 * (rho >> 3);
    ldsp kb = Kt + krow * TP + h * 16;
    p0 = zero16(); p1 = zero16();
#pragma unroll
    for (int s = 0; s < 4; ++s) {
        const bf16x8 a0 = *(const LAS bf16x8*)(kb + s * 32);
        const bf16x8 a1 = *(const LAS bf16x8*)(kb + 32 * TP + s * 32);
        p0 = __builtin_amdgcn_mfma_f32_32x32x16_bf16(a0, qf[s], p0, 0, 0, 0);
        p1 = __builtin_amdgcn_mfma_f32_32x32x16_bf16(a1, qf[s], p1, 0, 0, 0);
    }
}
__device__ __forceinline__ s16x4 vtr(ldsp p) { return __builtin_bit_cast(s16x4, __builtin_amdgcn_ds_read_tr16_b64_v4i16((LAS s16x4*)p)); }
__device__ __forceinline__ void pv_tile(ldsp Vt, const f32x16& w0, const f32x16& w1, int lane, f32x16& o0, f32x16& o1) {
    const int i = lane & 15, g16 = lane >> 4, D0 = 16 * (g16 & 1), h = g16 >> 1;
    ldsp vb = Vt + (16 * h + (i >> 2)) * TP + (D0 + 4 * (i & 3)) * 2;
#pragma unroll
    for (int sp = 0; sp < 4; ++sp) {
        u32x4 pw;
        if (sp < 2) { const int rb = (sp & 1) * 8; pw.x = pk2(w0[rb], w0[rb + 1]); pw.y = pk2(w0[rb + 2], w0[rb + 3]); pw.z = pk2(w0[rb + 4], w0[rb + 5]); pw.w = pk2(w0[rb + 6], w0[rb + 7]); }
        else        { const int rb = (sp & 1) * 8; pw.x = pk2(w1[rb], w1[rb + 1]); pw.y = pk2(w1[rb + 2], w1[rb + 3]); pw.z = pk2(w1[rb + 4], w1[rb + 5]); pw.w = pk2(w1[rb + 6], w1[rb + 7]); }
        const bf16x8 pb = __builtin_bit_cast(bf16x8, pw);
        const int key0 = 32 * (sp >> 1) + 8 * (sp & 1);
        {   const s16x4 lo = vtr(vb + key0 * TP), hi = vtr(vb + (key0 + 4) * TP);
            const bf16x8 a = {lo[0], lo[1], lo[2], lo[3], hi[0], hi[1], hi[2], hi[3]};
            o0 = __builtin_amdgcn_mfma_f32_32x32x16_bf16(a, pb, o0, 0, 0, 0); }
        {   const s16x4 lo = vtr(vb + key0 * TP + 64), hi = vtr(vb + (key0 + 4) * TP + 64);
            const bf16x8 a = {lo[0], lo[1], lo[2], lo[3], hi[0], hi[1], hi[2], hi[3]};
            o1 = __builtin_amdgcn_mfma_f32_32x32x16_bf16(a, pb, o1, 0, 0, 0); }
    }
}
__device__ __forceinline__ void softmax_step(f32x16& p0, f32x16& p1, float& m, float& l, f32x16& o0, f32x16& o1) {
    float mx = fmaxf(p0[0], p1[0]);
#pragma unroll
    for (int r = 1; r < 16; ++r) mx = fmaxf(mx, fmaxf(p0[r], p1[r]));
    mx = fmaxf(mx, __shfl_xor(mx, 32));
    const float mn = fmaxf(m, mx), alpha = ex2(m - mn);
    float ls = 0.f;
#pragma unroll
    for (int r = 0; r < 16; ++r) { p0[r] = p0[r] > -1e29f ? ex2(p0[r] - mn) : 0.f; p1[r] = p1[r] > -1e29f ? ex2(p1[r] - mn) : 0.f; ls += p0[r] + p1[r]; }
    ls += __shfl_xor(ls, 32);
    l = l * alpha + ls; m = mn; o0 *= alpha; o1 *= alpha;
}
__device__ __forceinline__ void prep_band(f32x16& p0, f32x16& p1, int tq, int tk0, int h, float slope2, int window, bool sel) {
#pragma unroll
    for (int r = 0; r < 16; ++r) {
        const int d0 = tq - (tk0 + 16 * h + r), d1 = d0 - 32;
        p0[r] = (sel && d0 >= 0 && d0 < window) ? p0[r] * KSC2 - slope2 * (float)d0 : NEG;
        p1[r] = (sel && d1 >= 0 && d1 < window) ? p1[r] * KSC2 - slope2 * (float)d1 : NEG;
    }
}
__device__ __forceinline__ void store_o(bf16_t* dst, const f32x16& o0, const f32x16& o1, float sc, int h) {
#pragma unroll
    for (int g = 0; g < 4; ++g) {
        u32x2 a; a.x = pk2(o0[4 * g] * sc, o0[4 * g + 1] * sc); a.y = pk2(o0[4 * g + 2] * sc, o0[4 * g + 3] * sc);
        u32x2 b; b.x = pk2(o1[4 * g] * sc, o1[4 * g + 1] * sc); b.y = pk2(o1[4 * g + 2] * sc, o1[4 * g + 3] * sc);
        *(u32x2*)(dst + 8 * g + 4 * h) = a; *(u32x2*)(dst + 32 + 8 * g + 4 * h) = b;
    }
}
__device__ __forceinline__ float sumsq(const f32x16& o0, const f32x16& o1) { float s = 0.f;
#pragma unroll
    for (int r = 0; r < 16; ++r) s += o0[r] * o0[r] + o1[r] * o1[r]; return s; }

__device__ __forceinline__ void unitA(ldsp lds, const bf16_t* proj, bf16_t* mixn, const float* sinks, int b, int T, int tid) {
    const int lane = tid & 63, w = tid >> 6, c = lane & 31, h = lane >> 5, head = c & 7;
    const float slope2 = exp2f(-8.0f * (float)(head + 1) / 12.0f) * LOG2E, sink2 = sinks[head] * LOG2E;
    const bf16_t* P = proj + (size_t)b * SEQ * LDP;
    const int t0 = 64 * T;
    ldsp Kt = lds, Vt = lds + TILE_B;
#pragma unroll 1
    for (int k = 0; k < 2; ++k) {
        const int tq = t0 + 8 * w + 4 * k + (c >> 3);
        bf16x8 qf[4];
        { const bf16_t* qp = P + (size_t)tq * LDP + C_QA + head * 64 + 8 * h;
#pragma unroll
          for (int s = 0; s < 4; ++s) qf[s] = *(const bf16x8*)(qp + 16 * s); }
        float m = sink2, l = 1.0f; f32x16 o0 = zero16(), o1 = zero16();
        const int j0 = T >= 2 ? T - 2 : 0;
        u32x4 rk = tile_ld(P + (size_t)(64 * j0) * LDP + C_KA, LDP, tid), rv = tile_ld(P + (size_t)(64 * j0) * LDP + C_VA, LDP, tid);
        for (int jt = j0; jt <= T; ++jt) {
            __syncthreads();
            tile_st(Kt, tid, rk); tile_st(Vt, tid, rv);
            __syncthreads();
            if (jt < T) { rk = tile_ld(P + (size_t)(64 * (jt + 1)) * LDP + C_KA, LDP, tid); rv = tile_ld(P + (size_t)(64 * (jt + 1)) * LDP + C_VA, LDP, tid); }
            f32x16 p0, p1; qk_tile(Kt, qf, lane, p0, p1); prep_band(p0, p1, tq, 64 * jt, h, slope2, 128, true);
            softmax_step(p0, p1, m, l, o0, o1); pv_tile(Vt, p0, p1, lane, o0, o1);
        }
        const float inv = 1.0f / l; float ss = sumsq(o0, o1) * inv * inv;
        ss += __shfl_xor(ss, 32); ss += __shfl_xor(ss, 1); ss += __shfl_xor(ss, 2); ss += __shfl_xor(ss, 4);
        const float sc = inv * __builtin_amdgcn_rsqf(ss * (1.0f / 512.0f) + 1e-6f);
        store_o(mixn + (size_t)(b * SEQ + tq) * DM + head * 64, o0, o1, sc, h);
    }
}

__device__ __forceinline__ float neg_softplus(float z) { const float az = fabsf(z); return -(fmaxf(z, 0.f) + 0.6931471805599453f * __builtin_amdgcn_logf(1.0f + ex2(-az * LOG2E))); }
__device__ __forceinline__ void stick_step(f32x16& p0, f32x16& p1, int tq, int tk0, int h, float& carry) {
    float run1 = 0.f, run0 = 0.f;
#pragma unroll
    for (int r = 15; r >= 0; --r) { const bool past = (tk0 + 32 + 16 * h + r) < tq; const float z = p1[r] * 0.125f; run1 += past ? neg_softplus(z) : 0.f; p1[r] = past ? z + run1 : NEG; }
#pragma unroll
    for (int r = 15; r >= 0; --r) { const bool past = (tk0 + 16 * h + r) < tq; const float z = p0[r] * 0.125f; run0 += past ? neg_softplus(z) : 0.f; p0[r] = past ? z + run0 : NEG; }
    const float ot1 = __shfl_xor(run1, 32), ot0 = __shfl_xor(run0, 32);
    const float off1 = carry + (h == 0 ? ot1 : 0.f);
    const float off0 = carry + run1 + ot1 + (h == 0 ? ot0 : 0.f);
    carry += (run0 + ot0) + (run1 + ot1);
#pragma unroll
    for (int r = 0; r < 16; ++r) { p1[r] = p1[r] > -1e29f ? ex2((p1[r] + off1) * LOG2E) : 0.f; p0[r] = p0[r] > -1e29f ? ex2((p0[r] + off0) * LOG2E) : 0.f; }
}
constexpr int C_SS_OFF = 8 * TILE_B;
__device__ __forceinline__ void unitC(ldsp lds, const bf16_t* proj, bf16_t* mixn, int b, int T, int tid) {
    const int lane = tid & 63, w = tid >> 6, c = lane & 31, h = lane >> 5, hd = w >> 1, ql = 32 * (w & 1) + c, tq = 64 * T + ql;
    const bf16_t* P = proj + (size_t)b * SEQ * LDP;
    bf16x8 qf[4];
    { const bf16_t* qp = P + (size_t)tq * LDP + C_QC + hd * 64 + 8 * h;
#pragma unroll
      for (int s = 0; s < 4; ++s) qf[s] = *(const bf16x8*)(qp + 16 * s); }
    f32x16 o0 = zero16(), o1 = zero16(); float carry = 0.f;
    u32x4 rg[8];
#pragma unroll
    for (int i = 0; i < 8; ++i) rg[i] = tile_ld(P + (size_t)(64 * T) * LDP + (i < 4 ? C_KC + i * 64 : C_VC + (i - 4) * 64), LDP, tid);
    LAS float* CF = (LAS float*)(lds + C_SS_OFF + 1024);
    for (int jt = T; jt >= 0; --jt) {
        __syncthreads();
        if (jt < T) {
            const float mc = fmaxf(fmaxf(fmaxf(CF[0], CF[1]), fmaxf(CF[2], CF[3])), fmaxf(fmaxf(CF[4], CF[5]), fmaxf(CF[6], CF[7])));
            if (mc < -40.0f) break;
        }
#pragma unroll
        for (int i = 0; i < 8; ++i) tile_st(lds + ((i & 3) * 2 + (i >> 2)) * TILE_B, tid, rg[i]);
        __syncthreads();
        if (jt > 0) {
#pragma unroll
            for (int i = 0; i < 8; ++i) rg[i] = tile_ld(P + (size_t)(64 * (jt - 1)) * LDP + (i < 4 ? C_KC + i * 64 : C_VC + (i - 4) * 64), LDP, tid); }
        f32x16 p0, p1; qk_tile(lds + hd * 2 * TILE_B, qf, lane, p0, p1);
        stick_step(p0, p1, tq, 64 * jt, h, carry);
        { float wc = carry;
#pragma unroll
          for (int o = 1; o < 64; o <<= 1) wc = fmaxf(wc, __shfl_xor(wc, o));
          if (lane == 0) CF[w] = wc; }
        pv_tile(lds + hd * 2 * TILE_B + TILE_B, p0, p1, lane, o0, o1);
    }
    float ss = sumsq(o0, o1); ss += __shfl_xor(ss, 32);
    LAS float* SS = (LAS float*)(lds + C_SS_OFF);
    if (h == 0) SS[ql * 4 + hd] = ss;
    __syncthreads();
    const float tot = (SS[ql * 4 + 0] + SS[ql * 4 + 1]) + (SS[ql * 4 + 2] + SS[ql * 4 + 3]);
    const float sc = __builtin_amdgcn_rsqf(tot * (1.0f / 256.0f) + 1e-6f);
    store_o(mixn + (size_t)(b * SEQ + tq) * DM + 768 + hd * 64, o0, o1, sc, h);
}

template <int MODE, bool INTERIOR>
__device__ __forceinline__ void kv_range(ldsp lds, const bf16_t* Kg, const bf16_t* Vg, int jlo, int jhi, int jend, u32x4& rka, u32x4& rva, const bf16_t* qp_, int tq, float slope2, unsigned sel,
                                         int tid, int lane, int h, float& m, float& l, f32x16& o0, f32x16& o1) {
    const float qs = slope2 * (1.0f / KSC2);
    for (int jt = jlo; jt <= jhi; ++jt) {
        u32x4 rkb = rka, rvb = rva;
        if (jt + 2 <= jend) { rkb = tile_ld(Kg + (size_t)(64 * (jt + 2)) * LDP, LDP, tid); rvb = tile_ld(Vg + (size_t)(64 * (jt + 2)) * LDP, LDP, tid); }
        ldsp Kt = lds + (jt & 1) * 2 * TILE_B, Vt = Kt + TILE_B;
        const bool mine = MODE == 0 ? ((sel >> jt) & 1u) != 0u : true;
        if (MODE == 1 || __any(mine ? 1 : 0)) {
            const bf16_t* qp = qp_; asm volatile("" : "+v"(qp));
            bf16x8 qf[4];
#pragma unroll
            for (int s = 0; s < 4; ++s) qf[s] = *(const bf16x8*)(qp + 16 * s);
            f32x16 p0, p1; qk_tile(Kt, qf, lane, p0, p1);
            if (INTERIOR) {
                const float A0 = mine ? -slope2 * (float)(tq - 64 * jt - 16 * h) : NEG, A1 = mine ? A0 + 32.0f * slope2 : NEG;
                float mx0 = NEG, mx1 = NEG;
#pragma unroll
                for (int r = 0; r < 16; ++r) { p0[r] = __builtin_fmaf(qs, (float)r, p0[r]); mx0 = fmaxf(mx0, p0[r]); p1[r] = __builtin_fmaf(qs, (float)r, p1[r]); mx1 = fmaxf(mx1, p1[r]); }
                float mxv = fmaxf(__builtin_fmaf(mx0, KSC2, A0), __builtin_fmaf(mx1, KSC2, A1)); mxv = fmaxf(mxv, __shfl_xor(mxv, 32));
                const float mn = fmaxf(m, mxv), alpha = ex2(m - mn);
                const float c0 = mine ? A0 - mn : -3e38f, c1 = mine ? A1 - mn : -3e38f;
                float ls = 0.f;
#pragma unroll
                for (int r = 0; r < 16; ++r) { p0[r] = ex2(__builtin_fmaf(p0[r], KSC2, c0)); p1[r] = ex2(__builtin_fmaf(p1[r], KSC2, c1)); ls += p0[r] + p1[r]; }
                ls += __shfl_xor(ls, 32);
                l = l * alpha + ls; m = mn; o0 *= alpha; o1 *= alpha;
            } else {
                prep_band(p0, p1, tq, 64 * jt, h, slope2, MODE == 0 ? 4096 : 512, mine);
                softmax_step(p0, p1, m, l, o0, o1);
            }
            pv_tile(Vt, p0, p1, lane, o0, o1);
        }
        if (jt + 1 <= jend) { ldsp Kn = lds + ((jt + 1) & 1) * 2 * TILE_B; tile_st(Kn, tid, rka); tile_st(Kn + TILE_B, tid, rva); }
        __syncthreads();
        rka = rkb; rva = rvb;
    }
}
__device__ __forceinline__ void kv_start(ldsp lds, const bf16_t* Kg, const bf16_t* Vg, int jlo, int jend, u32x4& rka, u32x4& rva, int tid) {
    const u32x4 k0 = tile_ld(Kg + (size_t)(64 * jlo) * LDP, LDP, tid), v0 = tile_ld(Vg + (size_t)(64 * jlo) * LDP, LDP, tid);
    rka = k0; rva = v0;
    if (jlo + 1 <= jend) { rka = tile_ld(Kg + (size_t)(64 * (jlo + 1)) * LDP, LDP, tid); rva = tile_ld(Vg + (size_t)(64 * (jlo + 1)) * LDP, LDP, tid); }
    __syncthreads();
    ldsp Kt = lds + (jlo & 1) * 2 * TILE_B; tile_st(Kt, tid, k0); tile_st(Kt + TILE_B, tid, v0);
    __syncthreads();
}
constexpr int B_CK = 4 * TILE_B, B_CV = 6 * TILE_B, B_IMP = 8 * TILE_B, B_MASK = B_IMP + 16384;
constexpr int B_GL = B_MASK + 256;
__device__ __forceinline__ void unitB(ldsp lds, const bf16_t* proj, const bf16_t* kc, const bf16_t* vc, bf16_t* mixn, const bf16_t* xb, const float* ssq, const bf16_t* wg, int b, int T, int tid) {
    const int lane = tid & 63, w = tid >> 6, c = lane & 31, h = lane >> 5, hd = c & 3, qloc = c >> 2, tq = 64 * T + 8 * w + qloc;
    const float slope2 = exp2f(-8.0f * (float)(hd + 9) / 12.0f) * LOG2E;
    const bf16_t* P = proj + (size_t)b * SEQ * LDP;
    bf16x8 qf[4];
    { const bf16_t* qp = P + (size_t)tq * LDP + C_QB + hd * 64 + 8 * h;
#pragma unroll
      for (int s = 0; s < 4; ++s) qf[s] = *(const bf16x8*)(qp + 16 * s); }
    LAS float* GL = (LAS float*)(lds + B_GL); LAS float* GP = GL + 768;
    u32x4 ckr[2], cvr[2];
#pragma unroll
    for (int t = 0; t < 2; ++t) { int n = 64 * t + (tid >> 3); n = n > 126 ? 126 : n; const size_t off = ((size_t)b * 128 + n) * 64 + (tid & 7) * 8;
        ckr[t] = *(const u32x4*)(kc + off); cvr[t] = *(const u32x4*)(vc + off); }
    { const int th = w & 1, kq = w >> 1, gc = c < 12 ? c : 11;
      const bf16_t* xa = xb + ((size_t)b * SEQ + 64 * T + 32 * th + c) * DM + 256 * kq + 8 * h;
      const bf16_t* wb = wg + (size_t)gc * 1024 + 256 * kq + 8 * h;
      f32x16 ga = zero16();
#pragma unroll 8
      for (int s = 0; s < 16; ++s) { const bf16x8 xa8 = *(const bf16x8*)(xa + 16 * s), wb8 = *(const bf16x8*)(wb + 16 * s); ga = __builtin_amdgcn_mfma_f32_32x32x16_bf16(xa8, wb8, ga, 0, 0, 0); }
      if (c < 12) {
#pragma unroll
          for (int r = 0; r < 16; ++r) GP[(kq * 64 + 32 * th + (r & 3) + 8 * (r >> 2) + 4 * h) * 12 + c] = ga[r]; } }
#define B_GATE(i) (GL[(8 * w + qloc) * 12 + hd * 3 + (i)])
    f32x16 ob0 = zero16(), ob1 = zero16();
    const int ntc = T >= 16 ? 2 : 1;
    __syncthreads();
    { int t2 = tid; asm volatile("" : "+v"(t2));
#pragma unroll 1
      for (; t2 < 768; t2 += 512) { const int tk = t2 / 12; const size_t row = (size_t)b * SEQ + 64 * T + tk;
        const f32x4v* sp = (const f32x4v*)(ssq + row * 16); const f32x4v s0 = sp[0], s1 = sp[1], s2 = sp[2], s3 = sp[3];
        const float sq = ((s0[0] + s0[1]) + (s0[2] + s0[3])) + ((s1[0] + s1[1]) + (s1[2] + s1[3])) + ((s2[0] + s2[1]) + (s2[2] + s2[3])) + ((s3[0] + s3[1]) + (s3[2] + s3[3]));
        const float rs = __builtin_amdgcn_rsqf(sq * (1.0f / 1024.0f) + 1e-6f);
        const float gv = (GP[t2] + GP[768 + t2]) + (GP[1536 + t2] + GP[2304 + t2]);
        GL[t2] = 1.0f / (1.0f + __expf(-gv * rs)); } }
#pragma unroll
    for (int t = 0; t < 2; ++t) { tile_st(lds + B_CK + t * TILE_B, tid, ckr[t]); tile_st(lds + B_CV + t * TILE_B, tid, cvr[t]); }
    __syncthreads();
    unsigned sel;
    {
        f32x16 pa0, pa1, pb0, pb1;
        qk_tile(lds + B_CK, qf, lane, pa0, pa1);
        if (ntc == 2) qk_tile(lds + B_CK + TILE_B, qf, lane, pb0, pb1); else { pb0 = zero16(); pb1 = zero16(); }
        float mxv = NEG;
#pragma unroll
        for (int r = 0; r < 16; ++r) {
            const int n0 = 16 * h + r; const int d0 = tq - (16 * n0 + 31), d1 = d0 - 512, d2 = d0 - 1024, d3 = d0 - 1536;
            pa0[r] = d0 >= 0 ? pa0[r] * KSC2 - slope2 * (float)d0 : NEG; pa1[r] = d1 >= 0 ? pa1[r] * KSC2 - slope2 * (float)d1 : NEG;
            pb0[r] = d2 >= 0 ? pb0[r] * KSC2 - slope2 * (float)d2 : NEG; pb1[r] = d3 >= 0 ? pb1[r] * KSC2 - slope2 * (float)d3 : NEG;
            mxv = fmaxf(fmaxf(mxv, fmaxf(pa0[r], pa1[r])), fmaxf(pb0[r], pb1[r]));
        }
        mxv = fmaxf(mxv, __shfl_xor(mxv, 32));
        float ls = 0.f;
#pragma unroll
        for (int r = 0; r < 16; ++r) {
            pa0[r] = pa0[r] > -1e29f ? ex2(pa0[r] - mxv) : 0.f; pa1[r] = pa1[r] > -1e29f ? ex2(pa1[r] - mxv) : 0.f;
            pb0[r] = pb0[r] > -1e29f ? ex2(pb0[r] - mxv) : 0.f; pb1[r] = pb1[r] > -1e29f ? ex2(pb1[r] - mxv) : 0.f;
            ls += (pa0[r] + pa1[r]) + (pb0[r] + pb1[r]);
        }
        ls += __shfl_xor(ls, 32);
        const float inv = ls > 0.f ? 1.0f / ls : 0.f;
        f32x16 oc0 = zero16(), oc1 = zero16();
        pv_tile(lds + B_CV, pa0, pa1, lane, oc0, oc1);
        if (ntc == 2) pv_tile(lds + B_CV + TILE_B, pb0, pb1, lane, oc0, oc1);
        const float gs = B_GATE(0) * inv;
        ob0 += oc0 * gs; ob1 += oc1 * gs;
        LAS float* IA = (LAS float*)(lds + B_IMP) + w * 512 + qloc * 32;
        LAS float* IB = IA + 256;
#pragma unroll
        for (int g = 0; g < 4; ++g) {
            float a0 = (2.0f * (pa0[4 * g] + pa0[4 * g + 1] + pa0[4 * g + 2]) + pa0[4 * g + 3]) * inv, b0 = pa0[4 * g + 3] * inv;
            float a1 = (2.0f * (pa1[4 * g] + pa1[4 * g + 1] + pa1[4 * g + 2]) + pa1[4 * g + 3]) * inv, b1 = pa1[4 * g + 3] * inv;
            float a2 = (2.0f * (pb0[4 * g] + pb0[4 * g + 1] + pb0[4 * g + 2]) + pb0[4 * g + 3]) * inv, b2 = pb0[4 * g + 3] * inv;
            float a3 = (2.0f * (pb1[4 * g] + pb1[4 * g + 1] + pb1[4 * g + 2]) + pb1[4 * g + 3]) * inv, b3 = pb1[4 * g + 3] * inv;
            a0 += __shfl_xor(a0, 1); a0 += __shfl_xor(a0, 2); b0 += __shfl_xor(b0, 1); b0 += __shfl_xor(b0, 2);
            a1 += __shfl_xor(a1, 1); a1 += __shfl_xor(a1, 2); b1 += __shfl_xor(b1, 1); b1 += __shfl_xor(b1, 2);
            a2 += __shfl_xor(a2, 1); a2 += __shfl_xor(a2, 2); b2 += __shfl_xor(b2, 1); b2 += __shfl_xor(b2, 2);
            a3 += __shfl_xor(a3, 1); a3 += __shfl_xor(a3, 2); b3 += __shfl_xor(b3, 1); b3 += __shfl_xor(b3, 2);
            if (hd == 0) { const int j = 4 * h + g; IA[j] = a0; IB[j] = b0; IA[8 + j] = a1; IB[8 + j] = b1; IA[16 + j] = a2; IB[16 + j] = b2; IA[24 + j] = a3; IB[24 + j] = b3; }
        }
        asm volatile("s_waitcnt lgkmcnt(0)" ::: "memory"); __builtin_amdgcn_wave_barrier();
        LAS unsigned* MK = (LAS unsigned*)(lds + B_MASK) + w * 8;
        if (lane < 8) {
            const LAS float* SA = (const LAS float*)(lds + B_IMP) + w * 512 + lane * 32; const LAS float* SB = SA + 256;
            float iv[32];
#pragma unroll
            for (int j = 1; j < 32; ++j) iv[j] = SA[j] + SB[j - 1];
            unsigned mk = 1u | (1u << T) | (T >= 1 ? (1u << (T - 1)) : 0u);
            const int need = 8 - __popc(mk);
#pragma unroll
            for (int j = 1; j < 32; ++j) if (j > T || ((mk >> j) & 1u)) iv[j] = -1.0f;
#pragma unroll 1
            for (int it = 0; it < need; ++it) {
                int best = 0; float bv = -0.5f;
#pragma unroll
                for (int j = 1; j < 32; ++j) { const bool gt = iv[j] > bv; bv = gt ? iv[j] : bv; best = gt ? j : best; }
                if (best == 0) break;
                mk |= 1u << best;
#pragma unroll
                for (int j = 1; j < 32; ++j) iv[j] = (j == best) ? -1.0f : iv[j];
            }
            MK[lane] = mk;
        }
        asm volatile("s_waitcnt lgkmcnt(0)" ::: "memory"); __builtin_amdgcn_wave_barrier();
        sel = MK[qloc];
    }
    const bf16_t* qpB = P + (size_t)tq * LDP + C_QB + hd * 64 + 8 * h;
    { float m = NEG, l = 0.f; f32x16 o0 = zero16(), o1 = zero16();
      const bf16_t* Kg = P + C_KSB; const bf16_t* Vg = P + C_VSB; u32x4 rk, rv;
      kv_start(lds, Kg, Vg, 0, T, rk, rv, tid);
      if (T > 0) kv_range<0, true>(lds, Kg, Vg, 0, T - 1, T, rk, rv, qpB, tq, slope2, sel, tid, lane, h, m, l, o0, o1);
      kv_range<0, false>(lds, Kg, Vg, T, T, T, rk, rv, qpB, tq, slope2, sel, tid, lane, h, m, l, o0, o1);
      const float gs = B_GATE(1) / l; ob0 += o0 * gs; ob1 += o1 * gs; }
    { float m = NEG, l = 0.f; f32x16 o0 = zero16(), o1 = zero16();
      const bf16_t* Kg = P + C_KWB; const bf16_t* Vg = P + C_VWB; u32x4 rk, rv;
      const int jlo = T >= 8 ? T - 8 : 0;
      kv_start(lds, Kg, Vg, jlo, T, rk, rv, tid);
      if (T >= 8) kv_range<1, false>(lds, Kg, Vg, T - 8, T - 8, T, rk, rv, qpB, tq, slope2, 0u, tid, lane, h, m, l, o0, o1);
      if (T >= 1) kv_range<1, true>(lds, Kg, Vg, T >= 7 ? T - 7 : 0, T - 1, T, rk, rv, qpB, tq, slope2, 0u, tid, lane, h, m, l, o0, o1);
      kv_range<1, false>(lds, Kg, Vg, T, T, T, rk, rv, qpB, tq, slope2, 0u, tid, lane, h, m, l, o0, o1);
      const float gs = B_GATE(2) / l; ob0 += o0 * gs; ob1 += o1 * gs; }
    float ss = sumsq(ob0, ob1); ss += __shfl_xor(ss, 32); ss += __shfl_xor(ss, 1); ss += __shfl_xor(ss, 2);
    const float sc = __builtin_amdgcn_rsqf(ss * (1.0f / 256.0f) + 1e-6f);
    store_o(mixn + (size_t)(b * SEQ + tq) * DM + 512 + hd * 64, ob0, ob1, sc, h);
}

__device__ __forceinline__ float gelu_tanh(float x) { const float u = 0.7978845608028654f * (x + 0.044715f * x * x * x); const float e = __expf(2.0f * u); return 0.5f * x * (1.0f + (1.0f - 2.0f / (e + 1.0f))); }
__device__ __forceinline__ void unitCmp(const bf16_t* proj, const bf16_t* w1t, const bf16_t* w2t, const float* bias1, bf16_t* kc, bf16_t* vc, int b, int tid) {
    const int lane = tid & 63, w = tid >> 6, c = lane & 31, h = lane >> 5, g = w >> 1, kv = w & 1;
    const int n = 32 * g + c, nn = n > 126 ? 126 : n;
    const bf16_t* src = proj + ((size_t)b * SEQ + 16 * nn) * LDP + (kv ? C_VCB : C_KCB) + 8 * h;
    const bf16_t* wa = w1t + (size_t)kv * 128 * 2048 + (size_t)lane * 8;
    f32x16 acc[4] = {zero16(), zero16(), zero16(), zero16()};
#pragma unroll 4
    for (int s = 0; s < 128; ++s) {
        const bf16x8 bq = *(const bf16x8*)(src + (size_t)(s >> 2) * LDP + (s & 3) * 16);
#pragma unroll
        for (int fb = 0; fb < 4; ++fb) { const bf16x8 a = *(const bf16x8*)(wa + ((size_t)fb * 128 + s) * 512); acc[fb] = __builtin_amdgcn_mfma_f32_32x32x16_bf16(a, bq, acc[fb], 0, 0, 0); }
    }
    f32x16 y0 = zero16(), y1 = zero16();
    const bf16_t* w2a = w2t + ((size_t)kv * 64 + c) * 128;
#pragma unroll
    for (int fb = 0; fb < 4; ++fb) {
#pragma unroll
        for (int r = 0; r < 16; ++r) acc[fb][r] = gelu_tanh(acc[fb][r] + bias1[kv * 128 + 32 * fb + (r & 3) + 8 * (r >> 2) + 4 * h]);
#pragma unroll
        for (int s2 = 0; s2 < 2; ++s2) {
            u32x4 pw; const int rb = 8 * s2; pw.x = pk2(acc[fb][rb], acc[fb][rb + 1]); pw.y = pk2(acc[fb][rb + 2], acc[fb][rb + 3]); pw.z = pk2(acc[fb][rb + 4], acc[fb][rb + 5]); pw.w = pk2(acc[fb][rb + 6], acc[fb][rb + 7]);
            const bf16x8 hb = __builtin_bit_cast(bf16x8, pw);
            const int f0 = 32 * fb + 16 * s2 + 4 * h;
            { const u32x2 lo = *(const u32x2*)(w2a + f0), hi = *(const u32x2*)(w2a + f0 + 8); u32x4 av; av.x = lo.x; av.y = lo.y; av.z = hi.x; av.w = hi.y;
              y0 = __builtin_amdgcn_mfma_f32_32x32x16_bf16(__builtin_bit_cast(bf16x8, av), hb, y0, 0, 0, 0); }
            { const u32x2 lo = *(const u32x2*)(w2a + 32 * 128 + f0), hi = *(const u32x2*)(w2a + 32 * 128 + f0 + 8); u32x4 av; av.x = lo.x; av.y = lo.y; av.z = hi.x; av.w = hi.y;
              y1 = __builtin_amdgcn_mfma_f32_32x32x16_bf16(__builtin_bit_cast(bf16x8, av), hb, y1, 0, 0, 0); }
        }
    }
    if (n < 127) store_o((kv ? vc : kc) + ((size_t)b * 128 + n) * 64, y0, y1, 1.0f, h);
}
}
using mx::ldsp; using mx::bf16_t;
typedef float f32x4 __attribute__((ext_vector_type(4)));
typedef unsigned u32x4 __attribute__((ext_vector_type(4)));
typedef unsigned u32x2 __attribute__((ext_vector_type(2)));
constexpr int BATCH = 32, SEQ = 2048, DM = 1024, DEPTH = 4, MTOK = BATCH * SEQ, NPROJ = 2048, INW = 2060, DFF = 2816, NGU = 2 * DFF;
constexpr size_t MiB = 1u << 20;
constexpr size_t WS_BAR = 64 * 1024, WS_ZERO_BYTES = 128 * 1024;
constexpr size_t WS_CTR = 0;
constexpr size_t WS_WIN = 1 * MiB, SZ_WIN = (size_t)NPROJ * DM * 2;
constexpr size_t WS_WOUT = 19 * MiB, SZ_WOUT = (size_t)DM * DM * 2;
constexpr size_t WS_WGU = 27 * MiB, SZ_WGU = (size_t)NGU * DM * 2;
constexpr size_t WS_WDN = 71 * MiB, SZ_WDN = (size_t)DM * DFF * 2;
constexpr size_t WS_W1T = 93 * MiB, SZ_W1T = (size_t)2 * 128 * 2048 * 2;
constexpr size_t WS_W2T = 97 * MiB, SZ_W2T = (size_t)2 * 64 * 128 * 2;
constexpr size_t WS_B1 = 97 * MiB + 512 * 1024, SZ_B1 = 2 * 128 * 4;
constexpr size_t WS_WG = 97 * MiB + 768 * 1024, SZ_WG = 32 * 1024;
constexpr size_t WS_KC = 98 * MiB, WS_VC = 98 * MiB + 512 * 1024;
constexpr size_t WS_SS = 100 * MiB;
constexpr size_t WS_XB = 104 * MiB;
constexpr size_t WS_PROJ = 232 * MiB;
constexpr size_t WS_MIXN = 520 * MiB;
constexpr size_t WS_HID = 232 * MiB;
constexpr size_t WS_END = 648 * MiB;
static_assert(WS_WIN + 4 * SZ_WIN <= WS_WOUT && WS_WOUT + 4 * SZ_WOUT <= WS_WGU && WS_WGU + 4 * SZ_WGU <= WS_WDN && WS_WDN + 4 * SZ_WDN <= WS_W1T && WS_W1T + 4 * SZ_W1T <= WS_W2T, "ws map");
static_assert(WS_HID + (size_t)MTOK * DFF * 2 <= WS_END && WS_PROJ + (size_t)MTOK * mx::LDP * 2 <= WS_MIXN && WS_XB + (size_t)MTOK * DM * 2 <= WS_PROJ, "ws map 2");
constexpr int LDS_BYTES = 143360, LDS_CTL = 131072;
constexpr int NPHASE = 2 + 6 * DEPTH;

#define RLX_AGENT __ATOMIC_RELAXED, __HIP_MEMORY_SCOPE_AGENT
#define XB_TMO      128
#define XB_XCNT(j)  (256  + 64 * (j))
#define XB_XSUB(j)  (1280 + 64 * (j))
#define XB_XGEN(j)  (2304 + 64 * (j))
#define XB_TOP      3328
#define XB_TOPGEN   3392
#define XCD_BAR_WORDS 3456
#define XB_SPIN_CAP (1u << 18)

__device__ __forceinline__ unsigned xb_ld(unsigned* p)              { return __hip_atomic_load(p, __ATOMIC_RELAXED, __HIP_MEMORY_SCOPE_AGENT); }
__device__ __forceinline__ unsigned xb_add(unsigned* p, unsigned v) { return __hip_atomic_fetch_add(p, v, __ATOMIC_RELAXED, __HIP_MEMORY_SCOPE_AGENT); }
__device__ __forceinline__ unsigned xb_xcc_id() { return (unsigned)__builtin_amdgcn_s_getreg((3 << 11) | 20) & 0xFu; }
#define XB_SPIN(cond, bar) do { unsigned _sp = 0; while (cond) { __builtin_amdgcn_s_sleep(1); \
    if ((++_sp & 255u) == 0u) { if (xb_ld(&(bar)[XB_TMO])) break; if (_sp > XB_SPIN_CAP) { atomicAdd(&(bar)[XB_TMO], 1u); break; } } } } while (0)

struct XcdBarrier {
    unsigned* bar; unsigned x;
    volatile LAS unsigned* st;
};

__device__ __forceinline__ XcdBarrier xcd_barrier_post(unsigned* bar, volatile LAS unsigned* st) {
    XcdBarrier b; b.bar = bar; b.x = xb_xcc_id(); b.st = st;
    if (threadIdx.x == 0) (void)xb_add(&bar[XB_XCNT(b.x)], 1u);
    return b;
}
__device__ __forceinline__ void xcd_barrier_complete(unsigned* bar, unsigned x, unsigned& nloc, unsigned& nx) {
    const unsigned G = gridDim.x * gridDim.y * gridDim.z;
    unsigned sum, cnt, mine, sp = 0u;
    for (;;) {
        sum = 0u; cnt = 0u; mine = 0u;
#pragma unroll
        for (unsigned j = 0; j < 16; ++j) { const unsigned c = xb_ld(&bar[XB_XCNT(j)]); sum += c; cnt += (c > 0u) ? 1u : 0u; mine = (j == x) ? c : mine; }
        if (sum == G) break;
        __builtin_amdgcn_s_sleep(1);
        if ((++sp & 255u) == 0u) { if (xb_ld(&bar[XB_TMO])) break; if (sp > XB_SPIN_CAP) { atomicAdd(&bar[XB_TMO], 1u); break; } }
    }
    nloc = mine > 0u ? mine : 1u; nx = cnt > 0u ? cnt : 1u;
}

__device__ __forceinline__ void xcd_barrier(const XcdBarrier& b) {
    asm volatile("s_waitcnt vmcnt(0)" ::: "memory");
    __syncthreads();
    if (threadIdx.x == 0) {
        unsigned* bar = b.bar;
        __builtin_amdgcn_s_waitcnt(0);
        unsigned nloc = b.st[0], nx = b.st[1];
        if (nloc == 0u) { xcd_barrier_complete(bar, b.x, nloc, nx); b.st[0] = nloc; b.st[1] = nx; }
        const unsigned old = xb_add(&bar[XB_XSUB(b.x)], 1u);
        const unsigned gen = old / nloc;
        if (old + 1u == (gen + 1u) * nloc) {
            __builtin_amdgcn_fence(__ATOMIC_RELEASE, "agent");
            asm volatile("s_waitcnt vmcnt(0)" ::: "memory");
            const unsigned og = xb_add(&bar[XB_TOP], 1u);
            const unsigned tg = og / nx;
            if (og + 1u == (tg + 1u) * nx) xb_add(&bar[XB_TOPGEN], 1u);
            else XB_SPIN(xb_ld(&bar[XB_TOPGEN]) == tg, bar);
            __builtin_amdgcn_fence(__ATOMIC_ACQUIRE, "agent");
            xb_add(&bar[XB_XGEN(b.x)], 1u);
            asm volatile("s_waitcnt vmcnt(0)" ::: "memory");
        } else {
            XB_SPIN(xb_ld(&bar[XB_XGEN(b.x)]) == gen, bar);
            __builtin_amdgcn_fence(__ATOMIC_ACQUIRE, "agent");
            asm volatile("s_waitcnt vmcnt(0)" ::: "memory");
        }
    }
    __syncthreads();
}

struct Params { const float* in[16]; float* out; unsigned char* ws; int ph_lo, ph_hi; };

__device__ __forceinline__ float wave_sum(float v) {
#pragma unroll
    for (int o = 1; o < 64; o <<= 1) v += __shfl_xor(v, o);
    return v;
}
template <class RowMap>
__device__ __forceinline__ void transpose_item(const float* W, int K, int N, const float* gk0  , bf16_t* WT, RowMap rm, LAS float* scr, int kb, int nb, int lane) {
    const int k0 = 64 * kb, n0 = 32 * nb, nl = n0 + (lane & 31);
#pragma unroll 4
    for (int i = 0; i < 32; ++i) { const int kk = 2 * i + (lane >> 5); float v = nl < N ? W[(size_t)(k0 + kk) * N + nl] : 0.f; if (gk0) v *= gk0[kk]; scr[kk * 33 + (lane & 31)] = v; }
    asm volatile("s_waitcnt lgkmcnt(0)" ::: "memory"); __builtin_amdgcn_wave_barrier();
    const int c = lane & 7;
#pragma unroll
    for (int j = 0; j < 4; ++j) { const int n = (lane >> 3) + 8 * j; const LAS float* s = scr + (8 * c) * 33 + n;
        u32x4 o; o.x = mx::pk2(s[0 * 33], s[1 * 33]); o.y = mx::pk2(s[2 * 33], s[3 * 33]); o.z = mx::pk2(s[4 * 33], s[5 * 33]); o.w = mx::pk2(s[6 * 33], s[7 * 33]);
        if (n0 + n < N) *(u32x4*)(WT + rm(n0 + n, k0 + 8 * c)) = o; }
    asm volatile("s_waitcnt lgkmcnt(0)" ::: "memory"); __builtin_amdgcn_wave_barrier();
}
struct RmId { int K; __device__ size_t operator()(int n, int k) const { return (size_t)n * K + k; } };
struct RmW1 { __device__ size_t operator()(int f, int k) const { return ((size_t)((f >> 5) * 128 + (k >> 4)) * 64 + (((k >> 3) & 1) * 32 + (f & 31))) * 8; } };
struct RmIn { size_t gdelta; __device__ size_t operator()(int n, int k) const { return n < 1280 ? (size_t)n * 1024 + k : (n < 1292 ? gdelta + (size_t)(n - 1280) * 1024 + k : (size_t)(n - 12) * 1024 + k); } };
struct RmGU { int up; __device__ size_t operator()(int n, int k) const { return (size_t)(256 * (n >> 7) + 128 * up + (n & 127)) * 1024 + k; } };

constexpr int I_IN = 16 * 65, I_OUT = 16 * 32, I_G = 16 * 88, I_DN = 44 * 32, I_W1 = 2 * 32 * 4, I_W2 = 2 * 2 * 2;
constexpr int I_LAYER = I_IN + I_OUT + 2 * I_G + I_DN + I_W1 + I_W2, CONV_UNITS = (I_LAYER + 7) / 8;
__device__ __forceinline__ void convert_item(const Params& p, int L, int r, LAS float* scr, int lane) {
    unsigned char* ws = p.ws;
    const float *w_in = p.in[1], *w_out = p.in[2], *g_attn = p.in[3], *g_ffn = p.in[4], *g_oa = p.in[5], *g_ob = p.in[6], *g_oc = p.in[7];
    const float *cmp_w1 = p.in[10], *cmp_w2 = p.in[11], *w_gate = p.in[12], *w_up = p.in[13], *w_down = p.in[14];
    if (r < I_IN) { const int kb = r / 65, nb = r % 65; transpose_item(w_in + (size_t)L * DM * INW, DM, INW, g_attn + L * DM + 64 * kb, (bf16_t*)(ws + WS_WIN + L * SZ_WIN), RmIn{((WS_WG + L * SZ_WG) - (WS_WIN + L * SZ_WIN)) / 2}, scr, kb, nb, lane); return; } r -= I_IN;
    if (r < I_OUT) { const int kb = r / 32, nb = r % 32, k0 = 64 * kb;
        const float* g = k0 < 512 ? g_oa + L * 512 + k0 : (k0 < 768 ? g_ob + L * 256 + (k0 - 512) : g_oc + L * 256 + (k0 - 768));
        transpose_item(w_out + (size_t)L * DM * DM, DM, DM, g, (bf16_t*)(ws + WS_WOUT + L * SZ_WOUT), RmId{DM}, scr, kb, nb, lane); return; } r -= I_OUT;
    if (r < I_G) { const int kb = r / 88, nb = r % 88; transpose_item(w_gate + (size_t)L * DM * DFF, DM, DFF, g_ffn + L * DM + 64 * kb, (bf16_t*)(ws + WS_WGU + L * SZ_WGU), RmGU{0}, scr, kb, nb, lane); return; } r -= I_G;
    if (r < I_G) { const int kb = r / 88, nb = r % 88; transpose_item(w_up + (size_t)L * DM * DFF, DM, DFF, g_ffn + L * DM + 64 * kb, (bf16_t*)(ws + WS_WGU + L * SZ_WGU), RmGU{1}, scr, kb, nb, lane); return; } r -= I_G;
    if (r < I_DN) { const int kb = r / 32, nb = r % 32; transpose_item(w_down + (size_t)L * DFF * DM, DFF, DM, nullptr, (bf16_t*)(ws + WS_WDN + L * SZ_WDN), RmId{DFF}, scr, kb, nb, lane); return; } r -= I_DN;
    if (r < I_W1) { const int kv = r / 128, r2 = r % 128, kb = r2 / 4, nb = r2 % 4;
        transpose_item(cmp_w1 + ((size_t)L * 2 + kv) * 2048 * 128, 2048, 128, nullptr, (bf16_t*)(ws + WS_W1T + L * SZ_W1T) + (size_t)kv * 128 * 2048, RmW1(), scr, kb, nb, lane); return; } r -= I_W1;
    { const int kv = r / 4, r2 = r % 4, kb = r2 / 2, nb = r2 % 2;
        transpose_item(cmp_w2 + ((size_t)L * 2 + kv) * 128 * 64, 128, 64, nullptr, (bf16_t*)(ws + WS_W2T + L * SZ_W2T) + (size_t)kv * 64 * 128, RmId{128}, scr, kb, nb, lane); }
}
__device__ __forceinline__ void prologue(const Params& p, ldsp lds, int tid) {
    const int lane = tid & 63, wave = tid >> 6, gw = blockIdx.x * 8 + wave, NGW = gridDim.x * 8;
    LAS float* scr = (LAS float*)(lds + wave * 16384);
    unsigned char* ws = p.ws;
    const float *cmp_pos = p.in[9], *cmp_w1 = p.in[10];
#ifdef CONV_IN_P0
    for (int it = gw; it < DEPTH * I_LAYER; it += NGW) convert_item(p, it / I_LAYER, it % I_LAYER, scr, lane);
#else
    for (int it = gw; it < I_LAYER; it += NGW) convert_item(p, 0, it, scr, lane);
#endif
    { const int gt = blockIdx.x * 512 + tid;
      if (gt < DEPTH * 256) { const int L = gt / 256, kv = (gt >> 7) & 1, f = gt & 127; const float* pos = cmp_pos + ((size_t)L * 2 + kv) * 2048; const float* w1 = cmp_w1 + ((size_t)L * 2 + kv) * 2048 * 128 + f;
          float s = 0.f; for (int k = 0; k < 2048; ++k) s += pos[k] * w1[(size_t)k * 128];
          ((float*)(ws + WS_B1 + L * SZ_B1))[kv * 128 + f] = s; } }
    { const float* x = p.in[0]; bf16_t* xb = (bf16_t*)(ws + WS_XB); float* ss = (float*)(ws + WS_SS);
      for (int row0 = 2 * gw; row0 < MTOK; row0 += 2 * NGW) { f32x4 v[2][4];
#pragma unroll
          for (int q = 0; q < 2; ++q)
#pragma unroll
              for (int j = 0; j < 2; ++j) { const float* xr = x + (size_t)(row0 + q) * DM + 512 * j + 8 * lane; v[q][2 * j] = *(const f32x4*)xr; v[q][2 * j + 1] = *(const f32x4*)(xr + 4); }
#pragma unroll
          for (int q = 0; q < 2; ++q) { float s = 0.f;
#pragma unroll
              for (int j = 0; j < 2; ++j) { const f32x4 a = v[q][2 * j], b = v[q][2 * j + 1];
                  s += ((a[0] * a[0] + a[1] * a[1]) + (a[2] * a[2] + a[3] * a[3])) + ((b[0] * b[0] + b[1] * b[1]) + (b[2] * b[2] + b[3] * b[3]));
                  u32x4 o; o.x = mx::pk2(a[0], a[1]); o.y = mx::pk2(a[2], a[3]); o.z = mx::pk2(b[0], b[1]); o.w = mx::pk2(b[2], b[3]);
                  *(u32x4*)(xb + (size_t)(row0 + q) * DM + 512 * j + 8 * lane) = o; }
              s = wave_sum(s);
              if (lane < 16) ss[(size_t)(row0 + q) * 16 + lane] = lane == 0 ? s : 0.f; } } }
}
__device__ __forceinline__ void final_norm(const Params& p, int tid) {
    const int lane = tid & 63, wave = tid >> 6, gw = blockIdx.x * 8 + wave, NGW = gridDim.x * 8;
    const float* ss = (const float*)(p.ws + WS_SS); const float* g = p.in[15]; float* out = p.out; const bf16_t* xb = (const bf16_t*)(p.ws + WS_XB);
    f32x4 gv[4];
#pragma unroll
    for (int j = 0; j < 2; ++j) { gv[2 * j] = *(const f32x4*)(g + 512 * j + 8 * lane); gv[2 * j + 1] = *(const f32x4*)(g + 512 * j + 8 * lane + 4); }
    for (int row0 = 2 * gw; row0 < MTOK; row0 += 2 * NGW) {
        float s[2]; u32x4 w[2][2];
#pragma unroll
        for (int q = 0; q < 2; ++q) { const int row = row0 + q; s[q] = lane < 16 ? ss[(size_t)row * 16 + lane] : 0.f;
#pragma unroll
            for (int j = 0; j < 2; ++j) w[q][j] = *(const u32x4*)(xb + (size_t)row * DM + 512 * j + 8 * lane); }
#pragma unroll
        for (int q = 0; q < 2; ++q) { const int row = row0 + q; const float rs = 1.0f / sqrtf(wave_sum(s[q]) * (1.0f / 1024.0f) + 1e-6f);
#pragma unroll
            for (int j = 0; j < 2; ++j) { const u32x4 ww = w[q][j]; float* o = out + (size_t)row * DM + 512 * j + 8 * lane;
                f32x4 a, b; a[0] = __uint_as_float(ww.x << 16); a[1] = __uint_as_float(ww.x & 0xffff0000u); a[2] = __uint_as_float(ww.y << 16); a[3] = __uint_as_float(ww.y & 0xffff0000u);
                b[0] = __uint_as_float(ww.z << 16); b[1] = __uint_as_float(ww.z & 0xffff0000u); b[2] = __uint_as_float(ww.w << 16); b[3] = __uint_as_float(ww.w & 0xffff0000u);
                *(f32x4*)o = a * rs * gv[2 * j]; *(f32x4*)(o + 4) = b * rs * gv[2 * j + 1]; } }
    }
}
__device__ __forceinline__ int q_next(unsigned* ctr, LAS unsigned* slot, int tid) {
    __syncthreads();
    if (tid == 0) *slot = atomicAdd(ctr, 1u);
    __syncthreads();
    return __builtin_amdgcn_readfirstlane((int)*slot);
}

__global__ void __launch_bounds__(512, 2) mk_fwd(Params p) {
    extern __shared__ __attribute__((aligned(16))) unsigned char lds_raw[];
    ldsp lds = (ldsp)lds_raw;
    cg::grid_group grid = cg::this_grid();
    const int lo = p.ph_lo, hi = p.ph_hi;
#define OPAQUE_TID() int tid = threadIdx.x; asm volatile("" : "+v"(tid))
    unsigned char* ws = p.ws;
    LAS unsigned* slot = (LAS unsigned*)(lds + LDS_CTL);
    bf16_t* XB = (bf16_t*)(ws + WS_XB); bf16_t* PROJ = (bf16_t*)(ws + WS_PROJ); bf16_t* MIXN = (bf16_t*)(ws + WS_MIXN); bf16_t* HID = (bf16_t*)(ws + WS_HID);
    bf16_t* KC = (bf16_t*)(ws + WS_KC); bf16_t* VC = (bf16_t*)(ws + WS_VC); float* SS = (float*)(ws + WS_SS);
    if (threadIdx.x < 8) slot[4 + threadIdx.x] = 0u;
    __syncthreads();
    const XcdBarrier xbar = xcd_barrier_post((unsigned*)(ws + WS_BAR), (volatile LAS unsigned*)(slot + 4));
    int ph = 0;
#ifdef TIMING_PROBE
    unsigned long long tp0 = __builtin_amdgcn_s_memrealtime(), tcat[4] = {0ull, 0ull, 0ull, 0ull};
#define TCAT(c) do { const unsigned long long tn = __builtin_amdgcn_s_memrealtime(); tcat[c] += tn - tp0; tp0 = tn; } while (0)
#else
#define TCAT(c) do {} while (0)
#endif
#ifndef REP_FINAL
#define REP_FINAL 1
#endif
#ifndef REP_RES
#define REP_RES 1
#endif
#ifndef REP_P0
#define REP_P0 1
#endif
#ifndef REP_P2
#define REP_P2 1
#endif
#ifndef REP_P3
#define REP_P3 1
#endif
#ifndef REP_GEMM
#define REP_GEMM 1
#endif
#ifndef REP_SYNC
#define REP_SYNC 1
#endif
#define RUN() (lo <= ph && ph < hi)
#define SEAM(c) do { TCAT(c); if (RUN() && ph + 1 < hi) { for (int rs_ = 0; rs_ < REP_SYNC; ++rs_) { if (lo < 0) grid.sync(); else xcd_barrier(xbar); }     } TCAT(2); ++ph; } while (0)
    #ifndef SKIP_P0
    if (RUN()) for (int rep_ = 0; rep_ < REP_P0; ++rep_) { if (rep_) xcd_barrier(xbar); OPAQUE_TID(); prologue(p, lds, tid); }
#endif
    SEAM(3);
    for (int L = 0; L < DEPTH; ++L) {
#ifndef SKIP_G1
        if (RUN()) for (int rep_ = 0; rep_ < REP_GEMM; ++rep_) { if (rep_) xcd_barrier(xbar); pg8::Gemm g{XB, (const bf16_t*)(ws + WS_WIN + L * SZ_WIN), MTOK, NPROJ, DM}; pg8::StaticOrder S; S.init(MTOK, NPROJ, (int)gridDim.x, (int)blockIdx.x);
            pg8::EpiProj E{PROJ, mx::LDP, SS};
            pg8::gemm_phase<pg8::EpiProj, pg8::StaticOrder, true, true>((PG8_LAS unsigned char*)lds, g, S, E); }
#endif
        SEAM(0);
#ifndef SKIP_P2
        if (RUN()) for (int rep_ = 0; rep_ < REP_P2; ++rep_) { if (rep_) xcd_barrier(xbar); OPAQUE_TID(); unsigned* ctr = (unsigned*)(ws + WS_CTR) + 64 * (ph + 32 * rep_);
            int u = q_next(ctr, slot, tid);
#ifdef CONV_IN_P0
            const int nq = 32 + 2048;
#else
            const int nq = 32 + 2048 + (L + 1 < DEPTH ? CONV_UNITS : 0);
#endif
            while (u < nq) {
                if (u < 32) {
#ifndef SKIP_CMP
 mx::unitCmp(PROJ, (const bf16_t*)(ws + WS_W1T + L * SZ_W1T), (const bf16_t*)(ws + WS_W2T + L * SZ_W2T), (const float*)(ws + WS_B1 + L * SZ_B1), KC, VC, u, tid);
#endif
 }
                else if (u < 32 + 1024) {
#ifndef SKIP_C
 const int k = u - 32; mx::unitC(lds, PROJ, MIXN, k & 31, 31 - (k >> 5), tid);
#endif
 }
#ifndef CONV_IN_P0
                else if (u >= 32 + 2048) { const int it = (u - 32 - 2048) * 8 + (tid >> 6); if (it < I_LAYER) convert_item(p, L + 1, it, (LAS float*)(lds + (tid >> 6) * 16384), tid & 63); }
#endif
                else {
#ifndef SKIP_A
 const int k = u - 32 - 1024; mx::unitA(lds, PROJ, MIXN, p.in[8] + L * 8, k & 31, 31 - (k >> 5), tid);
#endif
 }
                u = q_next(ctr, slot, tid); } }
#endif
        SEAM(1);
#ifndef SKIP_P3
        if (RUN()) { OPAQUE_TID(); unsigned* qbase = (unsigned*)(ws + WS_CTR) + 64 * (32 + 8 * L);
            int qi = (int)(xbar.x & 7u), qleft = 8;
            int u = q_next(qbase + 64 * qi, slot, tid);
            for (;;) {
                while (u >= 128 && --qleft > 0) { qi = (qi + 1) & 7; u = q_next(qbase + 64 * qi, slot, tid); }
                if (u >= 128) break;
                unsigned nxt_ = 0u; if (tid == 0) nxt_ = atomicAdd(qbase + 64 * qi, 1u);
                mx::unitB(lds, PROJ, KC, VC, MIXN, XB, SS, (const bf16_t*)(ws + WS_WG + L * SZ_WG), 4 * qi + (u & 3), 31 - (u >> 2), tid);
                __syncthreads(); if (tid == 0) *slot = nxt_; __syncthreads(); u = __builtin_amdgcn_readfirstlane((int)*slot); } }
#endif
        SEAM(1);
#ifndef SKIP_G4
        if (RUN()) for (int rep_ = 0; rep_ < REP_RES; ++rep_) { if (rep_) xcd_barrier(xbar); pg8::Gemm g{MIXN, (const bf16_t*)(ws + WS_WOUT + L * SZ_WOUT), MTOK, DM, DM}; pg8::StaticOrder S; S.init(MTOK, DM, (int)gridDim.x, (int)blockIdx.x);
            pg8::EpiRes E{XB, rep_ + 1 < REP_RES ? (float*)(ws + WS_END + 256 * MiB) : SS, rep_ + 1 < REP_RES ? (bf16_t*)(ws + WS_END) : XB};
            pg8::gemm_phase<pg8::EpiRes, pg8::StaticOrder, true, true>((PG8_LAS unsigned char*)lds, g, S, E); }
#endif
        SEAM(0);
#ifndef SKIP_G5
        if (RUN()) for (int rep_ = 0; rep_ < REP_GEMM; ++rep_) { if (rep_) xcd_barrier(xbar); pg8::Gemm g{XB, (const bf16_t*)(ws + WS_WGU + L * SZ_WGU), MTOK, NGU, DM}; pg8::StaticOrder S; S.init(MTOK, NGU, (int)gridDim.x, (int)blockIdx.x);
            pg8::EpiGU E{HID, DFF, SS};
            pg8::gemm_phase<pg8::EpiGU, pg8::StaticOrder, true, true>((PG8_LAS unsigned char*)lds, g, S, E); }
#endif
        SEAM(0);
#ifndef SKIP_G6
        if (RUN()) for (int rep_ = 0; rep_ < REP_RES; ++rep_) { if (rep_) xcd_barrier(xbar); pg8::Gemm g{HID, (const bf16_t*)(ws + WS_WDN + L * SZ_WDN), MTOK, DM, DFF}; pg8::StaticOrder S; S.init(MTOK, DM, (int)gridDim.x, (int)blockIdx.x);
            pg8::EpiRes E{XB, rep_ + 1 < REP_RES ? (float*)(ws + WS_END + 256 * MiB) : SS, rep_ + 1 < REP_RES ? (bf16_t*)(ws + WS_END) : XB};
            pg8::gemm_phase<pg8::EpiRes, pg8::StaticOrder, true, true>((PG8_LAS unsigned char*)lds, g, S, E); }
#endif
        SEAM(0);
    }
    if (RUN()) for (int rep_ = 0; rep_ < REP_FINAL; ++rep_) { OPAQUE_TID(); final_norm(p, tid); }
#ifdef TIMING_PROBE
    TCAT(3);
    grid.sync();
    if (blockIdx.x == 0 && threadIdx.x == 0) {
        const float va = (float)(tcat[TIMING_PROBE / 10] / 100ull), vb = (float)(tcat[TIMING_PROBE % 10] / 100ull);
        asm volatile("s_waitcnt vmcnt(0)" ::: "memory");
        p.out[0] = va; for (int i = 0; i < 10000; ++i) p.out[2048 + i] = vb;
    }
#endif
#undef RUN
#undef SEAM
}

#ifndef MK_PER_PHASE
#define MK_PER_PHASE 0
#endif
extern "C" void kernel_launch(void* const* d_in, const int* in_sizes, int n_in, void* d_out, int out_size, void* d_ws, size_t ws_size, hipStream_t stream) {
    static int grid = 0;
    if (grid == 0) {
        if (n_in != 16 || out_size != MTOK * DM || ws_size < WS_END) { fprintf(stderr, "kernel_launch: unexpected shapes (n_in %d, out %d, ws %zu)\n", n_in, out_size, ws_size); grid = -1; return; }
        int dev = 0, cus = 0, per_cu = 0;
        hipGetDevice(&dev); hipDeviceGetAttribute(&cus, hipDeviceAttributeMultiprocessorCount, dev);
        if (hipFuncSetAttribute((const void*)mk_fwd, hipFuncAttributeMaxDynamicSharedMemorySize, LDS_BYTES) != hipSuccess) { fprintf(stderr, "kernel_launch: hipFuncSetAttribute failed\n"); grid = -1; return; }
        if (hipOccupancyMaxActiveBlocksPerMultiprocessor(&per_cu, (const void*)mk_fwd, 512, LDS_BYTES) != hipSuccess || per_cu < 1) { fprintf(stderr, "kernel_launch: occupancy query says %d\n", per_cu); per_cu = 1; }
        (void)hipGetLastError();
        grid = cus;
    }
    if (grid < 0) return;
    if (hipMemsetAsync(d_ws, 0, WS_ZERO_BYTES, stream) != hipSuccess) { fprintf(stderr, "kernel_launch: memset failed\n"); return; }
    Params p{};
    for (int i = 0; i < 16; ++i) p.in[i] = (const float*)d_in[i];
    p.out = (float*)d_out; p.ws = (unsigned char*)d_ws;
#if MK_PER_PHASE
    for (int ph = 0; ph < NPHASE; ++ph) { p.ph_lo = ph; p.ph_hi = ph + 1; hipLaunchKernelGGL(mk_fwd, dim3(grid), dim3(512), LDS_BYTES, stream, p); }
#else
    p.ph_lo = 0; p.ph_hi = NPHASE;
    void* args[] = {&p};
    hipError_t e = hipLaunchCooperativeKernel((const void*)mk_fwd, dim3(grid), dim3(512), args, LDS_BYTES, stream);
    if (e != hipSuccess) fprintf(stderr, "kernel_launch: cooperative launch failed: %s (grid %d)\n", hipGetErrorString(e), grid);
#endif
}
```

```cpp
#include <hip/hip_runtime.h>
#include <hip/hip_cooperative_groups.h>
#include <cstdio>
#include <cstdint>
namespace cg = cooperative_groups;
namespace pg8 {
#define PG8_LAS __attribute__((address_space(3)))
typedef unsigned short bf16_t;
typedef short bf16x8 __attribute__((ext_vector_type(8)));
typedef float f32x4 __attribute__((ext_vector_type(4)));
typedef unsigned u32x4 __attribute__((ext_vector_type(4)));
constexpr int BM = 256, BK = 64, HALF = 128, HTB = HALF * BK * 2  , STAGE_BYTES = 8 * HTB, NXCD = 8, WGM = 8;

__host__ __device__ __forceinline__ int lds_byte(int r, int c) { const int st = (r >> 4) * 2 + (c >> 5), rr = r & 15, cc = c & 31, ob = rr * 64 + cc * 2; return st * 1024 + (ob ^ (((ob >> 9) & 1) << 5)); }
__host__ __device__ __forceinline__ void stage_rc(int b, int& R, int& C) { const int st = b / 1024, sb = b % 1024, swz = sb ^ (((sb >> 9) & 1) << 5); R = (st >> 1) * 16 + swz / 64; C = (st & 1) * 32 + (swz % 64) / 2; }
__host__ __device__ __forceinline__ int perm32(int rho) { const int n = rho >> 4, i = rho & 15; return 8 * (i >> 2) + 4 * n + (i & 3); }

struct Unit { int pm, pn; };
struct Gemm { const bf16_t* A; const bf16_t* Bt; int M, N, K; };

struct StaticOrder {
    int nM, nN, nwg, G, c;
    __host__ __device__ void init(int M, int N, int G_, int c_) { nM = M / BM; nN = N / BM; nwg = nM * nN; G = G_; c = c_; }
    __host__ __device__ bool next(int i, Unit& u) const {
        const long L = (long)i * G + c; if (L >= nwg) return false;
        int wgid = (int)L; { const int q = nwg / NXCD, r = nwg % NXCD, xcd = wgid % NXCD, off = wgid / NXCD; wgid = (xcd < r ? xcd * (q + 1) : r * (q + 1) + (xcd - r) * q) + off; }
        const int nig = WGM * nN, gid = wgid / nig, fm = gid * WGM, gsz = (nM - fm) < WGM ? (nM - fm) : WGM;
        u.pm = fm + ((wgid % nig) % gsz); u.pn = (wgid % nig) / gsz; return true;
    }
    __device__ __forceinline__ void a_ready(const Unit&) const {}
    __device__ __forceinline__ void done(const Unit&) const {}
};

__device__ __forceinline__ unsigned cvt_pk_bf16(float lo, float hi) { unsigned r; asm volatile("v_cvt_pk_bf16_f32 %0, %1, %2" : "=v"(r) : "v"(lo), "v"(hi)); return r; }
typedef float f32x2 __attribute__((ext_vector_type(2)));
typedef unsigned u32x2 __attribute__((ext_vector_type(2)));
__device__ __forceinline__ float row_rstd(const float* ss, int row, int fq) {
    const f32x4 v = *(const f32x4*)(ss + (size_t)row * 16 + 4 * fq);
    float s = (v[0] + v[1]) + (v[2] + v[3]);
    s += __shfl_xor(s, 16); s += __shfl_xor(s, 32);
    return __builtin_amdgcn_rsqf(s * (1.0f / 1024.0f) + 1e-6f);
}
__device__ __forceinline__ void row_rstd8(const float* ss, int row0, int fq, float (&rs)[2][4]) {
    f32x4 v[2][4];
#pragma unroll
    for (int ai = 0; ai < 2; ++ai)
#pragma unroll
        for (int m = 0; m < 4; ++m) v[ai][m] = *(const f32x4*)(ss + (size_t)(row0 + ai * HALF + m * 16) * 16 + 4 * fq);
#pragma unroll
    for (int ai = 0; ai < 2; ++ai)
#pragma unroll
        for (int m = 0; m < 4; ++m) { float s = (v[ai][m][0] + v[ai][m][1]) + (v[ai][m][2] + v[ai][m][3]); s += __shfl_xor(s, 16); s += __shfl_xor(s, 32);
            rs[ai][m] = __builtin_amdgcn_rsqf(s * (1.0f / 1024.0f) + 1e-6f); }
}
struct EpiProj {
    static constexpr bool PERM = true, AFTER_DRAIN = false;
    bf16_t* O; int ldc; const float* ss;
    __device__ __forceinline__ void operator()(const f32x4 (&acc)[2][2][4][2], const Unit& u, int wr, int wc, int fr, int fq) const {
        const int row0 = u.pm * BM + wr * 64 + fr, col0 = u.pn * BM + wc * 32 + 8 * fq;
        float rsv[2][4]; row_rstd8(ss, row0, fq, rsv);
#pragma unroll
        for (int ai = 0; ai < 2; ++ai)
#pragma unroll
            for (int m = 0; m < 4; ++m) { const int row = row0 + ai * HALF + m * 16; const float rs = rsv[ai][m]; bf16_t* rowp = O + (size_t)row * ldc + col0;
#pragma unroll
                for (int bj = 0; bj < 2; ++bj) { const f32x4 v0 = acc[ai][bj][m][0] * rs, v1 = acc[ai][bj][m][1] * rs;
                    u32x4 w; w.x = cvt_pk_bf16(v0[0], v0[1]); w.y = cvt_pk_bf16(v0[2], v0[3]); w.z = cvt_pk_bf16(v1[0], v1[1]); w.w = cvt_pk_bf16(v1[2], v1[3]);
                    *(u32x4*)(rowp + bj * HALF) = w; }
                if (m & 1) asm volatile("" ::: "memory"); }
    }
};
__device__ __forceinline__ float silu_mul(float g, float u) { return g * __builtin_amdgcn_rcpf(1.0f + __expf(-g)) * u; }
struct EpiGU {
    static constexpr bool PERM = true, AFTER_DRAIN = false;
    bf16_t* O; int ldc; const float* ss;
    __device__ __forceinline__ void operator()(const f32x4 (&acc)[2][2][4][2], const Unit& u, int wr, int wc, int fr, int fq) const {
        const int row0 = u.pm * BM + wr * 64 + fr, col0 = u.pn * HALF + wc * 32 + 8 * fq;
        float rsv[2][4]; row_rstd8(ss, row0, fq, rsv);
#pragma unroll
        for (int ai = 0; ai < 2; ++ai)
#pragma unroll
            for (int m = 0; m < 4; ++m) { const int row = row0 + ai * HALF + m * 16; const float rs = rsv[ai][m];
                const f32x4 g0 = acc[ai][0][m][0] * rs, g1 = acc[ai][0][m][1] * rs, u0 = acc[ai][1][m][0] * rs, u1 = acc[ai][1][m][1] * rs;
                u32x4 w; w.x = cvt_pk_bf16(silu_mul(g0[0], u0[0]), silu_mul(g0[1], u0[1])); w.y = cvt_pk_bf16(silu_mul(g0[2], u0[2]), silu_mul(g0[3], u0[3]));
                w.z = cvt_pk_bf16(silu_mul(g1[0], u1[0]), silu_mul(g1[1], u1[1])); w.w = cvt_pk_bf16(silu_mul(g1[2], u1[2]), silu_mul(g1[3], u1[3]));
                *(u32x4*)(O + (size_t)row * ldc + col0) = w;
                if (m & 1) asm volatile("" ::: "memory"); }
    }
};
__device__ __forceinline__ float bflo(unsigned w) { return __uint_as_float(w << 16); }
__device__ __forceinline__ float bfhi(unsigned w) { return __uint_as_float(w & 0xffff0000u); }
struct EpiRes {
    static constexpr bool PERM = true, AFTER_DRAIN = false;
    bf16_t* xb; float* ss; bf16_t* xo_;
    __device__ __forceinline__ void operator()(const f32x4 (&acc)[2][2][4][2], const Unit& u, int wr, int wc, int fr, int fq) const {
        const int row0 = u.pm * BM + wr * 64 + fr, col0 = u.pn * BM + wc * 32 + 8 * fq;
#pragma unroll
        for (int ai = 0; ai < 2; ++ai) {
            u32x4 xi[4][2];
#pragma unroll
            for (int m = 0; m < 4; ++m)
#pragma unroll
                for (int bj = 0; bj < 2; ++bj) xi[m][bj] = *(const u32x4*)(xb + (size_t)(row0 + ai * HALF + m * 16) * 1024 + col0 + bj * HALF);
#pragma unroll
            for (int m = 0; m < 4; ++m) { const int row = row0 + ai * HALF + m * 16; float s = 0.f;
#pragma unroll
                for (int bj = 0; bj < 2; ++bj) { const u32x4 xw = xi[m][bj]; const f32x4 a0 = acc[ai][bj][m][0], a1 = acc[ai][bj][m][1];
                    const float v0 = bflo(xw.x) + a0[0], v1 = bfhi(xw.x) + a0[1], v2 = bflo(xw.y) + a0[2], v3 = bfhi(xw.y) + a0[3];
                    const float v4 = bflo(xw.z) + a1[0], v5 = bfhi(xw.z) + a1[1], v6 = bflo(xw.w) + a1[2], v7 = bfhi(xw.w) + a1[3];
                    u32x4 w; w.x = cvt_pk_bf16(v0, v1); w.y = cvt_pk_bf16(v2, v3); w.z = cvt_pk_bf16(v4, v5); w.w = cvt_pk_bf16(v6, v7);
                    *(u32x4*)(xo_ + (size_t)row * 1024 + col0 + bj * HALF) = w;
                    s += ((v0 * v0 + v1 * v1) + (v2 * v2 + v3 * v3)) + ((v4 * v4 + v5 * v5) + (v6 * v6 + v7 * v7)); }
                s += __shfl_xor(s, 16); s += __shfl_xor(s, 32);
                if (fq == 0) ss[(size_t)row * 16 + u.pn * 4 + wc] = s; }
            asm volatile("" ::: "memory"); }
    }
};
template <class Epi, class Sched, bool ALIGN_EPI = false, bool SP2 = false>
__device__ __forceinline__ void gemm_phase(PG8_LAS unsigned char* lds, const Gemm g, const Sched& S, const Epi& E) {
    int tid_ = threadIdx.x; asm volatile("" : "+v"(tid_)); const int tid = tid_, wid = __builtin_amdgcn_readfirstlane(tid >> 6), lane = tid & 63, wr = wid >> 2, wc = wid & 3, fr = lane & 15, fq = lane >> 4;
    const int K = g.K, nt = K / BK;
    unsigned voffA[2], voffB[2];
#pragma unroll
    for (int i = 0; i < 2; ++i) { int R, C; stage_rc(tid * 16 + i * 8192, R, C); const int Rb = Epi::PERM ? ((R & ~31) + perm32(R & 31)) : R;
        voffA[i] = (unsigned)(R * K + C) * 2u; voffB[i] = (unsigned)(Rb * K + C) * 2u; }
    const size_t kstep = (size_t)(BK * 2);
    const size_t hstep = (size_t)HALF * K * 2;
    const size_t tstep = 2 * hstep;
    const unsigned ldsw = (unsigned)wid * 1024u;
    const int aoff = lds_byte(wr * 64 + fr, fq * 8), boff = lds_byte(wc * 32 + fr, fq * 8);
#define PG8_SA(b, h) (((b) * 2 + (h)) * HTB)
#define PG8_SB(b, h) ((4 + (b) * 2 + (h)) * HTB)
#define PG8_STAGE(bufoff, gbase, voff) do { _Pragma("unroll") for (int _i = 0; _i < 2; ++_i) \
        __builtin_amdgcn_global_load_lds((const unsigned*)((const char*)(gbase) + (voff)[_i]), (PG8_LAS unsigned*)(lds + (bufoff) + ldsw + _i * 8192), 16, 0, 0); } while (0)
#define PG8_LDA(dst, b, h) do { _Pragma("unroll") for (int m = 0; m < 4; ++m) _Pragma("unroll") for (int k = 0; k < 2; ++k) dst[m][k] = *(const PG8_LAS bf16x8*)(lds + PG8_SA(b, h) + aoff + m * 2048 + k * 1024); } while (0)
#define PG8_LDB(dst, b, h) do { _Pragma("unroll") for (int n = 0; n < 2; ++n) _Pragma("unroll") for (int k = 0; k < 2; ++k) dst[n][k] = *(const PG8_LAS bf16x8*)(lds + PG8_SB(b, h) + boff + n * 2048 + k * 1024); } while (0)
#define PG8_MMA(ai, bj, At, Bt) do { __builtin_amdgcn_s_setprio(1); _Pragma("unroll") for (int m = 0; m < 4; ++m) _Pragma("unroll") for (int n = 0; n < 2; ++n) _Pragma("unroll") for (int k = 0; k < 2; ++k) \
        acc[ai][bj][m][n] = __builtin_amdgcn_mfma_f32_16x16x32_bf16(Bt[n][k], At[m][k], acc[ai][bj][m][n], 0, 0, 0); __builtin_amdgcn_s_setprio(0); } while (0)
#define PG8_WAIT_V(n) asm volatile("s_waitcnt vmcnt(" #n ")" ::: "memory")
#define PG8_WAIT_L(n) asm volatile("s_waitcnt lgkmcnt(" #n ")" ::: "memory")
#define PG8_BAR __builtin_amdgcn_s_barrier()
#define PG8_SCHED __builtin_amdgcn_sched_barrier(0)
    Unit cur, nxt; int ui = 0;
    if (!S.next(0, cur)) return;
    f32x4 acc[2][2][4][2];
#pragma unroll
    for (int a = 0; a < 2; ++a)
#pragma unroll
        for (int b = 0; b < 2; ++b)
#pragma unroll
            for (int m = 0; m < 4; ++m)
#pragma unroll
                for (int n = 0; n < 2; ++n) acc[a][b][m][n] = (f32x4){0.f, 0.f, 0.f, 0.f};
    bf16x8 At[4][2], B0[2][2], B1[2][2];
    const char* cA = (const char*)g.A + (size_t)cur.pm * tstep; const char* cB = (const char*)g.Bt + (size_t)cur.pn * tstep;
    S.a_ready(cur);
    if constexpr (SP2) {
        PG8_STAGE(PG8_SB(0, 0), cB, voffB); PG8_STAGE(PG8_SB(0, 1), cB + hstep, voffB); PG8_STAGE(PG8_SA(0, 0), cA, voffA); PG8_STAGE(PG8_SA(0, 1), cA + hstep, voffA);
        if (wr == 1) PG8_BAR;
        PG8_WAIT_V(2); PG8_BAR;
        PG8_STAGE(PG8_SB(1, 0), cB + kstep, voffB); PG8_STAGE(PG8_SA(1, 0), cA + kstep, voffA); PG8_STAGE(PG8_SB(1, 1), cB + hstep + kstep, voffB);
        PG8_WAIT_V(6); PG8_BAR;
    } else {
        PG8_STAGE(PG8_SB(0, 0), cB, voffB); PG8_STAGE(PG8_SA(0, 0), cA, voffA); PG8_STAGE(PG8_SB(0, 1), cB + hstep, voffB); PG8_STAGE(PG8_SA(0, 1), cA + hstep, voffA);
        if (wr == 1) PG8_BAR;
        PG8_WAIT_V(4); PG8_BAR;
        PG8_STAGE(PG8_SB(1, 0), cB + kstep, voffB); PG8_STAGE(PG8_SA(1, 0), cA + kstep, voffA); PG8_STAGE(PG8_SB(1, 1), cB + hstep + kstep, voffB);
        PG8_WAIT_V(6); PG8_BAR;
    }
    for (;;) {
        const bool has_next = S.next(ui + 1, nxt);
        const char* nA = has_next ? (const char*)g.A + (size_t)nxt.pm * tstep : cA; const char* nB = has_next ? (const char*)g.Bt + (size_t)nxt.pn * tstep : cB;
        for (int t = 0; t < nt; t += 2) {
            const bool last = (t == nt - 2);
            const char* a1 = cA + (size_t)(t + 1) * kstep;
            const char* a2 = last ? nA : cA + (size_t)(t + 2) * kstep; const char* b2 = last ? nB : cB + (size_t)(t + 2) * kstep;
            const char* a3 = a2 + kstep; const char* b3 = b2 + kstep;
            if (last && has_next) S.a_ready(nxt);
            if constexpr (SP2) {
            PG8_LDB(B0, 0, 0); PG8_LDB(B1, 0, 1); PG8_SCHED; PG8_LDA(At, 0, 0); PG8_STAGE(PG8_SA(1, 1), a1 + hstep, voffA);
            PG8_WAIT_V(8); PG8_WAIT_L(0); PG8_BAR; PG8_MMA(0, 0, At, B0); PG8_MMA(0, 1, At, B1); PG8_BAR; PG8_SCHED;
            PG8_LDA(At, 0, 1); PG8_STAGE(PG8_SB(0, 0), b2, voffB); PG8_STAGE(PG8_SB(0, 1), b2 + hstep, voffB); PG8_STAGE(PG8_SA(0, 0), a2, voffA);
            PG8_WAIT_V(8); PG8_WAIT_L(0); PG8_BAR; PG8_MMA(1, 0, At, B0); PG8_MMA(1, 1, At, B1); PG8_BAR; PG8_SCHED;
            PG8_LDB(B0, 1, 0); PG8_LDB(B1, 1, 1); PG8_SCHED; PG8_LDA(At, 1, 0); PG8_STAGE(PG8_SA(0, 1), a2 + hstep, voffA);
            PG8_WAIT_V(8); PG8_WAIT_L(0); PG8_BAR; PG8_MMA(0, 0, At, B0); PG8_MMA(0, 1, At, B1); PG8_BAR; PG8_SCHED;
            PG8_LDA(At, 1, 1); PG8_STAGE(PG8_SB(1, 0), b3, voffB); PG8_STAGE(PG8_SB(1, 1), b3 + hstep, voffB); PG8_STAGE(PG8_SA(1, 0), a3, voffA);
            PG8_WAIT_V(8); PG8_WAIT_L(0); PG8_BAR; PG8_MMA(1, 0, At, B0); PG8_MMA(1, 1, At, B1); PG8_BAR; PG8_SCHED;
            } else {
            PG8_LDB(B0, 0, 0); PG8_SCHED; PG8_LDA(At, 0, 0); PG8_STAGE(PG8_SA(1, 1), a1 + hstep, voffA);
            PG8_WAIT_L(8); PG8_BAR; PG8_WAIT_L(0); PG8_MMA(0, 0, At, B0); PG8_BAR; PG8_SCHED;
            PG8_LDB(B1, 0, 1); PG8_STAGE(PG8_SB(0, 0), b2, voffB);
            PG8_BAR; PG8_WAIT_L(0); PG8_MMA(0, 1, At, B1); PG8_BAR;
            PG8_LDA(At, 0, 1); PG8_STAGE(PG8_SA(0, 0), a2, voffA);
            PG8_BAR; PG8_WAIT_L(0); PG8_MMA(1, 0, At, B0); PG8_BAR; PG8_SCHED;
            PG8_STAGE(PG8_SB(0, 1), b2 + hstep, voffB);
            PG8_WAIT_V(6); PG8_BAR; PG8_MMA(1, 1, At, B1); PG8_BAR;
            PG8_LDB(B0, 1, 0); PG8_SCHED; PG8_LDA(At, 1, 0); PG8_STAGE(PG8_SA(0, 1), a2 + hstep, voffA);
            PG8_WAIT_L(8); PG8_BAR; PG8_WAIT_L(0); PG8_MMA(0, 0, At, B0); PG8_BAR; PG8_SCHED;
            PG8_LDB(B1, 1, 1); PG8_STAGE(PG8_SB(1, 0), b3, voffB);
            PG8_BAR; PG8_WAIT_L(0); PG8_MMA(0, 1, At, B1); PG8_BAR;
            PG8_LDA(At, 1, 1); PG8_STAGE(PG8_SA(1, 0), a3, voffA);
            PG8_BAR; PG8_WAIT_L(0); PG8_MMA(1, 0, At, B0); PG8_BAR; PG8_SCHED;
            PG8_STAGE(PG8_SB(1, 1), b3 + hstep, voffB);
            PG8_WAIT_V(6); PG8_BAR; PG8_MMA(1, 1, At, B1); PG8_BAR;
            }
        }
        if constexpr (ALIGN_EPI) { if (wr == 0) PG8_BAR; }
        if constexpr (!Epi::AFTER_DRAIN) { E(acc, cur, wr, wc, fr, fq); S.done(cur); }
        if (!has_next) break;
#pragma unroll
        for (int a = 0; a < 2; ++a)
#pragma unroll
            for (int b = 0; b < 2; ++b)
#pragma unroll
                for (int m = 0; m < 4; ++m)
#pragma unroll
                    for (int n = 0; n < 2; ++n) acc[a][b][m][n] = (f32x4){0.f, 0.f, 0.f, 0.f};
        cur = nxt; cA = nA; cB = nB; ++ui;
        if constexpr (ALIGN_EPI) { if (wr == 1) PG8_BAR; }
    }
    PG8_WAIT_V(0);
    if constexpr (!ALIGN_EPI) { if (wr == 0) PG8_BAR; }
    PG8_BAR;
    if constexpr (Epi::AFTER_DRAIN) { E.fused(acc, cur, wr, wc, fr, fq, lds, wid, lane); S.done(cur); }
#undef PG8_SA
#undef PG8_SB
#undef PG8_STAGE
#undef PG8_LDA
#undef PG8_LDB
#undef PG8_MMA
#undef PG8_WAIT_V
#undef PG8_WAIT_L
#undef PG8_BAR
#undef PG8_SCHED
}
}
namespace mx {
#define LAS __attribute__((address_space(3)))
typedef unsigned short bf16_t;
typedef short bf16x8 __attribute__((ext_vector_type(8)));
typedef short s16x4 __attribute__((ext_vector_type(4)));
typedef float f32x16 __attribute__((ext_vector_type(16)));
typedef float f32x2v __attribute__((ext_vector_type(2)));
typedef float f32x4v __attribute__((ext_vector_type(4)));
typedef __bf16 bf16x2v __attribute__((ext_vector_type(2)));
typedef unsigned u32x4 __attribute__((ext_vector_type(4)));
typedef unsigned u32x2 __attribute__((ext_vector_type(2)));
typedef LAS unsigned char* ldsp;
constexpr int TP = 144, TILE_B = 64 * TP;
constexpr int LDP = 2304, SEQ = 2048, DM = 1024;
constexpr float LOG2E = 1.4426950408889634f, KSC2 = 0.125f * 1.4426950408889634f, NEG = -1e30f;
constexpr int C_QA = 0, C_KA = 512, C_VA = 576, C_QB = 640, C_KCB = 896, C_VCB = 960, C_KSB = 1024, C_VSB = 1088, C_KWB = 1152, C_VWB = 1216, C_QC = 1280, C_KC = 1536, C_VC = 1792, C_GB = 2048;

__device__ __forceinline__ unsigned pk2(float lo, float hi) { f32x2v v = {lo, hi}; bf16x2v b = __builtin_convertvector(v, bf16x2v); return __builtin_bit_cast(unsigned, b); }
__device__ __forceinline__ float ex2(float x) { return __builtin_amdgcn_exp2f(x); }
__device__ __forceinline__ float bf2f(bf16_t v) { return __uint_as_float((unsigned)v << 16); }
__device__ __forceinline__ f32x16 zero16() { f32x16 z;
#pragma unroll
    for (int i = 0; i < 16; ++i) z[i] = 0.f; return z; }

__device__ __forceinline__ u32x4 tile_ld(const bf16_t* row0, size_t pitch, int tid) { return *(const u32x4*)(row0 + (size_t)(tid >> 3) * pitch + (tid & 7) * 8); }
__device__ __forceinline__ void tile_st(ldsp tile, int tid, u32x4 v) { *(LAS u32x4*)(tile + (tid >> 3) * TP + (tid & 7) * 16) = v; }

__device__ __forceinline__ void qk_tile(ldsp Kt, const bf16x8 (&qf)[4], int lane, f32x16& p0, f32x16& p1) {
    const int rho = lane & 31, h = lane >> 5;
    const int krow = 16 * ((rho >> 2) & 1) + (rho & 3) + 4 * (rho >> 3);
    ldsp kb = Kt + krow * TP + h * 16;
    p0 = zero16(); p1 = zero16();
#pragma unroll
    for (int s = 0; s < 4; ++s) {
        const bf16x8 a0 = *(const LAS bf16x8*)(kb + s * 32);
        const bf16x8 a1 = *(const LAS bf16x8*)(kb + 32 * TP + s * 32);
        p0 = __builtin_amdgcn_mfma_f32_32x32x16_bf16(a0, qf[s], p0, 0, 0, 0);
        p1 = __builtin_amdgcn_mfma_f32_32x32x16_bf16(a1, qf[s], p1, 0, 0, 0);
    }
}
__device__ __forceinline__ s16x4 vtr(ldsp p) { return __builtin_bit_cast(s16x4, __builtin_amdgcn_ds_read_tr16_b64_v4i16((LAS s16x4*)p)); }
__device__ __forceinline__ void pv_tile(ldsp Vt, const f32x16& w0, const f32x16& w1, int lane, f32x16& o0, f32x16& o1) {
    const int i = lane & 15, g16 = lane >> 4, D0 = 16 * (g16 & 1), h = g16 >> 1;
    ldsp vb = Vt + (16 * h + (i >> 2)) * TP + (D0 + 4 * (i & 3)) * 2;
#pragma unroll
    for (int sp = 0; sp < 4; ++sp) {
        u32x4 pw;
        if (sp < 2) { const int rb = (sp & 1) * 8; pw.x = pk2(w0[rb], w0[rb + 1]); pw.y = pk2(w0[rb + 2], w0[rb + 3]); pw.z = pk2(w0[rb + 4], w0[rb + 5]); pw.w = pk2(w0[rb + 6], w0[rb + 7]); }
        else        { const int rb = (sp & 1) * 8; pw.x = pk2(w1[rb], w1[rb + 1]); pw.y = pk2(w1[rb + 2], w1[rb + 3]); pw.z = pk2(w1[rb + 4], w1[rb + 5]); pw.w = pk2(w1[rb + 6], w1[rb + 7]); }
        const bf16x8 pb = __builtin_bit_cast(bf16x8, pw);
        const int key0 = 32 * (sp >> 1) + 8 * (sp & 1);
        {   const s16x4 lo = vtr(vb + key0 * TP), hi = vtr(vb + (key0 + 4) * TP);
            const bf16x8 a = {lo[0], lo[1], lo[2], lo[3], hi[0], hi[1], hi[2], hi[3]};
            o0 = __builtin_amdgcn_mfma_f32_32x32x16_bf16(a, pb, o0, 0, 0, 0); }
        {   const s16x4 lo = vtr(vb + key0 * TP + 64), hi = vtr(vb + (key0 + 4) * TP + 64);
            const bf16x8 a = {lo[0], lo[1], lo[2], lo[3], hi[0], hi[1], hi[2], hi[3]};
            o1 = __builtin_amdgcn_mfma_f32_32x32x16_bf16(a, pb, o1, 0, 0, 0); }
    }
}
__device__ __forceinline__ void softmax_step(f32x16& p0, f32x16& p1, float& m, float& l, f32x16& o0, f32x16& o1) {
    float mx = fmaxf(p0[0], p1[0]);
#pragma unroll
    for (int r = 1; r < 16; ++r) mx = fmaxf(mx, fmaxf(p0[r], p1[r]));
    mx = fmaxf(mx, __shfl_xor(mx, 32));
    const float mn = fmaxf(m, mx), alpha = ex2(m - mn);
    float ls = 0.f;
#pragma unroll
    for (int r = 0; r < 16; ++r) { p0[r] = p0[r] > -1e29f ? ex2(p0[r] - mn) : 0.f; p1[r] = p1[r] > -1e29f ? ex2(p1[r] - mn) : 0.f; ls += p0[r] + p1[r]; }
    ls += __shfl_xor(ls, 32);
    l = l * alpha + ls; m = mn; o0 *= alpha; o1 *= alpha;
}
__device__ __forceinline__ void prep_band(f32x16& p0, f32x16& p1, int tq, int tk0, int h, float slope2, int window, bool sel) {
#pragma unroll
    for (int r = 0; r < 16; ++r) {
        const int d0 = tq - (tk0 + 16 * h + r), d1 = d0 - 32;
        p0[r] = (sel && d0 >= 0 && d0 < window) ? p0[r] * KSC2 - slope2 * (float)d0 : NEG;
        p1[r] = (sel && d1 >= 0 && d1 < window) ? p1[r] * KSC2 - slope2 * (float)d1 : NEG;
    }
}
__device__ __forceinline__ void store_o(bf16_t* dst, const f32x16& o0, const f32x16& o1, float sc, int h) {
#pragma unroll
    for (int g = 0; g < 4; ++g) {
        u32x2 a; a.x = pk2(o0[4 * g] * sc, o0[4 * g + 1] * sc); a.y = pk2(o0[4 * g + 2] * sc, o0[4 * g + 3] * sc);
        u32x2 b; b.x = pk2(o1[4 * g] * sc, o1[4 * g + 1] * sc); b.y = pk2(o1[4 * g + 2] * sc, o1[4 * g + 3] * sc);
        *(u32x2*)(dst + 8 * g + 4 * h) = a; *(u32x2*)(dst + 32 + 8 * g + 4 * h) = b;
    }
}
__device__ __forceinline__ float sumsq(const f32x16& o0, const f32x16& o1) { float s = 0.f;
#pragma unroll
    for (int r = 0; r < 16; ++r) s += o0[r] * o0[r] + o1[r] * o1[r]; return s; }

__device__ __forceinline__ void unitA(ldsp lds, const bf16_t* proj, bf16_t* mixn, const float* sinks, int b, int T, int tid) {
    const int lane = tid & 63, w = tid >> 6, c = lane & 31, h = lane >> 5, head = c & 7;
    const float slope2 = exp2f(-8.0f * (float)(head + 1) / 12.0f) * LOG2E, sink2 = sinks[head] * LOG2E;
    const bf16_t* P = proj + (size_t)b * SEQ * LDP;
    const int t0 = 64 * T;
    ldsp Kt = lds, Vt = lds + TILE_B;
#pragma unroll 1
    for (int k = 0; k < 2; ++k) {
        const int tq = t0 + 8 * w + 4 * k + (c >> 3);
        bf16x8 qf[4];
        { const bf16_t* qp = P + (size_t)tq * LDP + C_QA + head * 64 + 8 * h;
#pragma unroll
          for (int s = 0; s < 4; ++s) qf[s] = *(const bf16x8*)(qp + 16 * s); }
        float m = sink2, l = 1.0f; f32x16 o0 = zero16(), o1 = zero16();
        const int j0 = T >= 2 ? T - 2 : 0;
        u32x4 rk = tile_ld(P + (size_t)(64 * j0) * LDP + C_KA, LDP, tid), rv = tile_ld(P + (size_t)(64 * j0) * LDP + C_VA, LDP, tid);
        for (int jt = j0; jt <= T; ++jt) {
            __syncthreads();
            tile_st(Kt, tid, rk); tile_st(Vt, tid, rv);
            __syncthreads();
            if (jt < T) { rk = tile_ld(P + (size_t)(64 * (jt + 1)) * LDP + C_KA, LDP, tid); rv = tile_ld(P + (size_t)(64 * (jt + 1)) * LDP + C_VA, LDP, tid); }
            f32x16 p0, p1; qk_tile(Kt, qf, lane, p0, p1); prep_band(p0, p1, tq, 64 * jt, h, slope2, 128, true);
            softmax_step(p0, p1, m, l, o0, o1); pv_tile(Vt, p0, p1, lane, o0, o1);
        }
        const float inv = 1.0f / l; float ss = sumsq(o0, o1) * inv * inv;
        ss += __shfl_xor(ss, 32); ss += __shfl_xor(ss, 1); ss += __shfl_xor(ss, 2); ss += __shfl_xor(ss, 4);
        const float sc = inv * __builtin_amdgcn_rsqf(ss * (1.0f / 512.0f) + 1e-6f);
        store_o(mixn + (size_t)(b * SEQ + tq) * DM + head * 64, o0, o1, sc, h);
    }
}

__device__ __forceinline__ float neg_softplus(float z) { const float az = fabsf(z); return -(fmaxf(z, 0.f) + 0.6931471805599453f * __builtin_amdgcn_logf(1.0f + ex2(-az * LOG2E))); }
__device__ __forceinline__ void stick_step(f32x16& p0, f32x16& p1, int tq, int tk0, int h, float& carry) {
    float run1 = 0.f, run0 = 0.f;
#pragma unroll
    for (int r = 15; r >= 0; --r) { const bool past = (tk0 + 32 + 16 * h + r) < tq; const float z = p1[r] * 0.125f; run1 += past ? neg_softplus(z) : 0.f; p1[r] = past ? z + run1 : NEG; }
#pragma unroll
    for (int r = 15; r >= 0; --r) { const bool past = (tk0 + 16 * h + r) < tq; const float z = p0[r] * 0.125f; run0 += past ? neg_softplus(z) : 0.f; p0[r] = past ? z + run0 : NEG; }
    const float ot1 = __shfl_xor(run1, 32), ot0 = __shfl_xor(run0, 32);
    const float off1 = carry + (h == 0 ? ot1 : 0.f);
    const float off0 = carry + run1 + ot1 + (h == 0 ? ot0 : 0.f);
    carry += (run0 + ot0) + (run1 + ot1);
#pragma unroll
    for (int r = 0; r < 16; ++r) { p1[r] = p1[r] > -1e29f ? ex2((p1[r] + off1) * LOG2E) : 0.f; p0[r] = p0[r] > -1e29f ? ex2((p0[r] + off0) * LOG2E) : 0.f; }
}
constexpr int C_SS_OFF = 8 * TILE_B;
__device__ __forceinline__ void unitC(ldsp lds, const bf16_t* proj, bf16_t* mixn, int b, int T, int tid) {
    const int lane = tid & 63, w = tid >> 6, c = lane & 31, h = lane >> 5, hd = w >> 1, ql = 32 * (w & 1) + c, tq = 64 * T + ql;
    const bf16_t* P = proj + (size_t)b * SEQ * LDP;
    bf16x8 qf[4];
    { const bf16_t* qp = P + (size_t)tq * LDP + C_QC + hd * 64 + 8 * h;
#pragma unroll
      for (int s = 0; s < 4; ++s) qf[s] = *(const bf16x8*)(qp + 16 * s); }
    f32x16 o0 = zero16(), o1 = zero16(); float carry = 0.f;
    u32x4 rg[8];
#pragma unroll
    for (int i = 0; i < 8; ++i) rg[i] = tile_ld(P + (size_t)(64 * T) * LDP + (i < 4 ? C_KC + i * 64 : C_VC + (i - 4) * 64), LDP, tid);
    LAS float* CF = (LAS float*)(lds + C_SS_OFF + 1024);
    for (int jt = T; jt >= 0; --jt) {
        __syncthreads();
        if (jt < T) {
            const float mc = fmaxf(fmaxf(fmaxf(CF[0], CF[1]), fmaxf(CF[2], CF[3])), fmaxf(fmaxf(CF[4], CF[5]), fmaxf(CF[6], CF[7])));
            if (mc < -40.0f) break;
        }
#pragma unroll
        for (int i = 0; i < 8; ++i) tile_st(lds + ((i & 3) * 2 + (i >> 2)) * TILE_B, tid, rg[i]);
        __syncthreads();
        if (jt > 0) {
#pragma unroll
            for (int i = 0; i < 8; ++i) rg[i] = tile_ld(P + (size_t)(64 * (jt - 1)) * LDP + (i < 4 ? C_KC + i * 64 : C_VC + (i - 4) * 64), LDP, tid); }
        f32x16 p0, p1; qk_tile(lds + hd * 2 * TILE_B, qf, lane, p0, p1);
        stick_step(p0, p1, tq, 64 * jt, h, carry);
        { float wc = carry;
#pragma unroll
          for (int o = 1; o < 64; o <<= 1) wc = fmaxf(wc, __shfl_xor(wc, o));
          if (lane == 0) CF[w] = wc; }
        pv_tile(lds + hd * 2 * TILE_B + TILE_B, p0, p1, lane, o0, o1);
    }
    float ss = sumsq(o0, o1); ss += __shfl_xor(ss, 32);
    LAS float* SS = (LAS float*)(lds + C_SS_OFF);
    if (h == 0) SS[ql * 4 + hd] = ss;
    __syncthreads();
    const float tot = (SS[ql * 4 + 0] + SS[ql * 4 + 1]) + (SS[ql * 4 + 2] + SS[ql * 4 + 3]);
    const float sc = __builtin_amdgcn_rsqf(tot * (1.0f / 256.0f) + 1e-6f);
    store_o(mixn + (size_t)(b * SEQ + tq) * DM + 768 + hd * 64, o0, o1, sc, h);
}

template <int MODE, bool INTERIOR>
__device__ __forceinline__ void kv_range(ldsp lds, const bf16_t* Kg, const bf16_t* Vg, int jlo, int jhi, int jend, u32x4& rka, u32x4& rva, ldsp qs_, int tq, float slope2, unsigned sel,
                                         int tid, int lane, int h, float& m, float& l, f32x16& o0, f32x16& o1) {
    const float qs = slope2 * (1.0f / KSC2);
    for (int jt = jlo; jt <= jhi; ++jt) {
        u32x4 rkb = rka, rvb = rva;
        if (jt + 2 <= jend) { rkb = tile_ld(Kg + (size_t)(64 * (jt + 2)) * LDP, LDP, tid); rvb = tile_ld(Vg + (size_t)(64 * (jt + 2)) * LDP, LDP, tid); }
        ldsp Kt = lds + (jt & 1) * 2 * TILE_B, Vt = Kt + TILE_B;
        const bool mine = MODE == 0 ? ((sel >> jt) & 1u) != 0u : true;
        if (MODE == 1 || __any(mine ? 1 : 0)) {
            ldsp qsl = qs_; asm volatile("" : "+v"(qsl));
            bf16x8 qf[4];
#pragma unroll
            for (int s = 0; s < 4; ++s) qf[s] = *(const LAS bf16x8*)(qsl + s * 1024);
            f32x16 p0, p1; qk_tile(Kt, qf, lane, p0, p1);
            if (INTERIOR) {
                const float A0 = mine ? -slope2 * (float)(tq - 64 * jt - 16 * h) : NEG, A1 = mine ? A0 + 32.0f * slope2 : NEG;
                float mx0 = NEG, mx1 = NEG;
#pragma unroll
                for (int r = 0; r < 16; ++r) { p0[r] = __builtin_fmaf(qs, (float)r, p0[r]); mx0 = fmaxf(mx0, p0[r]); p1[r] = __builtin_fmaf(qs, (float)r, p1[r]); mx1 = fmaxf(mx1, p1[r]); }
                float mxv = fmaxf(__builtin_fmaf(mx0, KSC2, A0), __builtin_fmaf(mx1, KSC2, A1)); mxv = fmaxf(mxv, __shfl_xor(mxv, 32));
                const float mn = fmaxf(m, mxv), alpha = ex2(m - mn);
                const float c0 = mine ? A0 - mn : -3e38f, c1 = mine ? A1 - mn : -3e38f;
                float ls = 0.f;
#pragma unroll
                for (int r = 0; r < 16; ++r) { p0[r] = ex2(__builtin_fmaf(p0[r], KSC2, c0)); p1[r] = ex2(__builtin_fmaf(p1[r], KSC2, c1)); ls += p0[r] + p1[r]; }
                ls += __shfl_xor(ls, 32);
                l = l * alpha + ls; m = mn; o0 *= alpha; o1 *= alpha;
            } else {
                prep_band(p0, p1, tq, 64 * jt, h, slope2, MODE == 0 ? 4096 : 512, mine);
                softmax_step(p0, p1, m, l, o0, o1);
            }
            pv_tile(Vt, p0, p1, lane, o0, o1);
        }
        if (jt + 1 <= jend) { ldsp Kn = lds + ((jt + 1) & 1) * 2 * TILE_B; tile_st(Kn, tid, rka); tile_st(Kn + TILE_B, tid, rva); }
        __syncthreads();
        rka = rkb; rva = rvb;
    }
}
__device__ __forceinline__ void kv_start(ldsp lds, const bf16_t* Kg, const bf16_t* Vg, int jlo, int jend, u32x4& rka, u32x4& rva, int tid) {
    const u32x4 k0 = tile_ld(Kg + (size_t)(64 * jlo) * LDP, LDP, tid), v0 = tile_ld(Vg + (size_t)(64 * jlo) * LDP, LDP, tid);
    rka = k0; rva = v0;
    if (jlo + 1 <= jend) { rka = tile_ld(Kg + (size_t)(64 * (jlo + 1)) * LDP, LDP, tid); rva = tile_ld(Vg + (size_t)(64 * (jlo + 1)) * LDP, LDP, tid); }
    __syncthreads();
    ldsp Kt = lds + (jlo & 1) * 2 * TILE_B; tile_st(Kt, tid, k0); tile_st(Kt + TILE_B, tid, v0);
    __syncthreads();
}
constexpr int B_CK = 4 * TILE_B, B_CV = 6 * TILE_B, B_IMP = 8 * TILE_B, B_MASK = B_IMP + 16384;
constexpr int B_GL = B_MASK + 256;
__device__ __forceinline__ void unitB(ldsp lds, const bf16_t* proj, const bf16_t* kc, const bf16_t* vc, bf16_t* mixn, const bf16_t* xb, const float* ssq, const bf16_t* wg, int b, int T, int tid) {
    const int lane = tid & 63, w = tid >> 6, c = lane & 31, h = lane >> 5, hd = c & 3, qloc = c >> 2, tq = 64 * T + 8 * w + qloc;
    const float slope2 = exp2f(-8.0f * (float)(hd + 9) / 12.0f) * LOG2E;
    const bf16_t* P = proj + (size_t)b * SEQ * LDP;
    bf16x8 qf[4];
    { const bf16_t* qp = P + (size_t)tq * LDP + C_QB + hd * 64 + 8 * h;
#pragma unroll
      for (int s = 0; s < 4; ++s) qf[s] = *(const bf16x8*)(qp + 16 * s); }
    LAS float* GL = (LAS float*)(lds + B_GL); LAS float* GP = GL + 768;
    u32x4 ckr[2], cvr[2];
#pragma unroll
    for (int t = 0; t < 2; ++t) { int n = 64 * t + (tid >> 3); n = n > 126 ? 126 : n; const size_t off = ((size_t)b * 128 + n) * 64 + (tid & 7) * 8;
        ckr[t] = *(const u32x4*)(kc + off); cvr[t] = *(const u32x4*)(vc + off); }
    { const int th = w & 1, kq = w >> 1, gc = c < 12 ? c : 11;
      const bf16_t* xa = xb + ((size_t)b * SEQ + 64 * T + 32 * th + c) * DM + 256 * kq + 8 * h;
      const bf16_t* wb = wg + (size_t)gc * 1024 + 256 * kq + 8 * h;
      f32x16 ga = zero16();
#pragma unroll 8
      for (int s = 0; s < 16; ++s) { const bf16x8 xa8 = *(const bf16x8*)(xa + 16 * s), wb8 = *(const bf16x8*)(wb + 16 * s); ga = __builtin_amdgcn_mfma_f32_32x32x16_bf16(xa8, wb8, ga, 0, 0, 0); }
      if (c < 12) {
#pragma unroll
          for (int r = 0; r < 16; ++r) GP[(kq * 64 + 32 * th + (r & 3) + 8 * (r >> 2) + 4 * h) * 12 + c] = ga[r]; } }
#define B_GATE(i) (GL[(8 * w + qloc) * 12 + hd * 3 + (i)])
    f32x16 ob0 = zero16(), ob1 = zero16();
    const int ntc = T >= 16 ? 2 : 1;
    __syncthreads();
    { int t2 = tid; asm volatile("" : "+v"(t2));
#pragma unroll 1
      for (; t2 < 768; t2 += 512) { const int tk = t2 / 12; const size_t row = (size_t)b * SEQ + 64 * T + tk;
        const f32x4v* sp = (const f32x4v*)(ssq + row * 16); const f32x4v s0 = sp[0], s1 = sp[1], s2 = sp[2], s3 = sp[3];
        const float sq = ((s0[0] + s0[1]) + (s0[2] + s0[3])) + ((s1[0] + s1[1]) + (s1[2] + s1[3])) + ((s2[0] + s2[1]) + (s2[2] + s2[3])) + ((s3[0] + s3[1]) + (s3[2] + s3[3]));
        const float rs = __builtin_amdgcn_rsqf(sq * (1.0f / 1024.0f) + 1e-6f);
        const float gv = (GP[t2] + GP[768 + t2]) + (GP[1536 + t2] + GP[2304 + t2]);
        GL[t2] = 1.0f / (1.0f + __expf(-gv * rs)); } }
#pragma unroll
    for (int t = 0; t < 2; ++t) { tile_st(lds + B_CK + t * TILE_B, tid, ckr[t]); tile_st(lds + B_CV + t * TILE_B, tid, cvr[t]); }
    __syncthreads();
    unsigned sel;
    {
        f32x16 pa0, pa1, pb0, pb1;
        qk_tile(lds + B_CK, qf, lane, pa0, pa1);
        if (ntc == 2) qk_tile(lds + B_CK + TILE_B, qf, lane, pb0, pb1); else { pb0 = zero16(); pb1 = zero16(); }
        float mxv = NEG;
#pragma unroll
        for (int r = 0; r < 16; ++r) {
            const int n0 = 16 * h + r; const int d0 = tq - (16 * n0 + 31), d1 = d0 - 512, d2 = d0 - 1024, d3 = d0 - 1536;
            pa0[r] = d0 >= 0 ? pa0[r] * KSC2 - slope2 * (float)d0 : NEG; pa1[r] = d1 >= 0 ? pa1[r] * KSC2 - slope2 * (float)d1 : NEG;
            pb0[r] = d2 >= 0 ? pb0[r] * KSC2 - slope2 * (float)d2 : NEG; pb1[r] = d3 >= 0 ? pb1[r] * KSC2 - slope2 * (float)d3 : NEG;
            mxv = fmaxf(fmaxf(mxv, fmaxf(pa0[r], pa1[r])), fmaxf(pb0[r], pb1[r]));
        }
        mxv = fmaxf(mxv, __shfl_xor(mxv, 32));
        float ls = 0.f;
#pragma unroll
        for (int r = 0; r < 16; ++r) {
            pa0[r] = pa0[r] > -1e29f ? ex2(pa0[r] - mxv) : 0.f; pa1[r] = pa1[r] > -1e29f ? ex2(pa1[r] - mxv) : 0.f;
            pb0[r] = pb0[r] > -1e29f ? ex2(pb0[r] - mxv) : 0.f; pb1[r] = pb1[r] > -1e29f ? ex2(pb1[r] - mxv) : 0.f;
            ls += (pa0[r] + pa1[r]) + (pb0[r] + pb1[r]);
        }
        ls += __shfl_xor(ls, 32);
        const float inv = ls > 0.f ? 1.0f / ls : 0.f;
        f32x16 oc0 = zero16(), oc1 = zero16();
        pv_tile(lds + B_CV, pa0, pa1, lane, oc0, oc1);
        if (ntc == 2) pv_tile(lds + B_CV + TILE_B, pb0, pb1, lane, oc0, oc1);
        const float gs = B_GATE(0) * inv;
        ob0 += oc0 * gs; ob1 += oc1 * gs;
        LAS float* IA = (LAS float*)(lds + B_IMP) + w * 512 + qloc * 32;
        LAS float* IB = IA + 256;
#pragma unroll
        for (int g = 0; g < 4; ++g) {
            float a0 = (2.0f * (pa0[4 * g] + pa0[4 * g + 1] + pa0[4 * g + 2]) + pa0[4 * g + 3]) * inv, b0 = pa0[4 * g + 3] * inv;
            float a1 = (2.0f * (pa1[4 * g] + pa1[4 * g + 1] + pa1[4 * g + 2]) + pa1[4 * g + 3]) * inv, b1 = pa1[4 * g + 3] * inv;
            float a2 = (2.0f * (pb0[4 * g] + pb0[4 * g + 1] + pb0[4 * g + 2]) + pb0[4 * g + 3]) * inv, b2 = pb0[4 * g + 3] * inv;
            float a3 = (2.0f * (pb1[4 * g] + pb1[4 * g + 1] + pb1[4 * g + 2]) + pb1[4 * g + 3]) * inv, b3 = pb1[4 * g + 3] * inv;
            a0 += __shfl_xor(a0, 1); a0 += __shfl_xor(a0, 2); b0 += __shfl_xor(b0, 1); b0 += __shfl_xor(b0, 2);
            a1 += __shfl_xor(a1, 1); a1 += __shfl_xor(a1, 2); b1 += __shfl_xor(b1, 1); b1 += __shfl_xor(b1, 2);
            a2 += __shfl_xor(a2, 1); a2 += __shfl_xor(a2, 2); b2 += __shfl_xor(b2, 1); b2 += __shfl_xor(b2, 2);
            a3 += __shfl_xor(a3, 1); a3 += __shfl_xor(a3, 2); b3 += __shfl_xor(b3, 1); b3 += __shfl_xor(b3, 2);
            if (hd == 0) { const int j = 4 * h + g; IA[j] = a0; IB[j] = b0; IA[8 + j] = a1; IB[8 + j] = b1; IA[16 + j] = a2; IB[16 + j] = b2; IA[24 + j] = a3; IB[24 + j] = b3; }
        }
        asm volatile("s_waitcnt lgkmcnt(0)" ::: "memory"); __builtin_amdgcn_wave_barrier();
        LAS unsigned* MK = (LAS unsigned*)(lds + B_MASK) + w * 8;
        if (lane < 8) {
            const LAS float* SA = (const LAS float*)(lds + B_IMP) + w * 512 + lane * 32; const LAS float* SB = SA + 256;
            float iv[32];
#pragma unroll
            for (int j = 1; j < 32; ++j) iv[j] = SA[j] + SB[j - 1];
            unsigned mk = 1u | (1u << T) | (T >= 1 ? (1u << (T - 1)) : 0u);
            const int need = 8 - __popc(mk);
#pragma unroll
            for (int j = 1; j < 32; ++j) if (j > T || ((mk >> j) & 1u)) iv[j] = -1.0f;
#pragma unroll 1
            for (int it = 0; it < need; ++it) {
                int best = 0; float bv = -0.5f;
#pragma unroll
                for (int j = 1; j < 32; ++j) { const bool gt = iv[j] > bv; bv = gt ? iv[j] : bv; best = gt ? j : best; }
                if (best == 0) break;
                mk |= 1u << best;
#pragma unroll
                for (int j = 1; j < 32; ++j) iv[j] = (j == best) ? -1.0f : iv[j];
            }
            MK[lane] = mk;
        }
        asm volatile("s_waitcnt lgkmcnt(0)" ::: "memory"); __builtin_amdgcn_wave_barrier();
        sel = MK[qloc];
    }
    ldsp qpB = lds + B_GL + 3072 + w * 4096 + lane * 16;
#pragma unroll
    for (int s = 0; s < 4; ++s) *(LAS bf16x8*)(qpB + s * 1024) = qf[s];
    { float m = NEG, l = 0.f; f32x16 o0 = zero16(), o1 = zero16();
      const bf16_t* Kg = P + C_KSB; const bf16_t* Vg = P + C_VSB; u32x4 rk, rv;
      kv_start(lds, Kg, Vg, 0, T, rk, rv, tid);
      if (T > 0) kv_range<0, true>(lds, Kg, Vg, 0, T - 1, T, rk, rv, qpB, tq, slope2, sel, tid, lane, h, m, l, o0, o1);
      kv_range<0, false>(lds, Kg, Vg, T, T, T, rk, rv, qpB, tq, slope2, sel, tid, lane, h, m, l, o0, o1);
      const float gs = B_GATE(1) / l; ob0 += o0 * gs; ob1 += o1 * gs; }
    { float m = NEG, l = 0.f; f32x16 o0 = zero16(), o1 = zero16();
      const bf16_t* Kg = P + C_KWB; const bf16_t* Vg = P + C_VWB; u32x4 rk, rv;
      const int jlo = T >= 8 ? T - 8 : 0;
      kv_start(lds, Kg, Vg, jlo, T, rk, rv, tid);
      if (T >= 8) kv_range<1, false>(lds, Kg, Vg, T - 8, T - 8, T, rk, rv, qpB, tq, slope2, 0u, tid, lane, h, m, l, o0, o1);
      if (T >= 1) kv_range<1, true>(lds, Kg, Vg, T >= 7 ? T - 7 : 0, T - 1, T, rk, rv, qpB, tq, slope2, 0u, tid, lane, h, m, l, o0, o1);
      kv_range<1, false>(lds, Kg, Vg, T, T, T, rk, rv, qpB, tq, slope2, 0u, tid, lane, h, m, l, o0, o1);
      const float gs = B_GATE(2) / l; ob0 += o0 * gs; ob1 += o1 * gs; }
    float ss = sumsq(ob0, ob1); ss += __shfl_xor(ss, 32); ss += __shfl_xor(ss, 1); ss += __shfl_xor(ss, 2);
    const float sc = __builtin_amdgcn_rsqf(ss * (1.0f / 256.0f) + 1e-6f);
    store_o(mixn + (size_t)(b * SEQ + tq) * DM + 512 + hd * 64, ob0, ob1, sc, h);
}

__device__ __forceinline__ float gelu_tanh(float x) { const float u = 0.7978845608028654f * (x + 0.044715f * x * x * x); const float e = __expf(2.0f * u); return 0.5f * x * (1.0f + (1.0f - 2.0f / (e + 1.0f))); }
__device__ __forceinline__ void unitCmp(const bf16_t* proj, const bf16_t* w1t, const bf16_t* w2t, const float* bias1, bf16_t* kc, bf16_t* vc, int b, int tid) {
    const int lane = tid & 63, w = tid >> 6, c = lane & 31, h = lane >> 5, g = w >> 1, kv = w & 1;
    const int n = 32 * g + c, nn = n > 126 ? 126 : n;
    const bf16_t* src = proj + ((size_t)b * SEQ + 16 * nn) * LDP + (kv ? C_VCB : C_KCB) + 8 * h;
    const bf16_t* wa = w1t + (size_t)kv * 128 * 2048 + (size_t)lane * 8;
    f32x16 acc[4] = {zero16(), zero16(), zero16(), zero16()};
#pragma unroll 4
    for (int s = 0; s < 128; ++s) {
        const bf16x8 bq = *(const bf16x8*)(src + (size_t)(s >> 2) * LDP + (s & 3) * 16);
#pragma unroll
        for (int fb = 0; fb < 4; ++fb) { const bf16x8 a = *(const bf16x8*)(wa + ((size_t)fb * 128 + s) * 512); acc[fb] = __builtin_amdgcn_mfma_f32_32x32x16_bf16(a, bq, acc[fb], 0, 0, 0); }
    }
    f32x16 y0 = zero16(), y1 = zero16();
    const bf16_t* w2a = w2t + ((size_t)kv * 64 + c) * 128;
#pragma unroll
    for (int fb = 0; fb < 4; ++fb) {
#pragma unroll
        for (int r = 0; r < 16; ++r) acc[fb][r] = gelu_tanh(acc[fb][r] + bias1[kv * 128 + 32 * fb + (r & 3) + 8 * (r >> 2) + 4 * h]);
#pragma unroll
        for (int s2 = 0; s2 < 2; ++s2) {
            u32x4 pw; const int rb = 8 * s2; pw.x = pk2(acc[fb][rb], acc[fb][rb + 1]); pw.y = pk2(acc[fb][rb + 2], acc[fb][rb + 3]); pw.z = pk2(acc[fb][rb + 4], acc[fb][rb + 5]); pw.w = pk2(acc[fb][rb + 6], acc[fb][rb + 7]);
            const bf16x8 hb = __builtin_bit_cast(bf16x8, pw);
            const int f0 = 32 * fb + 16 * s2 + 4 * h;
            { const u32x2 lo = *(const u32x2*)(w2a + f0), hi = *(const u32x2*)(w2a + f0 + 8); u32x4 av; av.x = lo.x; av.y = lo.y; av.z = hi.x; av.w = hi.y;
              y0 = __builtin_amdgcn_mfma_f32_32x32x16_bf16(__builtin_bit_cast(bf16x8, av), hb, y0, 0, 0, 0); }
            { const u32x2 lo = *(const u32x2*)(w2a + 32 * 128 + f0), hi = *(const u32x2*)(w2a + 32 * 128 + f0 + 8); u32x4 av; av.x = lo.x; av.y = lo.y; av.z = hi.x; av.w = hi.y;
              y1 = __builtin_amdgcn_mfma_f32_32x32x16_bf16(__builtin_bit_cast(bf16x8, av), hb, y1, 0, 0, 0); }
        }
    }
    if (n < 127) store_o((kv ? vc : kc) + ((size_t)b * 128 + n) * 64, y0, y1, 1.0f, h);
}
}
using mx::ldsp; using mx::bf16_t;
typedef float f32x4 __attribute__((ext_vector_type(4)));
typedef unsigned u32x4 __attribute__((ext_vector_type(4)));
typedef unsigned u32x2 __attribute__((ext_vector_type(2)));
constexpr int BATCH = 32, SEQ = 2048, DM = 1024, DEPTH = 4, MTOK = BATCH * SEQ, NPROJ = 2048, INW = 2060, DFF = 2816, NGU = 2 * DFF;
constexpr size_t MiB = 1u << 20;
constexpr size_t WS_BAR = 64 * 1024, WS_ZERO_BYTES = 128 * 1024;
constexpr size_t WS_CTR = 0;
constexpr size_t WS_WIN = 1 * MiB, SZ_WIN = (size_t)NPROJ * DM * 2;
constexpr size_t WS_WOUT = 19 * MiB, SZ_WOUT = (size_t)DM * DM * 2;
constexpr size_t WS_WGU = 27 * MiB, SZ_WGU = (size_t)NGU * DM * 2;
constexpr size_t WS_WDN = 71 * MiB, SZ_WDN = (size_t)DM * DFF * 2;
constexpr size_t WS_W1T = 93 * MiB, SZ_W1T = (size_t)2 * 128 * 2048 * 2;
constexpr size_t WS_W2T = 97 * MiB, SZ_W2T = (size_t)2 * 64 * 128 * 2;
constexpr size_t WS_B1 = 97 * MiB + 512 * 1024, SZ_B1 = 2 * 128 * 4;
constexpr size_t WS_WG = 97 * MiB + 768 * 1024, SZ_WG = 32 * 1024;
constexpr size_t WS_KC = 98 * MiB, WS_VC = 98 * MiB + 512 * 1024;
constexpr size_t WS_SS = 100 * MiB;
constexpr size_t WS_XB = 104 * MiB;
constexpr size_t WS_PROJ = 232 * MiB;
constexpr size_t WS_MIXN = 520 * MiB;
constexpr size_t WS_HID = 232 * MiB;
constexpr size_t WS_END = 648 * MiB;
static_assert(WS_WIN + 4 * SZ_WIN <= WS_WOUT && WS_WOUT + 4 * SZ_WOUT <= WS_WGU && WS_WGU + 4 * SZ_WGU <= WS_WDN && WS_WDN + 4 * SZ_WDN <= WS_W1T && WS_W1T + 4 * SZ_W1T <= WS_W2T, "ws map");
static_assert(WS_HID + (size_t)MTOK * DFF * 2 <= WS_END && WS_PROJ + (size_t)MTOK * mx::LDP * 2 <= WS_MIXN && WS_XB + (size_t)MTOK * DM * 2 <= WS_PROJ, "ws map 2");
constexpr int LDS_BYTES = 143360, LDS_CTL = 131072;
constexpr int NPHASE = 2 + 6 * DEPTH;

#define RLX_AGENT __ATOMIC_RELAXED, __HIP_MEMORY_SCOPE_AGENT
#define XB_TMO      128
#define XB_XCNT(j)  (256  + 64 * (j))
#define XB_XSUB(j)  (1280 + 64 * (j))
#define XB_XGEN(j)  (2304 + 64 * (j))
#define XB_TOP      3328
#define XB_TOPGEN   3392
#define XCD_BAR_WORDS 3456
#define XB_SPIN_CAP (1u << 18)

__device__ __forceinline__ unsigned xb_ld(unsigned* p)              { return __hip_atomic_load(p, __ATOMIC_RELAXED, __HIP_MEMORY_SCOPE_AGENT); }
__device__ __forceinline__ unsigned xb_add(unsigned* p, unsigned v) { return __hip_atomic_fetch_add(p, v, __ATOMIC_RELAXED, __HIP_MEMORY_SCOPE_AGENT); }
__device__ __forceinline__ unsigned xb_xcc_id() { return (unsigned)__builtin_amdgcn_s_getreg((3 << 11) | 20) & 0xFu; }
#define XB_SPIN(cond, bar) do { unsigned _sp = 0; while (cond) { __builtin_amdgcn_s_sleep(1); \
    if ((++_sp & 255u) == 0u) { if (xb_ld(&(bar)[XB_TMO])) break; if (_sp > XB_SPIN_CAP) { atomicAdd(&(bar)[XB_TMO], 1u); break; } } } } while (0)

struct XcdBarrier {
    unsigned* bar; unsigned x;
    volatile LAS unsigned* st;
};

__device__ __forceinline__ XcdBarrier xcd_barrier_post(unsigned* bar, volatile LAS unsigned* st) {
    XcdBarrier b; b.bar = bar; b.x = xb_xcc_id(); b.st = st;
    if (threadIdx.x == 0) (void)xb_add(&bar[XB_XCNT(b.x)], 1u);
    return b;
}
__device__ __forceinline__ void xcd_barrier_complete(unsigned* bar, unsigned x, unsigned& nloc, unsigned& nx) {
    const unsigned G = gridDim.x * gridDim.y * gridDim.z;
    unsigned sum, cnt, mine, sp = 0u;
    for (;;) {
        sum = 0u; cnt = 0u; mine = 0u;
#pragma unroll
        for (unsigned j = 0; j < 16; ++j) { const unsigned c = xb_ld(&bar[XB_XCNT(j)]); sum += c; cnt += (c > 0u) ? 1u : 0u; mine = (j == x) ? c : mine; }
        if (sum == G) break;
        __builtin_amdgcn_s_sleep(1);
        if ((++sp & 255u) == 0u) { if (xb_ld(&bar[XB_TMO])) break; if (sp > XB_SPIN_CAP) { atomicAdd(&bar[XB_TMO], 1u); break; } }
    }
    nloc = mine > 0u ? mine : 1u; nx = cnt > 0u ? cnt : 1u;
}

__device__ __forceinline__ void xcd_barrier(const XcdBarrier& b) {
    asm volatile("s_waitcnt vmcnt(0)" ::: "memory");
    __syncthreads();
    if (threadIdx.x == 0) {
        unsigned* bar = b.bar; asm volatile("" : "+s"(bar));
        __builtin_amdgcn_s_waitcnt(0);
        unsigned nloc = b.st[0], nx = b.st[1];
        if (nloc == 0u) { xcd_barrier_complete(bar, b.x, nloc, nx); b.st[0] = nloc; b.st[1] = nx; }
        const unsigned old = xb_add(&bar[XB_XSUB(b.x)], 1u);
        const unsigned gen = old / nloc;
        if (old + 1u == (gen + 1u) * nloc) {
            __builtin_amdgcn_fence(__ATOMIC_RELEASE, "agent");
            asm volatile("s_waitcnt vmcnt(0)" ::: "memory");
            const unsigned og = xb_add(&bar[XB_TOP], 1u);
            const unsigned tg = og / nx;
            if (og + 1u == (tg + 1u) * nx) xb_add(&bar[XB_TOPGEN], 1u);
            else XB_SPIN(xb_ld(&bar[XB_TOPGEN]) == tg, bar);
            __builtin_amdgcn_fence(__ATOMIC_ACQUIRE, "agent");
            xb_add(&bar[XB_XGEN(b.x)], 1u);
            asm volatile("s_waitcnt vmcnt(0)" ::: "memory");
        } else {
            XB_SPIN(xb_ld(&bar[XB_XGEN(b.x)]) == gen, bar);
            __builtin_amdgcn_fence(__ATOMIC_ACQUIRE, "agent");
            asm volatile("s_waitcnt vmcnt(0)" ::: "memory");
        }
    }
    __syncthreads();
}

struct Params { const float* in[16]; float* out; unsigned char* ws; int ph_lo, ph_hi; };

__device__ __forceinline__ float wave_sum(float v) {
#pragma unroll
    for (int o = 1; o < 64; o <<= 1) v += __shfl_xor(v, o);
    return v;
}
template <class RowMap>
__device__ __forceinline__ void transpose_item(const float* W, int K, int N, const float* gk0  , bf16_t* WT, RowMap rm, LAS float* scr, int kb, int nb, int lane) {
    const int k0 = 64 * kb, n0 = 32 * nb, nl = n0 + (lane & 31);
#pragma unroll 4
    for (int i = 0; i < 32; ++i) { const int kk = 2 * i + (lane >> 5); float v = nl < N ? W[(size_t)(k0 + kk) * N + nl] : 0.f; if (gk0) v *= gk0[kk]; scr[kk * 33 + (lane & 31)] = v; }
    asm volatile("s_waitcnt lgkmcnt(0)" ::: "memory"); __builtin_amdgcn_wave_barrier();
    const int c = lane & 7;
#pragma unroll
    for (int j = 0; j < 4; ++j) { const int n = (lane >> 3) + 8 * j; const LAS float* s = scr + (8 * c) * 33 + n;
        u32x4 o; o.x = mx::pk2(s[0 * 33], s[1 * 33]); o.y = mx::pk2(s[2 * 33], s[3 * 33]); o.z = mx::pk2(s[4 * 33], s[5 * 33]); o.w = mx::pk2(s[6 * 33], s[7 * 33]);
        if (n0 + n < N) *(u32x4*)(WT + rm(n0 + n, k0 + 8 * c)) = o; }
    asm volatile("s_waitcnt lgkmcnt(0)" ::: "memory"); __builtin_amdgcn_wave_barrier();
}
struct RmId { int K; __device__ size_t operator()(int n, int k) const { return (size_t)n * K + k; } };
struct RmW1 { __device__ size_t operator()(int f, int k) const { return ((size_t)((f >> 5) * 128 + (k >> 4)) * 64 + (((k >> 3) & 1) * 32 + (f & 31))) * 8; } };
struct RmIn { size_t gdelta; __device__ size_t operator()(int n, int k) const { return n < 1280 ? (size_t)n * 1024 + k : (n < 1292 ? gdelta + (size_t)(n - 1280) * 1024 + k : (size_t)(n - 12) * 1024 + k); } };
struct RmGU { int up; __device__ size_t operator()(int n, int k) const { return (size_t)(256 * (n >> 7) + 128 * up + (n & 127)) * 1024 + k; } };

constexpr int I_IN = 16 * 65, I_OUT = 16 * 32, I_G = 16 * 88, I_DN = 44 * 32, I_W1 = 2 * 32 * 4, I_W2 = 2 * 2 * 2;
constexpr int I_LAYER = I_IN + I_OUT + 2 * I_G + I_DN + I_W1 + I_W2, CONV_UNITS = (I_LAYER + 7) / 8;
__device__ __forceinline__ void convert_item(const Params& p, int L, int r, LAS float* scr, int lane) {
    unsigned char* ws = p.ws;
    const float *w_in = p.in[1], *w_out = p.in[2], *g_attn = p.in[3], *g_ffn = p.in[4], *g_oa = p.in[5], *g_ob = p.in[6], *g_oc = p.in[7];
    const float *cmp_w1 = p.in[10], *cmp_w2 = p.in[11], *w_gate = p.in[12], *w_up = p.in[13], *w_down = p.in[14];
    if (r < I_IN) { const int kb = r / 65, nb = r % 65; transpose_item(w_in + (size_t)L * DM * INW, DM, INW, g_attn + L * DM + 64 * kb, (bf16_t*)(ws + WS_WIN + L * SZ_WIN), RmIn{((WS_WG + L * SZ_WG) - (WS_WIN + L * SZ_WIN)) / 2}, scr, kb, nb, lane); return; } r -= I_IN;
    if (r < I_OUT) { const int kb = r / 32, nb = r % 32, k0 = 64 * kb;
        const float* g = k0 < 512 ? g_oa + L * 512 + k0 : (k0 < 768 ? g_ob + L * 256 + (k0 - 512) : g_oc + L * 256 + (k0 - 768));
        transpose_item(w_out + (size_t)L * DM * DM, DM, DM, g, (bf16_t*)(ws + WS_WOUT + L * SZ_WOUT), RmId{DM}, scr, kb, nb, lane); return; } r -= I_OUT;
    if (r < I_G) { const int kb = r / 88, nb = r % 88; transpose_item(w_gate + (size_t)L * DM * DFF, DM, DFF, g_ffn + L * DM + 64 * kb, (bf16_t*)(ws + WS_WGU + L * SZ_WGU), RmGU{0}, scr, kb, nb, lane); return; } r -= I_G;
    if (r < I_G) { const int kb = r / 88, nb = r % 88; transpose_item(w_up + (size_t)L * DM * DFF, DM, DFF, g_ffn + L * DM + 64 * kb, (bf16_t*)(ws + WS_WGU + L * SZ_WGU), RmGU{1}, scr, kb, nb, lane); return; } r -= I_G;
    if (r < I_DN) { const int kb = r / 32, nb = r % 32; transpose_item(w_down + (size_t)L * DFF * DM, DFF, DM, nullptr, (bf16_t*)(ws + WS_WDN + L * SZ_WDN), RmId{DFF}, scr, kb, nb, lane); return; } r -= I_DN;
    if (r < I_W1) { const int kv = r / 128, r2 = r % 128, kb = r2 / 4, nb = r2 % 4;
        transpose_item(cmp_w1 + ((size_t)L * 2 + kv) * 2048 * 128, 2048, 128, nullptr, (bf16_t*)(ws + WS_W1T + L * SZ_W1T) + (size_t)kv * 128 * 2048, RmW1(), scr, kb, nb, lane); return; } r -= I_W1;
    { const int kv = r / 4, r2 = r % 4, kb = r2 / 2, nb = r2 % 2;
        transpose_item(cmp_w2 + ((size_t)L * 2 + kv) * 128 * 64, 128, 64, nullptr, (bf16_t*)(ws + WS_W2T + L * SZ_W2T) + (size_t)kv * 64 * 128, RmId{128}, scr, kb, nb, lane); }
}
__device__ __forceinline__ void prologue(const Params& p, ldsp lds, int tid) {
    const int lane = tid & 63, wave = tid >> 6, gw = blockIdx.x * 8 + wave, NGW = gridDim.x * 8;
    LAS float* scr = (LAS float*)(lds + wave * 16384);
    unsigned char* ws = p.ws;
    const float *cmp_pos = p.in[9], *cmp_w1 = p.in[10];
#ifdef CONV_IN_P0
    for (int it = gw; it < DEPTH * I_LAYER; it += NGW) convert_item(p, it / I_LAYER, it % I_LAYER, scr, lane);
#else
    for (int it = gw; it < I_LAYER; it += NGW) convert_item(p, 0, it, scr, lane);
#endif
    { const int gt = blockIdx.x * 512 + tid;
      if (gt < DEPTH * 256) { const int L = gt / 256, kv = (gt >> 7) & 1, f = gt & 127; const float* pos = cmp_pos + ((size_t)L * 2 + kv) * 2048; const float* w1 = cmp_w1 + ((size_t)L * 2 + kv) * 2048 * 128 + f;
          float s = 0.f; for (int k = 0; k < 2048; ++k) s += pos[k] * w1[(size_t)k * 128];
          ((float*)(ws + WS_B1 + L * SZ_B1))[kv * 128 + f] = s; } }
    { const float* x = p.in[0]; bf16_t* xb = (bf16_t*)(ws + WS_XB); float* ss = (float*)(ws + WS_SS);
      for (int row0 = 2 * gw; row0 < MTOK; row0 += 2 * NGW) { f32x4 v[2][4];
#pragma unroll
          for (int q = 0; q < 2; ++q)
#pragma unroll
              for (int j = 0; j < 2; ++j) { const float* xr = x + (size_t)(row0 + q) * DM + 512 * j + 8 * lane; v[q][2 * j] = *(const f32x4*)xr; v[q][2 * j + 1] = *(const f32x4*)(xr + 4); }
#pragma unroll
          for (int q = 0; q < 2; ++q) { float s = 0.f;
#pragma unroll
              for (int j = 0; j < 2; ++j) { const f32x4 a = v[q][2 * j], b = v[q][2 * j + 1];
                  s += ((a[0] * a[0] + a[1] * a[1]) + (a[2] * a[2] + a[3] * a[3])) + ((b[0] * b[0] + b[1] * b[1]) + (b[2] * b[2] + b[3] * b[3]));
                  u32x4 o; o.x = mx::pk2(a[0], a[1]); o.y = mx::pk2(a[2], a[3]); o.z = mx::pk2(b[0], b[1]); o.w = mx::pk2(b[2], b[3]);
                  *(u32x4*)(xb + (size_t)(row0 + q) * DM + 512 * j + 8 * lane) = o; }
              s = wave_sum(s);
              if (lane < 16) ss[(size_t)(row0 + q) * 16 + lane] = lane == 0 ? s : 0.f; } } }
}
__device__ __forceinline__ void final_norm(const Params& p, int tid) {
    const int lane = tid & 63, wave = tid >> 6, gw = blockIdx.x * 8 + wave, NGW = gridDim.x * 8;
    const float* ss = (const float*)(p.ws + WS_SS); const float* g = p.in[15]; float* out = p.out; const bf16_t* xb = (const bf16_t*)(p.ws + WS_XB);
    f32x4 gv[4];
#pragma unroll
    for (int j = 0; j < 2; ++j) { gv[2 * j] = *(const f32x4*)(g + 512 * j + 8 * lane); gv[2 * j + 1] = *(const f32x4*)(g + 512 * j + 8 * lane + 4); }
    for (int row0 = 2 * gw; row0 < MTOK; row0 += 2 * NGW) {
        float s[2]; u32x4 w[2][2];
#pragma unroll
        for (int q = 0; q < 2; ++q) { const int row = row0 + q; s[q] = lane < 16 ? ss[(size_t)row * 16 + lane] : 0.f;
#pragma unroll
            for (int j = 0; j < 2; ++j) w[q][j] = *(const u32x4*)(xb + (size_t)row * DM + 512 * j + 8 * lane); }
#pragma unroll
        for (int q = 0; q < 2; ++q) { const int row = row0 + q; const float rs = 1.0f / sqrtf(wave_sum(s[q]) * (1.0f / 1024.0f) + 1e-6f);
#pragma unroll
            for (int j = 0; j < 2; ++j) { const u32x4 ww = w[q][j]; float* o = out + (size_t)row * DM + 512 * j + 8 * lane;
                f32x4 a, b; a[0] = __uint_as_float(ww.x << 16); a[1] = __uint_as_float(ww.x & 0xffff0000u); a[2] = __uint_as_float(ww.y << 16); a[3] = __uint_as_float(ww.y & 0xffff0000u);
                b[0] = __uint_as_float(ww.z << 16); b[1] = __uint_as_float(ww.z & 0xffff0000u); b[2] = __uint_as_float(ww.w << 16); b[3] = __uint_as_float(ww.w & 0xffff0000u);
                *(f32x4*)o = a * rs * gv[2 * j]; *(f32x4*)(o + 4) = b * rs * gv[2 * j + 1]; } }
    }
}
__device__ __forceinline__ int opq_s(int v) { asm volatile("" : "+s"(v)); return v; }
__device__ __forceinline__ int q_next(unsigned* ctr, LAS unsigned* slot, int tid) {
    __syncthreads();
    if (tid == 0) *slot = atomicAdd(ctr, 1u);
    __syncthreads();
    return (int)*slot;
}

__global__ void __launch_bounds__(512, 2) mk_fwd(Params p) {
    extern __shared__ __attribute__((aligned(16))) unsigned char lds_raw[];
    ldsp lds = (ldsp)lds_raw;
    cg::grid_group grid = cg::this_grid();
    const int lo = p.ph_lo, hi = p.ph_hi;
#define OPAQUE_TID() int tid = threadIdx.x; asm volatile("" : "+v"(tid))
    unsigned char* ws = p.ws;
    LAS unsigned* slot = (LAS unsigned*)(lds + LDS_CTL);
    bf16_t* XB = (bf16_t*)(ws + WS_XB); bf16_t* PROJ = (bf16_t*)(ws + WS_PROJ); bf16_t* MIXN = (bf16_t*)(ws + WS_MIXN); bf16_t* HID = (bf16_t*)(ws + WS_HID);
    bf16_t* KC = (bf16_t*)(ws + WS_KC); bf16_t* VC = (bf16_t*)(ws + WS_VC); float* SS = (float*)(ws + WS_SS);
    if (threadIdx.x < 8) slot[4 + threadIdx.x] = 0u;
    __syncthreads();
    const XcdBarrier xbar = xcd_barrier_post((unsigned*)(ws + WS_BAR), (volatile LAS unsigned*)(slot + 4));
    int ph = 0;
#ifdef TIMING_PROBE
    unsigned long long tp0 = __builtin_amdgcn_s_memrealtime(), tcat[4] = {0ull, 0ull, 0ull, 0ull};
#define TCAT(c) do { const unsigned long long tn = __builtin_amdgcn_s_memrealtime(); tcat[c] += tn - tp0; tp0 = tn; } while (0)
#else
#define TCAT(c) do {} while (0)
#endif
#ifndef REP_FINAL
#define REP_FINAL 1
#endif
#ifndef REP_RES
#define REP_RES 1
#endif
#ifndef REP_P0
#define REP_P0 1
#endif
#ifndef REP_P2
#define REP_P2 1
#endif
#ifndef REP_P3
#define REP_P3 1
#endif
#ifndef REP_GEMM
#define REP_GEMM 1
#endif
#ifndef REP_SYNC
#define REP_SYNC 1
#endif
#define RUN() (lo <= ph && ph < hi)
#define SEAM(c) do { TCAT(c); if (RUN() && ph + 1 < hi) { for (int rs_ = 0; rs_ < REP_SYNC; ++rs_) { if (lo < 0) grid.sync(); else xcd_barrier(xbar); }     } TCAT(2); ++ph; } while (0)
    #ifndef SKIP_P0
    if (RUN()) for (int rep_ = 0; rep_ < REP_P0; ++rep_) { if (rep_) xcd_barrier(xbar); OPAQUE_TID(); prologue(p, lds, tid); }
#endif
    SEAM(3);
    for (int L_ = 0; L_ < DEPTH; ++L_) {
#ifndef SKIP_G1
        if (RUN()) if (const int L = opq_s(L_); true) for (int rep_ = 0; rep_ < REP_GEMM; ++rep_) { if (rep_) xcd_barrier(xbar); pg8::Gemm g{XB, (const bf16_t*)(ws + WS_WIN + L * SZ_WIN), MTOK, NPROJ, DM}; pg8::StaticOrder S; S.init(MTOK, NPROJ, (int)gridDim.x, (int)blockIdx.x);
            pg8::EpiProj E{PROJ, mx::LDP, SS};
            pg8::gemm_phase<pg8::EpiProj, pg8::StaticOrder, true, true>((PG8_LAS unsigned char*)lds, g, S, E); }
#endif
        SEAM(0);
#ifndef SKIP_P2
        if (RUN()) if (const int L = opq_s(L_); true) for (int rep_ = 0; rep_ < REP_P2; ++rep_) { if (rep_) xcd_barrier(xbar); OPAQUE_TID(); unsigned* ctr = (unsigned*)(ws + WS_CTR) + 64 * (ph + 32 * rep_);
            int u = q_next(ctr, slot, tid);
#ifdef CONV_IN_P0
            const int nq = 32 + 2048;
#else
            const int nq = 32 + 2048 + (L + 1 < DEPTH ? CONV_UNITS : 0);
#endif
            while (u < nq) {
                if (u < 32) {
#ifndef SKIP_CMP
 mx::unitCmp(PROJ, (const bf16_t*)(ws + WS_W1T + L * SZ_W1T), (const bf16_t*)(ws + WS_W2T + L * SZ_W2T), (const float*)(ws + WS_B1 + L * SZ_B1), KC, VC, u, tid);
#endif
 }
                else if (u < 32 + 1024) {
#ifndef SKIP_C
 const int k = u - 32; mx::unitC(lds, PROJ, MIXN, k & 31, 31 - (k >> 5), tid);
#endif
 }
#ifndef CONV_IN_P0
                else if (u >= 32 + 2048) { const int it = (u - 32 - 2048) * 8 + (tid >> 6); if (it < I_LAYER) convert_item(p, L + 1, it, (LAS float*)(lds + (tid >> 6) * 16384), tid & 63); }
#endif
                else {
#ifndef SKIP_A
 const int k = u - 32 - 1024; mx::unitA(lds, PROJ, MIXN, p.in[8] + L * 8, k & 31, 31 - (k >> 5), tid);
#endif
 }
                u = q_next(ctr, slot, tid); } }
#endif
        SEAM(1);
#ifndef SKIP_P3
        if (RUN()) if (const int L = opq_s(L_); true) for (int rep_ = 0; rep_ < REP_P3; ++rep_) { if (rep_) xcd_barrier(xbar); OPAQUE_TID(); unsigned* ctr = (unsigned*)(ws + WS_CTR) + 64 * (ph + 32 * rep_);
            int u = q_next(ctr, slot, tid);
            while (u < 1024) { unsigned nxt_ = 0u; if (tid == 0) nxt_ = atomicAdd(ctr, 1u); mx::unitB(lds, PROJ, KC, VC, MIXN, XB, SS, (const bf16_t*)(ws + WS_WG + L * SZ_WG), u & 31, 31 - (u >> 5), tid);
                __syncthreads(); if (tid == 0) *slot = nxt_; __syncthreads(); u = (int)*slot; } }
#endif
        SEAM(1);
#ifndef SKIP_G4
        if (RUN()) if (const int L = opq_s(L_); true) for (int rep_ = 0; rep_ < REP_RES; ++rep_) { if (rep_) xcd_barrier(xbar); pg8::Gemm g{MIXN, (const bf16_t*)(ws + WS_WOUT + L * SZ_WOUT), MTOK, DM, DM}; pg8::StaticOrder S; S.init(MTOK, DM, (int)gridDim.x, (int)blockIdx.x);
            pg8::EpiRes E{XB, rep_ + 1 < REP_RES ? (float*)(ws + WS_END + 256 * MiB) : SS, rep_ + 1 < REP_RES ? (bf16_t*)(ws + WS_END) : XB};
            pg8::gemm_phase<pg8::EpiRes, pg8::StaticOrder, true, true>((PG8_LAS unsigned char*)lds, g, S, E); }
#endif
        SEAM(0);
#ifndef SKIP_G5
        if (RUN()) if (const int L = opq_s(L_); true) for (int rep_ = 0; rep_ < REP_GEMM; ++rep_) { if (rep_) xcd_barrier(xbar); pg8::Gemm g{XB, (const bf16_t*)(ws + WS_WGU + L * SZ_WGU), MTOK, NGU, DM}; pg8::StaticOrder S; S.init(MTOK, NGU, (int)gridDim.x, (int)blockIdx.x);
            pg8::EpiGU E{HID, DFF, SS};
            pg8::gemm_phase<pg8::EpiGU, pg8::StaticOrder, true, true>((PG8_LAS unsigned char*)lds, g, S, E); }
#endif
        SEAM(0);
#ifndef SKIP_G6
        if (RUN()) if (const int L = opq_s(L_); true) for (int rep_ = 0; rep_ < REP_RES; ++rep_) { if (rep_) xcd_barrier(xbar); pg8::Gemm g{HID, (const bf16_t*)(ws + WS_WDN + L * SZ_WDN), MTOK, DM, DFF}; pg8::StaticOrder S; S.init(MTOK, DM, (int)gridDim.x, (int)blockIdx.x);
            pg8::EpiRes E{XB, rep_ + 1 < REP_RES ? (float*)(ws + WS_END + 256 * MiB) : SS, rep_ + 1 < REP_RES ? (bf16_t*)(ws + WS_END) : XB};
            pg8::gemm_phase<pg8::EpiRes, pg8::StaticOrder, true, true>((PG8_LAS unsigned char*)lds, g, S, E); }
#endif
        SEAM(0);
    }
    if (RUN()) for (int rep_ = 0; rep_ < REP_FINAL; ++rep_) { OPAQUE_TID(); final_norm(p, tid); }
#ifdef TIMING_PROBE
    TCAT(3);
    grid.sync();
    if (blockIdx.x == 0 && threadIdx.x == 0) {
        const float va = (float)(tcat[TIMING_PROBE / 10] / 100ull), vb = (float)(tcat[TIMING_PROBE % 10] / 100ull);
        asm volatile("s_waitcnt vmcnt(0)" ::: "memory");
        p.out[0] = va; for (int i = 0; i < 10000; ++i) p.out[2048 + i] = vb;
    }
#endif
#undef RUN
#undef SEAM
}

#ifndef MK_PER_PHASE
#define MK_PER_PHASE 0
#endif
extern "C" void kernel_launch(void* const* d_in, const int* in_sizes, int n_in, void* d_out, int out_size, void* d_ws, size_t ws_size, hipStream_t stream) {
    static int grid = 0;
    if (grid == 0) {
        if (n_in != 16 || out_size != MTOK * DM || ws_size < WS_END) { fprintf(stderr, "kernel_launch: unexpected shapes (n_in %d, out %d, ws %zu)\n", n_in, out_size, ws_size); grid = -1; return; }
        int dev = 0, cus = 0, per_cu = 0;
        hipGetDevice(&dev); hipDeviceGetAttribute(&cus, hipDeviceAttributeMultiprocessorCount, dev);
        if (hipFuncSetAttribute((const void*)mk_fwd, hipFuncAttributeMaxDynamicSharedMemorySize, LDS_BYTES) != hipSuccess) { fprintf(stderr, "kernel_launch: hipFuncSetAttribute failed\n"); grid = -1; return; }
        if (hipOccupancyMaxActiveBlocksPerMultiprocessor(&per_cu, (const void*)mk_fwd, 512, LDS_BYTES) != hipSuccess || per_cu < 1) { fprintf(stderr, "kernel_launch: occupancy query says %d\n", per_cu); per_cu = 1; }
        (void)hipGetLastError();
        grid = cus;
    }
    if (grid < 0) return;
    if (hipMemsetAsync(d_ws, 0, WS_ZERO_BYTES, stream) != hipSuccess) { fprintf(stderr, "kernel_launch: memset failed\n"); return; }
    Params p{};
    for (int i = 0; i < 16; ++i) p.in[i] = (const float*)d_in[i];
    p.out = (float*)d_out; p.ws = (unsigned char*)d_ws;
#if MK_PER_PHASE
    for (int ph = 0; ph < NPHASE; ++ph) { p.ph_lo = ph; p.ph_hi = ph + 1; hipLaunchKernelGGL(mk_fwd, dim3(grid), dim3(512), LDS_BYTES, stream, p); }
#else
    p.ph_lo = 0; p.ph_hi = NPHASE;
    void* args[] = {&p};
    hipError_t e = hipLaunchCooperativeKernel((const void*)mk_fwd, dim3(grid), dim3(512), args, LDS_BYTES, stream);
    if (e != hipSuccess) fprintf(stderr, "kernel_launch: cooperative launch failed: %s (grid %d)\n", hipGetErrorString(e), grid);
#endif
}
```

```cpp
#include <hip/hip_runtime.h>
#include <hip/hip_cooperative_groups.h>
#include <cstdio>
#include <cstdint>
namespace cg = cooperative_groups;
namespace pg8 {
#define PG8_LAS __attribute__((address_space(3)))
typedef unsigned short bf16_t;
typedef short bf16x8 __attribute__((ext_vector_type(8)));
typedef float f32x4 __attribute__((ext_vector_type(4)));
typedef unsigned u32x4 __attribute__((ext_vector_type(4)));
constexpr int BM = 256, BK = 64, HALF = 128, HTB = HALF * BK * 2  , STAGE_BYTES = 8 * HTB, NXCD = 8, WGM = 8;

__host__ __device__ __forceinline__ int lds_byte(int r, int c) { const int st = (r >> 4) * 2 + (c >> 5), rr = r & 15, cc = c & 31, ob = rr * 64 + cc * 2; return st * 1024 + (ob ^ (((ob >> 9) & 1) << 5)); }
__host__ __device__ __forceinline__ void stage_rc(int b, int& R, int& C) { const int st = b / 1024, sb = b % 1024, swz = sb ^ (((sb >> 9) & 1) << 5); R = (st >> 1) * 16 + swz / 64; C = (st & 1) * 32 + (swz % 64) / 2; }
__host__ __device__ __forceinline__ int perm32(int rho) { const int n = rho >> 4, i = rho & 15; return 8 * (i >> 2) + 4 * n + (i & 3); }

struct Unit { int pm, pn; };
struct Gemm { const bf16_t* A; const bf16_t* Bt; int M, N, K; };

struct StaticOrder {
    int nM, nN, nwg, G, c;
    __host__ __device__ void init(int M, int N, int G_, int c_) { nM = M / BM; nN = N / BM; nwg = nM * nN; G = G_; c = c_; }
    __host__ __device__ bool next(int i, Unit& u) const {
        const long L = (long)i * G + c; if (L >= nwg) return false;
        int wgid = (int)L; { const int q = nwg / NXCD, r = nwg % NXCD, xcd = wgid % NXCD, off = wgid / NXCD; wgid = (xcd < r ? xcd * (q + 1) : r * (q + 1) + (xcd - r) * q) + off; }
        const int nig = WGM * nN, gid = wgid / nig, fm = gid * WGM, gsz = (nM - fm) < WGM ? (nM - fm) : WGM;
        u.pm = fm + ((wgid % nig) % gsz); u.pn = (wgid % nig) / gsz; return true;
    }
    __device__ __forceinline__ void a_ready(const Unit&) const {}
    __device__ __forceinline__ void done(const Unit&) const {}
};

__device__ __forceinline__ unsigned cvt_pk_bf16(float lo, float hi) { unsigned r; asm volatile("v_cvt_pk_bf16_f32 %0, %1, %2" : "=v"(r) : "v"(lo), "v"(hi)); return r; }
typedef float f32x2 __attribute__((ext_vector_type(2)));
typedef unsigned u32x2 __attribute__((ext_vector_type(2)));
__device__ __forceinline__ float row_rstd(const float* ss, int row, int fq) {
    const f32x4 v = *(const f32x4*)(ss + (size_t)row * 16 + 4 * fq);
    float s = (v[0] + v[1]) + (v[2] + v[3]);
    s += __shfl_xor(s, 16); s += __shfl_xor(s, 32);
    return __builtin_amdgcn_rsqf(s * (1.0f / 1024.0f) + 1e-6f);
}
__device__ __forceinline__ void row_rstd8(const float* ss, int row0, int fq, float (&rs)[2][4]) {
    f32x4 v[2][4];
#pragma unroll
    for (int ai = 0; ai < 2; ++ai)
#pragma unroll
        for (int m = 0; m < 4; ++m) v[ai][m] = *(const f32x4*)(ss + (size_t)(row0 + ai * HALF + m * 16) * 16 + 4 * fq);
#pragma unroll
    for (int ai = 0; ai < 2; ++ai)
#pragma unroll
        for (int m = 0; m < 4; ++m) { float s = (v[ai][m][0] + v[ai][m][1]) + (v[ai][m][2] + v[ai][m][3]); s += __shfl_xor(s, 16); s += __shfl_xor(s, 32);
            rs[ai][m] = __builtin_amdgcn_rsqf(s * (1.0f / 1024.0f) + 1e-6f); }
}
struct EpiProj {
    static constexpr bool PERM = true, AFTER_DRAIN = false;
    bf16_t* O; int ldc; const float* ss;
    __device__ __forceinline__ void operator()(const f32x4 (&acc)[2][2][4][2], const Unit& u, int wr, int wc, int fr, int fq) const {
        const int row0 = u.pm * BM + wr * 64 + fr, col0 = u.pn * BM + wc * 32 + 8 * fq;
        float rsv[2][4]; row_rstd8(ss, row0, fq, rsv);
#pragma unroll
        for (int ai = 0; ai < 2; ++ai)
#pragma unroll
            for (int m = 0; m < 4; ++m) { const int row = row0 + ai * HALF + m * 16; const float rs = rsv[ai][m]; bf16_t* rowp = O + (size_t)row * ldc + col0;
#pragma unroll
                for (int bj = 0; bj < 2; ++bj) { const f32x4 v0 = acc[ai][bj][m][0] * rs, v1 = acc[ai][bj][m][1] * rs;
                    u32x4 w; w.x = cvt_pk_bf16(v0[0], v0[1]); w.y = cvt_pk_bf16(v0[2], v0[3]); w.z = cvt_pk_bf16(v1[0], v1[1]); w.w = cvt_pk_bf16(v1[2], v1[3]);
                    *(u32x4*)(rowp + bj * HALF) = w; }
                if (m & 1) asm volatile("" ::: "memory"); }
    }
};
__device__ __forceinline__ float silu_mul(float g, float u) { return g * __builtin_amdgcn_rcpf(1.0f + __expf(-g)) * u; }
struct EpiGU {
    static constexpr bool PERM = true, AFTER_DRAIN = false;
    bf16_t* O; int ldc; const float* ss;
    __device__ __forceinline__ void operator()(const f32x4 (&acc)[2][2][4][2], const Unit& u, int wr, int wc, int fr, int fq) const {
        const int row0 = u.pm * BM + wr * 64 + fr, col0 = u.pn * HALF + wc * 32 + 8 * fq;
        float rsv[2][4]; row_rstd8(ss, row0, fq, rsv);
#pragma unroll
        for (int ai = 0; ai < 2; ++ai)
#pragma unroll
            for (int m = 0; m < 4; ++m) { const int row = row0 + ai * HALF + m * 16; const float rs = rsv[ai][m];
                const f32x4 g0 = acc[ai][0][m][0] * rs, g1 = acc[ai][0][m][1] * rs, u0 = acc[ai][1][m][0] * rs, u1 = acc[ai][1][m][1] * rs;
                u32x4 w; w.x = cvt_pk_bf16(silu_mul(g0[0], u0[0]), silu_mul(g0[1], u0[1])); w.y = cvt_pk_bf16(silu_mul(g0[2], u0[2]), silu_mul(g0[3], u0[3]));
                w.z = cvt_pk_bf16(silu_mul(g1[0], u1[0]), silu_mul(g1[1], u1[1])); w.w = cvt_pk_bf16(silu_mul(g1[2], u1[2]), silu_mul(g1[3], u1[3]));
                *(u32x4*)(O + (size_t)row * ldc + col0) = w;
                if (m & 1) asm volatile("" ::: "memory"); }
    }
};
__device__ __forceinline__ float bflo(unsigned w) { return __uint_as_float(w << 16); }
__device__ __forceinline__ float bfhi(unsigned w) { return __uint_as_float(w & 0xffff0000u); }
struct EpiRes {
    static constexpr bool PERM = true, AFTER_DRAIN = false;
    bf16_t* xb; float* ss; bf16_t* xo_;
    __device__ __forceinline__ void operator()(const f32x4 (&acc)[2][2][4][2], const Unit& u, int wr, int wc, int fr, int fq) const {
        const int row0 = u.pm * BM + wr * 64 + fr, col0 = u.pn * BM + wc * 32 + 8 * fq;
#pragma unroll
        for (int ai = 0; ai < 2; ++ai) {
            u32x4 xi[4][2];
#pragma unroll
            for (int m = 0; m < 4; ++m)
#pragma unroll
                for (int bj = 0; bj < 2; ++bj) xi[m][bj] = *(const u32x4*)(xb + (size_t)(row0 + ai * HALF + m * 16) * 1024 + col0 + bj * HALF);
#pragma unroll
            for (int m = 0; m < 4; ++m) { const int row = row0 + ai * HALF + m * 16; float s = 0.f;
#pragma unroll
                for (int bj = 0; bj < 2; ++bj) { const u32x4 xw = xi[m][bj]; const f32x4 a0 = acc[ai][bj][m][0], a1 = acc[ai][bj][m][1];
                    const float v0 = bflo(xw.x) + a0[0], v1 = bfhi(xw.x) + a0[1], v2 = bflo(xw.y) + a0[2], v3 = bfhi(xw.y) + a0[3];
                    const float v4 = bflo(xw.z) + a1[0], v5 = bfhi(xw.z) + a1[1], v6 = bflo(xw.w) + a1[2], v7 = bfhi(xw.w) + a1[3];
                    u32x4 w; w.x = cvt_pk_bf16(v0, v1); w.y = cvt_pk_bf16(v2, v3); w.z = cvt_pk_bf16(v4, v5); w.w = cvt_pk_bf16(v6, v7);
                    *(u32x4*)(xo_ + (size_t)row * 1024 + col0 + bj * HALF) = w;
                    s += ((v0 * v0 + v1 * v1) + (v2 * v2 + v3 * v3)) + ((v4 * v4 + v5 * v5) + (v6 * v6 + v7 * v7)); }
                s += __shfl_xor(s, 16); s += __shfl_xor(s, 32);
                if (fq == 0) ss[(size_t)row * 16 + u.pn * 4 + wc] = s; }
            asm volatile("" ::: "memory"); }
    }
};
template <class Epi, class Sched, bool ALIGN_EPI = false, bool SP2 = false>
__device__ __forceinline__ void gemm_phase(PG8_LAS unsigned char* lds, const Gemm g, const Sched& S, const Epi& E) {
    int tid_ = threadIdx.x; asm volatile("" : "+v"(tid_)); const int tid = tid_, wid = __builtin_amdgcn_readfirstlane(tid >> 6), lane = tid & 63, wr = wid >> 2, wc = wid & 3, fr = lane & 15, fq = lane >> 4;
    const int K = g.K, nt = K / BK;
    unsigned voffA[2], voffB[2];
#pragma unroll
    for (int i = 0; i < 2; ++i) { int R, C; stage_rc(tid * 16 + i * 8192, R, C); const int Rb = Epi::PERM ? ((R & ~31) + perm32(R & 31)) : R;
        voffA[i] = (unsigned)(R * K + C) * 2u; voffB[i] = (unsigned)(Rb * K + C) * 2u; }
    const size_t kstep = (size_t)(BK * 2);
    const size_t hstep = (size_t)HALF * K * 2;
    const size_t tstep = 2 * hstep;
    const unsigned ldsw = (unsigned)wid * 1024u;
    const int aoff = lds_byte(wr * 64 + fr, fq * 8), boff = lds_byte(wc * 32 + fr, fq * 8);
#define PG8_SA(b, h) (((b) * 2 + (h)) * HTB)
#define PG8_SB(b, h) ((4 + (b) * 2 + (h)) * HTB)
#define PG8_STAGE(bufoff, gbase, voff) do { _Pragma("unroll") for (int _i = 0; _i < 2; ++_i) \
        __builtin_amdgcn_global_load_lds((const unsigned*)((const char*)(gbase) + (voff)[_i]), (PG8_LAS unsigned*)(lds + (bufoff) + ldsw + _i * 8192), 16, 0, 0); } while (0)
#define PG8_LDA(dst, b, h) do { _Pragma("unroll") for (int m = 0; m < 4; ++m) _Pragma("unroll") for (int k = 0; k < 2; ++k) dst[m][k] = *(const PG8_LAS bf16x8*)(lds + PG8_SA(b, h) + aoff + m * 2048 + k * 1024); } while (0)
#define PG8_LDB(dst, b, h) do { _Pragma("unroll") for (int n = 0; n < 2; ++n) _Pragma("unroll") for (int k = 0; k < 2; ++k) dst[n][k] = *(const PG8_LAS bf16x8*)(lds + PG8_SB(b, h) + boff + n * 2048 + k * 1024); } while (0)
#define PG8_MMA(ai, bj, At, Bt) do { __builtin_amdgcn_s_setprio(1); _Pragma("unroll") for (int m = 0; m < 4; ++m) _Pragma("unroll") for (int n = 0; n < 2; ++n) _Pragma("unroll") for (int k = 0; k < 2; ++k) \
        acc[ai][bj][m][n] = __builtin_amdgcn_mfma_f32_16x16x32_bf16(Bt[n][k], At[m][k], acc[ai][bj][m][n], 0, 0, 0); __builtin_amdgcn_s_setprio(0); } while (0)
#define PG8_WAIT_V(n) asm volatile("s_waitcnt vmcnt(" #n ")" ::: "memory")
#define PG8_WAIT_L(n) asm volatile("s_waitcnt lgkmcnt(" #n ")" ::: "memory")
#define PG8_BAR __builtin_amdgcn_s_barrier()
#define PG8_SCHED __builtin_amdgcn_sched_barrier(0)
    Unit cur, nxt; int ui = 0;
    if (!S.next(0, cur)) return;
    f32x4 acc[2][2][4][2];
#pragma unroll
    for (int a = 0; a < 2; ++a)
#pragma unroll
        for (int b = 0; b < 2; ++b)
#pragma unroll
            for (int m = 0; m < 4; ++m)
#pragma unroll
                for (int n = 0; n < 2; ++n) acc[a][b][m][n] = (f32x4){0.f, 0.f, 0.f, 0.f};
    bf16x8 At[4][2], B0[2][2], B1[2][2];
    const char* cA = (const char*)g.A + (size_t)cur.pm * tstep; const char* cB = (const char*)g.Bt + (size_t)cur.pn * tstep;
    S.a_ready(cur);
    if constexpr (SP2) {
        PG8_STAGE(PG8_SB(0, 0), cB, voffB); PG8_STAGE(PG8_SB(0, 1), cB + hstep, voffB); PG8_STAGE(PG8_SA(0, 0), cA, voffA); PG8_STAGE(PG8_SA(0, 1), cA + hstep, voffA);
        if (wr == 1) PG8_BAR;
        PG8_WAIT_V(2); PG8_BAR;
        PG8_STAGE(PG8_SB(1, 0), cB + kstep, voffB); PG8_STAGE(PG8_SA(1, 0), cA + kstep, voffA); PG8_STAGE(PG8_SB(1, 1), cB + hstep + kstep, voffB);
        PG8_WAIT_V(6); PG8_BAR;
    } else {
        PG8_STAGE(PG8_SB(0, 0), cB, voffB); PG8_STAGE(PG8_SA(0, 0), cA, voffA); PG8_STAGE(PG8_SB(0, 1), cB + hstep, voffB); PG8_STAGE(PG8_SA(0, 1), cA + hstep, voffA);
        if (wr == 1) PG8_BAR;
        PG8_WAIT_V(4); PG8_BAR;
        PG8_STAGE(PG8_SB(1, 0), cB + kstep, voffB); PG8_STAGE(PG8_SA(1, 0), cA + kstep, voffA); PG8_STAGE(PG8_SB(1, 1), cB + hstep + kstep, voffB);
        PG8_WAIT_V(6); PG8_BAR;
    }
    for (;;) {
        const bool has_next = S.next(ui + 1, nxt);
        const char* nA = has_next ? (const char*)g.A + (size_t)nxt.pm * tstep : cA; const char* nB = has_next ? (const char*)g.Bt + (size_t)nxt.pn * tstep : cB;
        for (int t = 0; t < nt; t += 2) {
            const bool last = (t == nt - 2);
            const char* a1 = cA + (size_t)(t + 1) * kstep;
            const char* a2 = last ? nA : cA + (size_t)(t + 2) * kstep; const char* b2 = last ? nB : cB + (size_t)(t + 2) * kstep;
            const char* a3 = a2 + kstep; const char* b3 = b2 + kstep;
            if (last && has_next) S.a_ready(nxt);
            if constexpr (SP2) {
            PG8_LDB(B0, 0, 0); PG8_LDB(B1, 0, 1); PG8_SCHED; PG8_LDA(At, 0, 0); PG8_STAGE(PG8_SA(1, 1), a1 + hstep, voffA);
            PG8_WAIT_V(8); PG8_WAIT_L(0); PG8_BAR; PG8_MMA(0, 0, At, B0); PG8_MMA(0, 1, At, B1); PG8_BAR; PG8_SCHED;
            PG8_LDA(At, 0, 1); PG8_STAGE(PG8_SB(0, 0), b2, voffB); PG8_STAGE(PG8_SB(0, 1), b2 + hstep, voffB); PG8_STAGE(PG8_SA(0, 0), a2, voffA);
            PG8_WAIT_V(8); PG8_WAIT_L(0); PG8_BAR; PG8_MMA(1, 0, At, B0); PG8_MMA(1, 1, At, B1); PG8_BAR; PG8_SCHED;
            PG8_LDB(B0, 1, 0); PG8_LDB(B1, 1, 1); PG8_SCHED; PG8_LDA(At, 1, 0); PG8_STAGE(PG8_SA(0, 1), a2 + hstep, voffA);
            PG8_WAIT_V(8); PG8_WAIT_L(0); PG8_BAR; PG8_MMA(0, 0, At, B0); PG8_MMA(0, 1, At, B1); PG8_BAR; PG8_SCHED;
            PG8_LDA(At, 1, 1); PG8_STAGE(PG8_SB(1, 0), b3, voffB); PG8_STAGE(PG8_SB(1, 1), b3 + hstep, voffB); PG8_STAGE(PG8_SA(1, 0), a3, voffA);
            PG8_WAIT_V(8); PG8_WAIT_L(0); PG8_BAR; PG8_MMA(1, 0, At, B0); PG8_MMA(1, 1, At, B1); PG8_BAR; PG8_SCHED;
            } else {
            PG8_LDB(B0, 0, 0); PG8_SCHED; PG8_LDA(At, 0, 0); PG8_STAGE(PG8_SA(1, 1), a1 + hstep, voffA);
            PG8_WAIT_L(8); PG8_BAR; PG8_WAIT_L(0); PG8_MMA(0, 0, At, B0); PG8_BAR; PG8_SCHED;
            PG8_LDB(B1, 0, 1); PG8_STAGE(PG8_SB(0, 0), b2, voffB);
            PG8_BAR; PG8_WAIT_L(0); PG8_MMA(0, 1, At, B1); PG8_BAR;
            PG8_LDA(At, 0, 1); PG8_STAGE(PG8_SA(0, 0), a2, voffA);
            PG8_BAR; PG8_WAIT_L(0); PG8_MMA(1, 0, At, B0); PG8_BAR; PG8_SCHED;
            PG8_STAGE(PG8_SB(0, 1), b2 + hstep, voffB);
            PG8_WAIT_V(6); PG8_BAR; PG8_MMA(1, 1, At, B1); PG8_BAR;
            PG8_LDB(B0, 1, 0); PG8_SCHED; PG8_LDA(At, 1, 0); PG8_STAGE(PG8_SA(0, 1), a2 + hstep, voffA);
            PG8_WAIT_L(8); PG8_BAR; PG8_WAIT_L(0); PG8_MMA(0, 0, At, B0); PG8_BAR; PG8_SCHED;
            PG8_LDB(B1, 1, 1); PG8_STAGE(PG8_SB(1, 0), b3, voffB);
            PG8_BAR; PG8_WAIT_L(0); PG8_MMA(0, 1, At, B1); PG8_BAR;
            PG8_LDA(At, 1, 1); PG8_STAGE(PG8_SA(1, 0), a3, voffA);
            PG8_BAR; PG8_WAIT_L(0); PG8_MMA(1, 0, At, B0); PG8_BAR; PG8_SCHED;
            PG8_STAGE(PG8_SB(1, 1), b3 + hstep, voffB);
            PG8_WAIT_V(6); PG8_BAR; PG8_MMA(1, 1, At, B1); PG8_BAR;
            }
        }
        if constexpr (ALIGN_EPI) { if (wr == 0) PG8_BAR; }
        if constexpr (!Epi::AFTER_DRAIN) { E(acc, cur, wr, wc, fr, fq); S.done(cur); }
        if (!has_next) break;
#pragma unroll
        for (int a = 0; a < 2; ++a)
#pragma unroll
            for (int b = 0; b < 2; ++b)
#pragma unroll
                for (int m = 0; m < 4; ++m)
#pragma unroll
                    for (int n = 0; n < 2; ++n) acc[a][b][m][n] = (f32x4){0.f, 0.f, 0.f, 0.f};
        cur = nxt; cA = nA; cB = nB; ++ui;
        if constexpr (ALIGN_EPI) { if (wr == 1) PG8_BAR; }
    }
    PG8_WAIT_V(0);
    if constexpr (!ALIGN_EPI) { if (wr == 0) PG8_BAR; }
    PG8_BAR;
    if constexpr (Epi::AFTER_DRAIN) { E.fused(acc, cur, wr, wc, fr, fq, lds, wid, lane); S.done(cur); }
#undef PG8_SA
#undef PG8_SB
#undef PG8_STAGE
#undef PG8_LDA
#undef PG8_LDB
#undef PG8_MMA
#undef PG8_WAIT_V
#undef PG8_WAIT_L
#undef PG8_BAR
#undef PG8_SCHED
}
}
namespace mx {
#define LAS __attribute__((address_space(3)))
typedef unsigned short bf16_t;
typedef short bf16x8 __attribute__((ext_vector_type(8)));
typedef short s16x4 __attribute__((ext_vector_type(4)));
typedef float f32x16 __attribute__((ext_vector_type(16)));
typedef float f32x2v __attribute__((ext_vector_type(2)));
typedef float f32x4v __attribute__((ext_vector_type(4)));
typedef __bf16 bf16x2v __attribute__((ext_vector_type(2)));
typedef unsigned u32x4 __attribute__((ext_vector_type(4)));
typedef unsigned u32x2 __attribute__((ext_vector_type(2)));
typedef LAS unsigned char* ldsp;
constexpr int TP = 144, TILE_B = 64 * TP;
constexpr int LDP = 2304, SEQ = 2048, DM = 1024;
constexpr float LOG2E = 1.4426950408889634f, KSC2 = 0.125f * 1.4426950408889634f, NEG = -1e30f;
constexpr int C_QA = 0, C_KA = 512, C_VA = 576, C_QB = 640, C_KCB = 896, C_VCB = 960, C_KSB = 1024, C_VSB = 1088, C_KWB = 1152, C_VWB = 1216, C_QC = 1280, C_KC = 1536, C_VC = 1792, C_GB = 2048;

__device__ __forceinline__ unsigned pk2(float lo, float hi) { f32x2v v = {lo, hi}; bf16x2v b = __builtin_convertvector(v, bf16x2v); return __builtin_bit_cast(unsigned, b); }
__device__ __forceinline__ float ex2(float x) { return __builtin_amdgcn_exp2f(x); }
__device__ __forceinline__ float bf2f(bf16_t v) { return __uint_as_float((unsigned)v << 16); }
__device__ __forceinline__ f32x16 zero16() { f32x16 z;
#pragma unroll
    for (int i = 0; i < 16; ++i) z[i] = 0.f; return z; }

__device__ __forceinline__ u32x4 tile_ld(const bf16_t* row0, size_t pitch, int tid) { return *(const u32x4*)(row0 + (size_t)(tid >> 3) * pitch + (tid & 7) * 8); }
__device__ __forceinline__ void tile_st(ldsp tile, int tid, u32x4 v) { *(LAS u32x4*)(tile + (tid >> 3) * TP + (tid & 7) * 16) = v; }

__device__ __forceinline__ void qk_tile(ldsp Kt, const bf16x8 (&qf)[4], int lane, f32x16& p0, f32x16& p1) {
    const int rho = lane & 31, h = lane >> 5;
    const int krow = 16 * ((rho >> 2) & 1) + (rho & 3) + 4 * (rho >> 3);
    ldsp kb = Kt + krow * TP + h * 16;
    p0 = zero16(); p1 = zero16();
#pragma unroll
    for (int s = 0; s < 4; ++s) {
        const bf16x8 a0 = *(const LAS bf16x8*)(kb + s * 32);
        const bf16x8 a1 = *(const LAS bf16x8*)(kb + 32 * TP + s * 32);
        p0 = __builtin_amdgcn_mfma_f32_32x32x16_bf16(a0, qf[s], p0, 0, 0, 0);
        p1 = __builtin_amdgcn_mfma_f32_32x32x16_bf16(a1, qf[s], p1, 0, 0, 0);
    }
}
__device__ __forceinline__ void qk_tile_pre(ldsp Kt, const bf16x8 (&qf)[4], int lane, f32x16& p0, f32x16& p1) {
    const int rho = lane & 31, h = lane >> 5;
    const int krow = 16 * ((rho >> 2) & 1) + (rho & 3) + 4 * (rho >> 3);
    ldsp kb = Kt + krow * TP + h * 16;
    bf16x8 a0[4], a1[4];
#pragma unroll
    for (int s = 0; s < 4; ++s) { a0[s] = *(const LAS bf16x8*)(kb + s * 32); a1[s] = *(const LAS bf16x8*)(kb + 32 * TP + s * 32); }
    asm volatile("" ::: "memory");
    p0 = zero16(); p1 = zero16();
#pragma unroll
    for (int s = 0; s < 4; ++s) { p0 = __builtin_amdgcn_mfma_f32_32x32x16_bf16(a0[s], qf[s], p0, 0, 0, 0); p1 = __builtin_amdgcn_mfma_f32_32x32x16_bf16(a1[s], qf[s], p1, 0, 0, 0); }
}
__device__ __forceinline__ s16x4 vtr(ldsp p) { return __builtin_bit_cast(s16x4, __builtin_amdgcn_ds_read_tr16_b64_v4i16((LAS s16x4*)p)); }
__device__ __forceinline__ void pv_tile(ldsp Vt, const f32x16& w0, const f32x16& w1, int lane, f32x16& o0, f32x16& o1) {
    const int i = lane & 15, g16 = lane >> 4, D0 = 16 * (g16 & 1), h = g16 >> 1;
    ldsp vb = Vt + (16 * h + (i >> 2)) * TP + (D0 + 4 * (i & 3)) * 2;
#pragma unroll
    for (int sp = 0; sp < 4; ++sp) {
        u32x4 pw;
        if (sp < 2) { const int rb = (sp & 1) * 8; pw.x = pk2(w0[rb], w0[rb + 1]); pw.y = pk2(w0[rb + 2], w0[rb + 3]); pw.z = pk2(w0[rb + 4], w0[rb + 5]); pw.w = pk2(w0[rb + 6], w0[rb + 7]); }
        else        { const int rb = (sp & 1) * 8; pw.x = pk2(w1[rb], w1[rb + 1]); pw.y = pk2(w1[rb + 2], w1[rb + 3]); pw.z = pk2(w1[rb + 4], w1[rb + 5]); pw.w = pk2(w1[rb + 6], w1[rb + 7]); }
        const bf16x8 pb = __builtin_bit_cast(bf16x8, pw);
        const int key0 = 32 * (sp >> 1) + 8 * (sp & 1);
        {   const s16x4 lo = vtr(vb + key0 * TP), hi = vtr(vb + (key0 + 4) * TP);
            const bf16x8 a = {lo[0], lo[1], lo[2], lo[3], hi[0], hi[1], hi[2], hi[3]};
            o0 = __builtin_amdgcn_mfma_f32_32x32x16_bf16(a, pb, o0, 0, 0, 0); }
        {   const s16x4 lo = vtr(vb + key0 * TP + 64), hi = vtr(vb + (key0 + 4) * TP + 64);
            const bf16x8 a = {lo[0], lo[1], lo[2], lo[3], hi[0], hi[1], hi[2], hi[3]};
            o1 = __builtin_amdgcn_mfma_f32_32x32x16_bf16(a, pb, o1, 0, 0, 0); }
    }
}
__device__ __forceinline__ void softmax_step(f32x16& p0, f32x16& p1, float& m, float& l, f32x16& o0, f32x16& o1) {
    float mx = fmaxf(p0[0], p1[0]);
#pragma unroll
    for (int r = 1; r < 16; ++r) mx = fmaxf(mx, fmaxf(p0[r], p1[r]));
    mx = fmaxf(mx, __shfl_xor(mx, 32));
    const float mn = fmaxf(m, mx), alpha = ex2(m - mn);
    float ls = 0.f;
#pragma unroll
    for (int r = 0; r < 16; ++r) { p0[r] = p0[r] > -1e29f ? ex2(p0[r] - mn) : 0.f; p1[r] = p1[r] > -1e29f ? ex2(p1[r] - mn) : 0.f; ls += p0[r] + p1[r]; }
    ls += __shfl_xor(ls, 32);
    l = l * alpha + ls; m = mn; o0 *= alpha; o1 *= alpha;
}
__device__ __forceinline__ void prep_band(f32x16& p0, f32x16& p1, int tq, int tk0, int h, float slope2, int window, bool sel) {
#pragma unroll
    for (int r = 0; r < 16; ++r) {
        const int d0 = tq - (tk0 + 16 * h + r), d1 = d0 - 32;
        p0[r] = (sel && d0 >= 0 && d0 < window) ? p0[r] * KSC2 - slope2 * (float)d0 : NEG;
        p1[r] = (sel && d1 >= 0 && d1 < window) ? p1[r] * KSC2 - slope2 * (float)d1 : NEG;
    }
}
__device__ __forceinline__ void store_o(bf16_t* dst, const f32x16& o0, const f32x16& o1, float sc, int h) {
#pragma unroll
    for (int g = 0; g < 4; ++g) {
        u32x2 a; a.x = pk2(o0[4 * g] * sc, o0[4 * g + 1] * sc); a.y = pk2(o0[4 * g + 2] * sc, o0[4 * g + 3] * sc);
        u32x2 b; b.x = pk2(o1[4 * g] * sc, o1[4 * g + 1] * sc); b.y = pk2(o1[4 * g + 2] * sc, o1[4 * g + 3] * sc);
        *(u32x2*)(dst + 8 * g + 4 * h) = a; *(u32x2*)(dst + 32 + 8 * g + 4 * h) = b;
    }
}
__device__ __forceinline__ float sumsq(const f32x16& o0, const f32x16& o1) { float s = 0.f;
#pragma unroll
    for (int r = 0; r < 16; ++r) s += o0[r] * o0[r] + o1[r] * o1[r]; return s; }

__device__ __forceinline__ void unitA(ldsp lds, const bf16_t* proj, bf16_t* mixn, const float* sinks, int b, int T, int tid) {
    const int lane = tid & 63, w = tid >> 6, c = lane & 31, h = lane >> 5, head = c & 7;
    const float slope2 = exp2f(-8.0f * (float)(head + 1) / 12.0f) * LOG2E, sink2 = sinks[head] * LOG2E;
    const bf16_t* P = proj + (size_t)b * SEQ * LDP;
    const int t0 = 64 * T, j0 = T >= 2 ? T - 2 : 0, nT = T - j0 + 1;
    u32x4 rk[3], rv[3];
#pragma unroll
    for (int i = 0; i < 3; ++i) if (i < nT) { rk[i] = tile_ld(P + (size_t)(64 * (j0 + i)) * LDP + C_KA, LDP, tid); rv[i] = tile_ld(P + (size_t)(64 * (j0 + i)) * LDP + C_VA, LDP, tid); }
    __syncthreads();
#pragma unroll
    for (int i = 0; i < 3; ++i) if (i < nT) { tile_st(lds + (2 * i) * TILE_B, tid, rk[i]); tile_st(lds + (2 * i + 1) * TILE_B, tid, rv[i]); }
    __syncthreads();
#pragma unroll 1
    for (int k = 0; k < 2; ++k) {
        const int tq = t0 + 8 * w + 4 * k + (c >> 3);
        bf16x8 qf[4];
        { const bf16_t* qp = P + (size_t)tq * LDP + C_QA + head * 64 + 8 * h;
#pragma unroll
          for (int s = 0; s < 4; ++s) qf[s] = *(const bf16x8*)(qp + 16 * s); }
        float m = sink2, l = 1.0f; f32x16 o0 = zero16(), o1 = zero16();
#pragma unroll 1
        for (int i = 0; i < nT; ++i) {
            ldsp Kt = lds + (2 * i) * TILE_B, Vt = Kt + TILE_B;
            f32x16 p0, p1; qk_tile(Kt, qf, lane, p0, p1); prep_band(p0, p1, tq, 64 * (j0 + i), h, slope2, 128, true);
            softmax_step(p0, p1, m, l, o0, o1); pv_tile(Vt, p0, p1, lane, o0, o1);
        }
        const float inv = 1.0f / l; float ss = sumsq(o0, o1) * inv * inv;
        ss += __shfl_xor(ss, 32); ss += __shfl_xor(ss, 1); ss += __shfl_xor(ss, 2); ss += __shfl_xor(ss, 4);
        const float sc = inv * __builtin_amdgcn_rsqf(ss * (1.0f / 512.0f) + 1e-6f);
        store_o(mixn + (size_t)(b * SEQ + tq) * DM + head * 64, o0, o1, sc, h);
    }
}

__device__ __forceinline__ float neg_softplus(float z) { const float az = fabsf(z); return -(fmaxf(z, 0.f) + 0.6931471805599453f * __builtin_amdgcn_logf(1.0f + ex2(-az * LOG2E))); }
__device__ __forceinline__ void stick_step(f32x16& p0, f32x16& p1, int tq, int tk0, int h, float& carry) {
    float run1 = 0.f, run0 = 0.f;
#pragma unroll
    for (int r = 15; r >= 0; --r) { const bool past = (tk0 + 32 + 16 * h + r) < tq; const float z = p1[r] * 0.125f; run1 += past ? neg_softplus(z) : 0.f; p1[r] = past ? z + run1 : NEG; }
#pragma unroll
    for (int r = 15; r >= 0; --r) { const bool past = (tk0 + 16 * h + r) < tq; const float z = p0[r] * 0.125f; run0 += past ? neg_softplus(z) : 0.f; p0[r] = past ? z + run0 : NEG; }
    const float ot1 = __shfl_xor(run1, 32), ot0 = __shfl_xor(run0, 32);
    const float off1 = carry + (h == 0 ? ot1 : 0.f);
    const float off0 = carry + run1 + ot1 + (h == 0 ? ot0 : 0.f);
    carry += (run0 + ot0) + (run1 + ot1);
#pragma unroll
    for (int r = 0; r < 16; ++r) { p1[r] = p1[r] > -1e29f ? ex2((p1[r] + off1) * LOG2E) : 0.f; p0[r] = p0[r] > -1e29f ? ex2((p0[r] + off0) * LOG2E) : 0.f; }
}
constexpr int C_SS_OFF = 8 * TILE_B;
__device__ __forceinline__ void unitC(ldsp lds, const bf16_t* proj, bf16_t* mixn, int b, int T, int tid) {
    const int lane = tid & 63, w = tid >> 6, c = lane & 31, h = lane >> 5, hd = w >> 1, ql = 32 * (w & 1) + c, tq = 64 * T + ql;
    const bf16_t* P = proj + (size_t)b * SEQ * LDP;
    bf16x8 qf[4];
    { const bf16_t* qp = P + (size_t)tq * LDP + C_QC + hd * 64 + 8 * h;
#pragma unroll
      for (int s = 0; s < 4; ++s) qf[s] = *(const bf16x8*)(qp + 16 * s); }
    f32x16 o0 = zero16(), o1 = zero16(); float carry = 0.f;
    u32x4 rg[8];
#pragma unroll
    for (int i = 0; i < 8; ++i) rg[i] = tile_ld(P + (size_t)(64 * T) * LDP + (i < 4 ? C_KC + i * 64 : C_VC + (i - 4) * 64), LDP, tid);
    LAS float* CF = (LAS float*)(lds + C_SS_OFF + 1024);
    for (int jt = T; jt >= 0; --jt) {
        __syncthreads();
        if (jt < T) {
            const float mc = fmaxf(fmaxf(fmaxf(CF[0], CF[1]), fmaxf(CF[2], CF[3])), fmaxf(fmaxf(CF[4], CF[5]), fmaxf(CF[6], CF[7])));
            if (mc < -40.0f) break;
        }
#pragma unroll
        for (int i = 0; i < 8; ++i) tile_st(lds + ((i & 3) * 2 + (i >> 2)) * TILE_B, tid, rg[i]);
        __syncthreads();
        if (jt > 0) {
#pragma unroll
            for (int i = 0; i < 8; ++i) rg[i] = tile_ld(P + (size_t)(64 * (jt - 1)) * LDP + (i < 4 ? C_KC + i * 64 : C_VC + (i - 4) * 64), LDP, tid); }
        f32x16 p0, p1; qk_tile(lds + hd * 2 * TILE_B, qf, lane, p0, p1);
        stick_step(p0, p1, tq, 64 * jt, h, carry);
        { float wc = carry;
#pragma unroll
          for (int o = 1; o < 64; o <<= 1) wc = fmaxf(wc, __shfl_xor(wc, o));
          if (lane == 0) CF[w] = wc; }
        pv_tile(lds + hd * 2 * TILE_B + TILE_B, p0, p1, lane, o0, o1);
    }
    float ss = sumsq(o0, o1); ss += __shfl_xor(ss, 32);
    LAS float* SS = (LAS float*)(lds + C_SS_OFF);
    if (h == 0) SS[ql * 4 + hd] = ss;
    __syncthreads();
    const float tot = (SS[ql * 4 + 0] + SS[ql * 4 + 1]) + (SS[ql * 4 + 2] + SS[ql * 4 + 3]);
    const float sc = __builtin_amdgcn_rsqf(tot * (1.0f / 256.0f) + 1e-6f);
    store_o(mixn + (size_t)(b * SEQ + tq) * DM + 768 + hd * 64, o0, o1, sc, h);
}

template <int MODE, bool INTERIOR>
__device__ __forceinline__ void kv_range(ldsp lds, const bf16_t* Kg, const bf16_t* Vg, int jlo, int jhi, int jend, u32x4& rka, u32x4& rva, ldsp qs_, int tq, float slope2, unsigned sel,
                                         int tid, int lane, int h, float& m, float& l, f32x16& o0, f32x16& o1) {
    const float qs = slope2 * (1.0f / KSC2);
    for (int jt = jlo; jt <= jhi; ++jt) {
        u32x4 rkb = rka, rvb = rva;
        if (jt + 2 <= jend) { rkb = tile_ld(Kg + (size_t)(64 * (jt + 2)) * LDP, LDP, tid); rvb = tile_ld(Vg + (size_t)(64 * (jt + 2)) * LDP, LDP, tid); }
        ldsp Kt = lds + (jt & 1) * 2 * TILE_B, Vt = Kt + TILE_B;
        const bool mine = MODE == 0 ? ((sel >> jt) & 1u) != 0u : true;
        if (MODE == 1 || __any(mine ? 1 : 0)) {
            ldsp qsl = qs_; asm volatile("" : "+v"(qsl));
            bf16x8 qf[4];
#pragma unroll
            for (int s = 0; s < 4; ++s) qf[s] = *(const LAS bf16x8*)(qsl + s * 1024);
            f32x16 p0, p1; if (INTERIOR) qk_tile_pre(Kt, qf, lane, p0, p1); else qk_tile(Kt, qf, lane, p0, p1);
            if (INTERIOR) {
                const float A0 = mine ? -slope2 * (float)(tq - 64 * jt - 16 * h) : NEG, A1 = mine ? A0 + 32.0f * slope2 : NEG;
                float mx0 = NEG, mx1 = NEG;
#pragma unroll
                for (int r = 0; r < 16; ++r) { p0[r] = __builtin_fmaf(qs, (float)r, p0[r]); mx0 = fmaxf(mx0, p0[r]); p1[r] = __builtin_fmaf(qs, (float)r, p1[r]); mx1 = fmaxf(mx1, p1[r]); }
                float mxv = fmaxf(__builtin_fmaf(mx0, KSC2, A0), __builtin_fmaf(mx1, KSC2, A1)); mxv = fmaxf(mxv, __shfl_xor(mxv, 32));
                const float mn = fmaxf(m, mxv), alpha = ex2(m - mn);
                const float c0 = mine ? A0 - mn : -3e38f, c1 = mine ? A1 - mn : -3e38f;
                float ls = 0.f;
#pragma unroll
                for (int r = 0; r < 16; ++r) { p0[r] = ex2(__builtin_fmaf(p0[r], KSC2, c0)); p1[r] = ex2(__builtin_fmaf(p1[r], KSC2, c1)); ls += p0[r] + p1[r]; }
                ls += __shfl_xor(ls, 32);
                l = l * alpha + ls; m = mn; o0 *= alpha; o1 *= alpha;
            } else {
                prep_band(p0, p1, tq, 64 * jt, h, slope2, MODE == 0 ? 4096 : 512, mine);
                softmax_step(p0, p1, m, l, o0, o1);
            }
            pv_tile(Vt, p0, p1, lane, o0, o1);
        }
        if (jt + 1 <= jend) { ldsp Kn = lds + ((jt + 1) & 1) * 2 * TILE_B; tile_st(Kn, tid, rka); tile_st(Kn + TILE_B, tid, rva); }
        __syncthreads();
        rka = rkb; rva = rvb;
    }
}
__device__ __forceinline__ void kv_start(ldsp lds, const bf16_t* Kg, const bf16_t* Vg, int jlo, int jend, u32x4& rka, u32x4& rva, int tid) {
    const u32x4 k0 = tile_ld(Kg + (size_t)(64 * jlo) * LDP, LDP, tid), v0 = tile_ld(Vg + (size_t)(64 * jlo) * LDP, LDP, tid);
    rka = k0; rva = v0;
    if (jlo + 1 <= jend) { rka = tile_ld(Kg + (size_t)(64 * (jlo + 1)) * LDP, LDP, tid); rva = tile_ld(Vg + (size_t)(64 * (jlo + 1)) * LDP, LDP, tid); }
    __syncthreads();
    ldsp Kt = lds + (jlo & 1) * 2 * TILE_B; tile_st(Kt, tid, k0); tile_st(Kt + TILE_B, tid, v0);
    __syncthreads();
}
constexpr int B_CK = 4 * TILE_B, B_CV = 6 * TILE_B, B_IMP = 8 * TILE_B, B_MASK = B_IMP + 16384;
constexpr int B_GL = B_MASK + 256;
__device__ __forceinline__ void unitB(ldsp lds, const bf16_t* proj, const bf16_t* kc, const bf16_t* vc, bf16_t* mixn, const bf16_t* xb, const float* ssq, const bf16_t* wg, int b, int T, int tid) {
    const int lane = tid & 63, w = tid >> 6, c = lane & 31, h = lane >> 5, hd = c & 3, qloc = c >> 2, tq = 64 * T + 8 * w + qloc;
    const float slope2 = exp2f(-8.0f * (float)(hd + 9) / 12.0f) * LOG2E;
    const bf16_t* P = proj + (size_t)b * SEQ * LDP;
    bf16x8 qf[4];
    { const bf16_t* qp = P + (size_t)tq * LDP + C_QB + hd * 64 + 8 * h;
#pragma unroll
      for (int s = 0; s < 4; ++s) qf[s] = *(const bf16x8*)(qp + 16 * s); }
    LAS float* GL = (LAS float*)(lds + B_GL); LAS float* GP = GL + 768;
    u32x4 ckr[2], cvr[2];
#pragma unroll
    for (int t = 0; t < 2; ++t) { int n = 64 * t + (tid >> 3); n = n > 126 ? 126 : n; const size_t off = ((size_t)b * 128 + n) * 64 + (tid & 7) * 8;
        ckr[t] = *(const u32x4*)(kc + off); cvr[t] = *(const u32x4*)(vc + off); }
    { const int th = w & 1, kq = w >> 1, gc = c < 12 ? c : 11;
      const bf16_t* xa = xb + ((size_t)b * SEQ + 64 * T + 32 * th + c) * DM + 256 * kq + 8 * h;
      const bf16_t* wb = wg + (size_t)gc * 1024 + 256 * kq + 8 * h;
      f32x16 ga = zero16();
#pragma unroll 8
      for (int s = 0; s < 16; ++s) { const bf16x8 xa8 = *(const bf16x8*)(xa + 16 * s), wb8 = *(const bf16x8*)(wb + 16 * s); ga = __builtin_amdgcn_mfma_f32_32x32x16_bf16(xa8, wb8, ga, 0, 0, 0); }
      if (c < 12) {
#pragma unroll
          for (int r = 0; r < 16; ++r) GP[(kq * 64 + 32 * th + (r & 3) + 8 * (r >> 2) + 4 * h) * 12 + c] = ga[r]; } }
#define B_GATE(i) (GL[(8 * w + qloc) * 12 + hd * 3 + (i)])
    f32x16 ob0 = zero16(), ob1 = zero16();
    const int ntc = T >= 16 ? 2 : 1;
    __syncthreads();
    { int t2 = tid; asm volatile("" : "+v"(t2));
#pragma unroll 1
      for (; t2 < 768; t2 += 512) { const int tk = t2 / 12; const size_t row = (size_t)b * SEQ + 64 * T + tk;
        const f32x4v* sp = (const f32x4v*)(ssq + row * 16); const f32x4v s0 = sp[0], s1 = sp[1], s2 = sp[2], s3 = sp[3];
        const float sq = ((s0[0] + s0[1]) + (s0[2] + s0[3])) + ((s1[0] + s1[1]) + (s1[2] + s1[3])) + ((s2[0] + s2[1]) + (s2[2] + s2[3])) + ((s3[0] + s3[1]) + (s3[2] + s3[3]));
        const float rs = __builtin_amdgcn_rsqf(sq * (1.0f / 1024.0f) + 1e-6f);
        const float gv = (GP[t2] + GP[768 + t2]) + (GP[1536 + t2] + GP[2304 + t2]);
        GL[t2] = 1.0f / (1.0f + __expf(-gv * rs)); } }
#pragma unroll
    for (int t = 0; t < 2; ++t) { tile_st(lds + B_CK + t * TILE_B, tid, ckr[t]); tile_st(lds + B_CV + t * TILE_B, tid, cvr[t]); }
    __syncthreads();
    unsigned sel;
    {
        f32x16 pa0, pa1, pb0, pb1;
        qk_tile(lds + B_CK, qf, lane, pa0, pa1);
        if (ntc == 2) qk_tile(lds + B_CK + TILE_B, qf, lane, pb0, pb1); else { pb0 = zero16(); pb1 = zero16(); }
        float mxv = NEG;
#pragma unroll
        for (int r = 0; r < 16; ++r) {
            const int n0 = 16 * h + r; const int d0 = tq - (16 * n0 + 31), d1 = d0 - 512, d2 = d0 - 1024, d3 = d0 - 1536;
            pa0[r] = d0 >= 0 ? pa0[r] * KSC2 - slope2 * (float)d0 : NEG; pa1[r] = d1 >= 0 ? pa1[r] * KSC2 - slope2 * (float)d1 : NEG;
            pb0[r] = d2 >= 0 ? pb0[r] * KSC2 - slope2 * (float)d2 : NEG; pb1[r] = d3 >= 0 ? pb1[r] * KSC2 - slope2 * (float)d3 : NEG;
            mxv = fmaxf(fmaxf(mxv, fmaxf(pa0[r], pa1[r])), fmaxf(pb0[r], pb1[r]));
        }
        mxv = fmaxf(mxv, __shfl_xor(mxv, 32));
        float ls = 0.f;
#pragma unroll
        for (int r = 0; r < 16; ++r) {
            pa0[r] = pa0[r] > -1e29f ? ex2(pa0[r] - mxv) : 0.f; pa1[r] = pa1[r] > -1e29f ? ex2(pa1[r] - mxv) : 0.f;
            pb0[r] = pb0[r] > -1e29f ? ex2(pb0[r] - mxv) : 0.f; pb1[r] = pb1[r] > -1e29f ? ex2(pb1[r] - mxv) : 0.f;
            ls += (pa0[r] + pa1[r]) + (pb0[r] + pb1[r]);
        }
        ls += __shfl_xor(ls, 32);
        const float inv = ls > 0.f ? 1.0f / ls : 0.f;
        f32x16 oc0 = zero16(), oc1 = zero16();
        pv_tile(lds + B_CV, pa0, pa1, lane, oc0, oc1);
        if (ntc == 2) pv_tile(lds + B_CV + TILE_B, pb0, pb1, lane, oc0, oc1);
        const float gs = B_GATE(0) * inv;
        ob0 += oc0 * gs; ob1 += oc1 * gs;
        LAS float* IA = (LAS float*)(lds + B_IMP) + w * 512 + qloc * 32;
        LAS float* IB = IA + 256;
#pragma unroll
        for (int g = 0; g < 4; ++g) {
            float a0 = (2.0f * (pa0[4 * g] + pa0[4 * g + 1] + pa0[4 * g + 2]) + pa0[4 * g + 3]) * inv, b0 = pa0[4 * g + 3] * inv;
            float a1 = (2.0f * (pa1[4 * g] + pa1[4 * g + 1] + pa1[4 * g + 2]) + pa1[4 * g + 3]) * inv, b1 = pa1[4 * g + 3] * inv;
            float a2 = (2.0f * (pb0[4 * g] + pb0[4 * g + 1] + pb0[4 * g + 2]) + pb0[4 * g + 3]) * inv, b2 = pb0[4 * g + 3] * inv;
            float a3 = (2.0f * (pb1[4 * g] + pb1[4 * g + 1] + pb1[4 * g + 2]) + pb1[4 * g + 3]) * inv, b3 = pb1[4 * g + 3] * inv;
            a0 += __shfl_xor(a0, 1); a0 += __shfl_xor(a0, 2); b0 += __shfl_xor(b0, 1); b0 += __shfl_xor(b0, 2);
            a1 += __shfl_xor(a1, 1); a1 += __shfl_xor(a1, 2); b1 += __shfl_xor(b1, 1); b1 += __shfl_xor(b1, 2);
            a2 += __shfl_xor(a2, 1); a2 += __shfl_xor(a2, 2); b2 += __shfl_xor(b2, 1); b2 += __shfl_xor(b2, 2);
            a3 += __shfl_xor(a3, 1); a3 += __shfl_xor(a3, 2); b3 += __shfl_xor(b3, 1); b3 += __shfl_xor(b3, 2);
            if (hd == 0) { const int j = 4 * h + g; IA[j] = a0; IB[j] = b0; IA[8 + j] = a1; IB[8 + j] = b1; IA[16 + j] = a2; IB[16 + j] = b2; IA[24 + j] = a3; IB[24 + j] = b3; }
        }
        asm volatile("s_waitcnt lgkmcnt(0)" ::: "memory"); __builtin_amdgcn_wave_barrier();
        LAS unsigned* MK = (LAS unsigned*)(lds + B_MASK) + w * 8;
        if (lane < 8) {
            const LAS float* SA = (const LAS float*)(lds + B_IMP) + w * 512 + lane * 32; const LAS float* SB = SA + 256;
            float iv[32];
#pragma unroll
            for (int j = 1; j < 32; ++j) iv[j] = SA[j] + SB[j - 1];
            unsigned mk = 1u | (1u << T) | (T >= 1 ? (1u << (T - 1)) : 0u);
            const int need = 8 - __popc(mk);
#pragma unroll
            for (int j = 1; j < 32; ++j) if (j > T || ((mk >> j) & 1u)) iv[j] = -1.0f;
#pragma unroll 1
            for (int it = 0; it < need; ++it) {
                int best = 0; float bv = -0.5f;
#pragma unroll
                for (int j = 1; j < 32; ++j) { const bool gt = iv[j] > bv; bv = gt ? iv[j] : bv; best = gt ? j : best; }
                if (best == 0) break;
                mk |= 1u << best;
#pragma unroll
                for (int j = 1; j < 32; ++j) iv[j] = (j == best) ? -1.0f : iv[j];
            }
            MK[lane] = mk;
        }
        asm volatile("s_waitcnt lgkmcnt(0)" ::: "memory"); __builtin_amdgcn_wave_barrier();
        sel = MK[qloc];
    }
    ldsp qpB = lds + B_GL + 3072 + w * 4096 + lane * 16;
#pragma unroll
    for (int s = 0; s < 4; ++s) *(LAS bf16x8*)(qpB + s * 1024) = qf[s];
    { float m = NEG, l = 0.f; f32x16 o0 = zero16(), o1 = zero16();
      const bf16_t* Kg = P + C_KSB; const bf16_t* Vg = P + C_VSB; u32x4 rk, rv;
      kv_start(lds, Kg, Vg, 0, T, rk, rv, tid);
      if (T > 0) kv_range<0, true>(lds, Kg, Vg, 0, T - 1, T, rk, rv, qpB, tq, slope2, sel, tid, lane, h, m, l, o0, o1);
      kv_range<0, false>(lds, Kg, Vg, T, T, T, rk, rv, qpB, tq, slope2, sel, tid, lane, h, m, l, o0, o1);
      const float gs = B_GATE(1) / l; ob0 += o0 * gs; ob1 += o1 * gs; }
    { float m = NEG, l = 0.f; f32x16 o0 = zero16(), o1 = zero16();
      const bf16_t* Kg = P + C_KWB; const bf16_t* Vg = P + C_VWB; u32x4 rk, rv;
      const int jlo = T >= 8 ? T - 8 : 0;
      kv_start(lds, Kg, Vg, jlo, T, rk, rv, tid);
      if (T >= 8) kv_range<1, false>(lds, Kg, Vg, T - 8, T - 8, T, rk, rv, qpB, tq, slope2, 0u, tid, lane, h, m, l, o0, o1);
      if (T >= 1) kv_range<1, true>(lds, Kg, Vg, T >= 7 ? T - 7 : 0, T - 1, T, rk, rv, qpB, tq, slope2, 0u, tid, lane, h, m, l, o0, o1);
      kv_range<1, false>(lds, Kg, Vg, T, T, T, rk, rv, qpB, tq, slope2, 0u, tid, lane, h, m, l, o0, o1);
      const float gs = B_GATE(2) / l; ob0 += o0 * gs; ob1 += o1 * gs; }
    float ss = sumsq(ob0, ob1); ss += __shfl_xor(ss, 32); ss += __shfl_xor(ss, 1); ss += __shfl_xor(ss, 2);
    const float sc = __builtin_amdgcn_rsqf(ss * (1.0f / 256.0f) + 1e-6f);
    store_o(mixn + (size_t)(b * SEQ + tq) * DM + 512 + hd * 64, ob0, ob1, sc, h);
}

__device__ __forceinline__ float gelu_tanh(float x) { const float u = 0.7978845608028654f * (x + 0.044715f * x * x * x); const float e = __expf(2.0f * u); return 0.5f * x * (1.0f + (1.0f - 2.0f / (e + 1.0f))); }
__device__ __forceinline__ void unitCmp(const bf16_t* proj, const bf16_t* w1t, const bf16_t* w2t, const float* bias1, bf16_t* kc, bf16_t* vc, int b, int tid) {
    const int lane = tid & 63, w = tid >> 6, c = lane & 31, h = lane >> 5, g = w >> 1, kv = w & 1;
    const int n = 32 * g + c, nn = n > 126 ? 126 : n;
    const bf16_t* src = proj + ((size_t)b * SEQ + 16 * nn) * LDP + (kv ? C_VCB : C_KCB) + 8 * h;
    const bf16_t* wa = w1t + (size_t)kv * 128 * 2048 + (size_t)lane * 8;
    f32x16 acc[4] = {zero16(), zero16(), zero16(), zero16()};
#pragma unroll 4
    for (int s = 0; s < 128; ++s) {
        const bf16x8 bq = *(const bf16x8*)(src + (size_t)(s >> 2) * LDP + (s & 3) * 16);
#pragma unroll
        for (int fb = 0; fb < 4; ++fb) { const bf16x8 a = *(const bf16x8*)(wa + ((size_t)fb * 128 + s) * 512); acc[fb] = __builtin_amdgcn_mfma_f32_32x32x16_bf16(a, bq, acc[fb], 0, 0, 0); }
    }
    f32x16 y0 = zero16(), y1 = zero16();
    const bf16_t* w2a = w2t + ((size_t)kv * 64 + c) * 128;
#pragma unroll
    for (int fb = 0; fb < 4; ++fb) {
#pragma unroll
        for (int r = 0; r < 16; ++r) acc[fb][r] = gelu_tanh(acc[fb][r] + bias1[kv * 128 + 32 * fb + (r & 3) + 8 * (r >> 2) + 4 * h]);
#pragma unroll
        for (int s2 = 0; s2 < 2; ++s2) {
            u32x4 pw; const int rb = 8 * s2; pw.x = pk2(acc[fb][rb], acc[fb][rb + 1]); pw.y = pk2(acc[fb][rb + 2], acc[fb][rb + 3]); pw.z = pk2(acc[fb][rb + 4], acc[fb][rb + 5]); pw.w = pk2(acc[fb][rb + 6], acc[fb][rb + 7]);
            const bf16x8 hb = __builtin_bit_cast(bf16x8, pw);
            const int f0 = 32 * fb + 16 * s2 + 4 * h;
            { const u32x2 lo = *(const u32x2*)(w2a + f0), hi = *(const u32x2*)(w2a + f0 + 8); u32x4 av; av.x = lo.x; av.y = lo.y; av.z = hi.x; av.w = hi.y;
              y0 = __builtin_amdgcn_mfma_f32_32x32x16_bf16(__builtin_bit_cast(bf16x8, av), hb, y0, 0, 0, 0); }
            { const u32x2 lo = *(const u32x2*)(w2a + 32 * 128 + f0), hi = *(const u32x2*)(w2a + 32 * 128 + f0 + 8); u32x4 av; av.x = lo.x; av.y = lo.y; av.z = hi.x; av.w = hi.y;
              y1 = __builtin_amdgcn_mfma_f32_32x32x16_bf16(__builtin_bit_cast(bf16x8, av), hb, y1, 0, 0, 0); }
        }
    }
    if (n < 127) store_o((kv ? vc : kc) + ((size_t)b * 128 + n) * 64, y0, y1, 1.0f, h);
}
}
using mx::ldsp; using mx::bf16_t;
typedef float f32x4 __attribute__((ext_vector_type(4)));
typedef unsigned u32x4 __attribute__((ext_vector_type(4)));
typedef unsigned u32x2 __attribute__((ext_vector_type(2)));
constexpr int BATCH = 32, SEQ = 2048, DM = 1024, DEPTH = 4, MTOK = BATCH * SEQ, NPROJ = 2048, INW = 2060, DFF = 2816, NGU = 2 * DFF;
constexpr size_t MiB = 1u << 20;
constexpr size_t WS_BAR = 64 * 1024, WS_ZERO_BYTES = 128 * 1024;
constexpr size_t WS_CTR = 0;
constexpr size_t WS_WIN = 1 * MiB, SZ_WIN = (size_t)NPROJ * DM * 2;
constexpr size_t WS_WOUT = 19 * MiB, SZ_WOUT = (size_t)DM * DM * 2;
constexpr size_t WS_WGU = 27 * MiB, SZ_WGU = (size_t)NGU * DM * 2;
constexpr size_t WS_WDN = 71 * MiB, SZ_WDN = (size_t)DM * DFF * 2;
constexpr size_t WS_W1T = 93 * MiB, SZ_W1T = (size_t)2 * 128 * 2048 * 2;
constexpr size_t WS_W2T = 97 * MiB, SZ_W2T = (size_t)2 * 64 * 128 * 2;
constexpr size_t WS_B1 = 97 * MiB + 512 * 1024, SZ_B1 = 2 * 128 * 4;
constexpr size_t WS_WG = 97 * MiB + 768 * 1024, SZ_WG = 32 * 1024;
constexpr size_t WS_KC = 98 * MiB, WS_VC = 98 * MiB + 512 * 1024;
constexpr size_t WS_SS = 100 * MiB;
constexpr size_t WS_XB = 104 * MiB;
constexpr size_t WS_PROJ = 232 * MiB;
constexpr size_t WS_MIXN = 520 * MiB;
constexpr size_t WS_HID = 232 * MiB;
constexpr size_t WS_END = 648 * MiB;
static_assert(WS_WIN + 4 * SZ_WIN <= WS_WOUT && WS_WOUT + 4 * SZ_WOUT <= WS_WGU && WS_WGU + 4 * SZ_WGU <= WS_WDN && WS_WDN + 4 * SZ_WDN <= WS_W1T && WS_W1T + 4 * SZ_W1T <= WS_W2T, "ws map");
static_assert(WS_HID + (size_t)MTOK * DFF * 2 <= WS_END && WS_PROJ + (size_t)MTOK * mx::LDP * 2 <= WS_MIXN && WS_XB + (size_t)MTOK * DM * 2 <= WS_PROJ, "ws map 2");
constexpr int LDS_BYTES = 143360, LDS_CTL = 131072;
constexpr int NPHASE = 2 + 6 * DEPTH;

#define RLX_AGENT __ATOMIC_RELAXED, __HIP_MEMORY_SCOPE_AGENT
#define XB_TMO      128
#define XB_XCNT(j)  (256  + 64 * (j))
#define XB_XSUB(j)  (1280 + 64 * (j))
#define XB_XGEN(j)  (2304 + 64 * (j))
#define XB_TOP      3328
#define XB_TOPGEN   3392
#define XCD_BAR_WORDS 3456
#define XB_SPIN_CAP (1u << 18)

__device__ __forceinline__ unsigned xb_ld(unsigned* p)              { return __hip_atomic_load(p, __ATOMIC_RELAXED, __HIP_MEMORY_SCOPE_AGENT); }
__device__ __forceinline__ unsigned xb_add(unsigned* p, unsigned v) { return __hip_atomic_fetch_add(p, v, __ATOMIC_RELAXED, __HIP_MEMORY_SCOPE_AGENT); }
__device__ __forceinline__ unsigned xb_xcc_id() { return (unsigned)__builtin_amdgcn_s_getreg((3 << 11) | 20) & 0xFu; }
#define XB_SPIN(cond, bar) do { unsigned _sp = 0; while (cond) { __builtin_amdgcn_s_sleep(1); \
    if ((++_sp & 255u) == 0u) { if (xb_ld(&(bar)[XB_TMO])) break; if (_sp > XB_SPIN_CAP) { atomicAdd(&(bar)[XB_TMO], 1u); break; } } } } while (0)

struct XcdBarrier {
    unsigned* bar; unsigned x;
    volatile LAS unsigned* st;
};

__device__ __forceinline__ XcdBarrier xcd_barrier_post(unsigned* bar, volatile LAS unsigned* st) {
    XcdBarrier b; b.bar = bar; b.x = xb_xcc_id(); b.st = st;
    if (threadIdx.x == 0) (void)xb_add(&bar[XB_XCNT(b.x)], 1u);
    return b;
}
__device__ __forceinline__ void xcd_barrier_complete(unsigned* bar, unsigned x, unsigned& nloc, unsigned& nx) {
    const unsigned G = gridDim.x * gridDim.y * gridDim.z;
    unsigned sum, cnt, mine, sp = 0u;
    for (;;) {
        sum = 0u; cnt = 0u; mine = 0u;
#pragma unroll
        for (unsigned j = 0; j < 16; ++j) { const unsigned c = xb_ld(&bar[XB_XCNT(j)]); sum += c; cnt += (c > 0u) ? 1u : 0u; mine = (j == x) ? c : mine; }
        if (sum == G) break;
        __builtin_amdgcn_s_sleep(1);
        if ((++sp & 255u) == 0u) { if (xb_ld(&bar[XB_TMO])) break; if (sp > XB_SPIN_CAP) { atomicAdd(&bar[XB_TMO], 1u); break; } }
    }
    nloc = mine > 0u ? mine : 1u; nx = cnt > 0u ? cnt : 1u;
}

__device__ __forceinline__ void xcd_barrier(const XcdBarrier& b) {
    asm volatile("s_waitcnt vmcnt(0)" ::: "memory");
    __syncthreads();
    if (threadIdx.x == 0) {
        unsigned* bar = b.bar; asm volatile("" : "+s"(bar));
        __builtin_amdgcn_s_waitcnt(0);
        unsigned nloc = b.st[0], nx = b.st[1];
        if (nloc == 0u) { xcd_barrier_complete(bar, b.x, nloc, nx); b.st[0] = nloc; b.st[1] = nx; }
        const unsigned old = xb_add(&bar[XB_XSUB(b.x)], 1u);
        const unsigned gen = old / nloc;
        if (old + 1u == (gen + 1u) * nloc) {
            __builtin_amdgcn_fence(__ATOMIC_RELEASE, "agent");
            asm volatile("s_waitcnt vmcnt(0)" ::: "memory");
            const unsigned og = xb_add(&bar[XB_TOP], 1u);
            const unsigned tg = og / nx;
            if (og + 1u == (tg + 1u) * nx) xb_add(&bar[XB_TOPGEN], 1u);
            else XB_SPIN(xb_ld(&bar[XB_TOPGEN]) == tg, bar);
            __builtin_amdgcn_fence(__ATOMIC_ACQUIRE, "agent");
            xb_add(&bar[XB_XGEN(b.x)], 1u);
            asm volatile("s_waitcnt vmcnt(0)" ::: "memory");
        } else {
            XB_SPIN(xb_ld(&bar[XB_XGEN(b.x)]) == gen, bar);
            __builtin_amdgcn_fence(__ATOMIC_ACQUIRE, "agent");
            asm volatile("s_waitcnt vmcnt(0)" ::: "memory");
        }
    }
    __syncthreads();
}

struct Params { const float* in[16]; float* out; unsigned char* ws; int ph_lo, ph_hi; };

__device__ __forceinline__ float wave_sum(float v) {
#pragma unroll
    for (int o = 1; o < 64; o <<= 1) v += __shfl_xor(v, o);
    return v;
}
template <class RowMap>
__device__ __forceinline__ void transpose_item(const float* W, int K, int N, const float* gk0  , bf16_t* WT, RowMap rm, LAS float* scr, int kb, int nb, int lane) {
    const int k0 = 64 * kb, n0 = 32 * nb, nl = n0 + (lane & 31);
#pragma unroll 4
    for (int i = 0; i < 32; ++i) { const int kk = 2 * i + (lane >> 5); float v = nl < N ? W[(size_t)(k0 + kk) * N + nl] : 0.f; if (gk0) v *= gk0[kk]; scr[kk * 33 + (lane & 31)] = v; }
    asm volatile("s_waitcnt lgkmcnt(0)" ::: "memory"); __builtin_amdgcn_wave_barrier();
    const int c = lane & 7;
#pragma unroll
    for (int j = 0; j < 4; ++j) { const int n = (lane >> 3) + 8 * j; const LAS float* s = scr + (8 * c) * 33 + n;
        u32x4 o; o.x = mx::pk2(s[0 * 33], s[1 * 33]); o.y = mx::pk2(s[2 * 33], s[3 * 33]); o.z = mx::pk2(s[4 * 33], s[5 * 33]); o.w = mx::pk2(s[6 * 33], s[7 * 33]);
        if (n0 + n < N) *(u32x4*)(WT + rm(n0 + n, k0 + 8 * c)) = o; }
    asm volatile("s_waitcnt lgkmcnt(0)" ::: "memory"); __builtin_amdgcn_wave_barrier();
}
struct RmId { int K; __device__ size_t operator()(int n, int k) const { return (size_t)n * K + k; } };
struct RmW1 { __device__ size_t operator()(int f, int k) const { return ((size_t)((f >> 5) * 128 + (k >> 4)) * 64 + (((k >> 3) & 1) * 32 + (f & 31))) * 8; } };
struct RmIn { size_t gdelta; __device__ size_t operator()(int n, int k) const { return n < 1280 ? (size_t)n * 1024 + k : (n < 1292 ? gdelta + (size_t)(n - 1280) * 1024 + k : (size_t)(n - 12) * 1024 + k); } };
struct RmGU { int up; __device__ size_t operator()(int n, int k) const { return (size_t)(256 * (n >> 7) + 128 * up + (n & 127)) * 1024 + k; } };

constexpr int I_IN = 16 * 65, I_OUT = 16 * 32, I_G = 16 * 88, I_DN = 44 * 32, I_W1 = 2 * 32 * 4, I_W2 = 2 * 2 * 2;
constexpr int I_LAYER = I_IN + I_OUT + 2 * I_G + I_DN + I_W1 + I_W2, CONV_UNITS = (I_LAYER + 7) / 8;
__device__ __forceinline__ void convert_item(const Params& p, int L, int r, LAS float* scr, int lane) {
    unsigned char* ws = p.ws;
    const float *w_in = p.in[1], *w_out = p.in[2], *g_attn = p.in[3], *g_ffn = p.in[4], *g_oa = p.in[5], *g_ob = p.in[6], *g_oc = p.in[7];
    const float *cmp_w1 = p.in[10], *cmp_w2 = p.in[11], *w_gate = p.in[12], *w_up = p.in[13], *w_down = p.in[14];
    if (r < I_IN) { const int kb = r / 65, nb = r % 65; transpose_item(w_in + (size_t)L * DM * INW, DM, INW, g_attn + L * DM + 64 * kb, (bf16_t*)(ws + WS_WIN + L * SZ_WIN), RmIn{((WS_WG + L * SZ_WG) - (WS_WIN + L * SZ_WIN)) / 2}, scr, kb, nb, lane); return; } r -= I_IN;
    if (r < I_OUT) { const int kb = r / 32, nb = r % 32, k0 = 64 * kb;
        const float* g = k0 < 512 ? g_oa + L * 512 + k0 : (k0 < 768 ? g_ob + L * 256 + (k0 - 512) : g_oc + L * 256 + (k0 - 768));
        transpose_item(w_out + (size_t)L * DM * DM, DM, DM, g, (bf16_t*)(ws + WS_WOUT + L * SZ_WOUT), RmId{DM}, scr, kb, nb, lane); return; } r -= I_OUT;
    if (r < I_G) { const int kb = r / 88, nb = r % 88; transpose_item(w_gate + (size_t)L * DM * DFF, DM, DFF, g_ffn + L * DM + 64 * kb, (bf16_t*)(ws + WS_WGU + L * SZ_WGU), RmGU{0}, scr, kb, nb, lane); return; } r -= I_G;
    if (r < I_G) { const int kb = r / 88, nb = r % 88; transpose_item(w_up + (size_t)L * DM * DFF, DM, DFF, g_ffn + L * DM + 64 * kb, (bf16_t*)(ws + WS_WGU + L * SZ_WGU), RmGU{1}, scr, kb, nb, lane); return; } r -= I_G;
    if (r < I_DN) { const int kb = r / 32, nb = r % 32; transpose_item(w_down + (size_t)L * DFF * DM, DFF, DM, nullptr, (bf16_t*)(ws + WS_WDN + L * SZ_WDN), RmId{DFF}, scr, kb, nb, lane); return; } r -= I_DN;
    if (r < I_W1) { const int kv = r / 128, r2 = r % 128, kb = r2 / 4, nb = r2 % 4;
        transpose_item(cmp_w1 + ((size_t)L * 2 + kv) * 2048 * 128, 2048, 128, nullptr, (bf16_t*)(ws + WS_W1T + L * SZ_W1T) + (size_t)kv * 128 * 2048, RmW1(), scr, kb, nb, lane); return; } r -= I_W1;
    { const int kv = r / 4, r2 = r % 4, kb = r2 / 2, nb = r2 % 2;
        transpose_item(cmp_w2 + ((size_t)L * 2 + kv) * 128 * 64, 128, 64, nullptr, (bf16_t*)(ws + WS_W2T + L * SZ_W2T) + (size_t)kv * 64 * 128, RmId{128}, scr, kb, nb, lane); }
}
__device__ __forceinline__ void prologue(const Params& p, ldsp lds, int tid) {
    const int lane = tid & 63, wave = tid >> 6, gw = blockIdx.x * 8 + wave, NGW = gridDim.x * 8;
    LAS float* scr = (LAS float*)(lds + wave * 16384);
    unsigned char* ws = p.ws;
    const float *cmp_pos = p.in[9], *cmp_w1 = p.in[10];
#ifdef CONV_IN_P0
    for (int it = gw; it < DEPTH * I_LAYER; it += NGW) convert_item(p, it / I_LAYER, it % I_LAYER, scr, lane);
#else
    for (int it = gw; it < I_LAYER; it += NGW) convert_item(p, 0, it, scr, lane);
#endif
    { const int gt = blockIdx.x * 512 + tid;
      if (gt < DEPTH * 256) { const int L = gt / 256, kv = (gt >> 7) & 1, f = gt & 127; const float* pos = cmp_pos + ((size_t)L * 2 + kv) * 2048; const float* w1 = cmp_w1 + ((size_t)L * 2 + kv) * 2048 * 128 + f;
          float s = 0.f; for (int k = 0; k < 2048; ++k) s += pos[k] * w1[(size_t)k * 128];
          ((float*)(ws + WS_B1 + L * SZ_B1))[kv * 128 + f] = s; } }
    { const float* x = p.in[0]; bf16_t* xb = (bf16_t*)(ws + WS_XB); float* ss = (float*)(ws + WS_SS);
      for (int row0 = 2 * gw; row0 < MTOK; row0 += 2 * NGW) { f32x4 v[2][4];
#pragma unroll
          for (int q = 0; q < 2; ++q)
#pragma unroll
              for (int j = 0; j < 2; ++j) { const float* xr = x + (size_t)(row0 + q) * DM + 512 * j + 8 * lane; v[q][2 * j] = *(const f32x4*)xr; v[q][2 * j + 1] = *(const f32x4*)(xr + 4); }
#pragma unroll
          for (int q = 0; q < 2; ++q) { float s = 0.f;
#pragma unroll
              for (int j = 0; j < 2; ++j) { const f32x4 a = v[q][2 * j], b = v[q][2 * j + 1];
                  s += ((a[0] * a[0] + a[1] * a[1]) + (a[2] * a[2] + a[3] * a[3])) + ((b[0] * b[0] + b[1] * b[1]) + (b[2] * b[2] + b[3] * b[3]));
                  u32x4 o; o.x = mx::pk2(a[0], a[1]); o.y = mx::pk2(a[2], a[3]); o.z = mx::pk2(b[0], b[1]); o.w = mx::pk2(b[2], b[3]);
                  *(u32x4*)(xb + (size_t)(row0 + q) * DM + 512 * j + 8 * lane) = o; }
              s = wave_sum(s);
              if (lane < 16) ss[(size_t)(row0 + q) * 16 + lane] = lane == 0 ? s : 0.f; } } }
}
__device__ __forceinline__ void final_norm(const Params& p, int tid) {
    const int lane = tid & 63, wave = tid >> 6, gw = blockIdx.x * 8 + wave, NGW = gridDim.x * 8;
    const float* ss = (const float*)(p.ws + WS_SS); const float* g = p.in[15]; float* out = p.out; const bf16_t* xb = (const bf16_t*)(p.ws + WS_XB);
    f32x4 gv[4];
#pragma unroll
    for (int j = 0; j < 2; ++j) { gv[2 * j] = *(const f32x4*)(g + 512 * j + 8 * lane); gv[2 * j + 1] = *(const f32x4*)(g + 512 * j + 8 * lane + 4); }
    for (int row0 = 2 * gw; row0 < MTOK; row0 += 2 * NGW) {
        float s[2]; u32x4 w[2][2];
#pragma unroll
        for (int q = 0; q < 2; ++q) { const int row = row0 + q; s[q] = lane < 16 ? ss[(size_t)row * 16 + lane] : 0.f;
#pragma unroll
            for (int j = 0; j < 2; ++j) w[q][j] = *(const u32x4*)(xb + (size_t)row * DM + 512 * j + 8 * lane); }
#pragma unroll
        for (int q = 0; q < 2; ++q) { const int row = row0 + q; const float rs = 1.0f / sqrtf(wave_sum(s[q]) * (1.0f / 1024.0f) + 1e-6f);
#pragma unroll
            for (int j = 0; j < 2; ++j) { const u32x4 ww = w[q][j]; float* o = out + (size_t)row * DM + 512 * j + 8 * lane;
                f32x4 a, b; a[0] = __uint_as_float(ww.x << 16); a[1] = __uint_as_float(ww.x & 0xffff0000u); a[2] = __uint_as_float(ww.y << 16); a[3] = __uint_as_float(ww.y & 0xffff0000u);
                b[0] = __uint_as_float(ww.z << 16); b[1] = __uint_as_float(ww.z & 0xffff0000u); b[2] = __uint_as_float(ww.w << 16); b[3] = __uint_as_float(ww.w & 0xffff0000u);
                *(f32x4*)o = a * rs * gv[2 * j]; *(f32x4*)(o + 4) = b * rs * gv[2 * j + 1]; } }
    }
}
__device__ __forceinline__ int opq_s(int v) { asm volatile("" : "+s"(v)); return v; }
__device__ __forceinline__ int q_next(unsigned* ctr, LAS unsigned* slot, int tid) {
    __syncthreads();
    if (tid == 0) *slot = atomicAdd(ctr, 1u);
    __syncthreads();
    return (int)*slot;
}

__global__ void __launch_bounds__(512, 2) mk_fwd(Params p) {
    extern __shared__ __attribute__((aligned(16))) unsigned char lds_raw[];
    ldsp lds = (ldsp)lds_raw;
    cg::grid_group grid = cg::this_grid();
    const int lo = p.ph_lo, hi = p.ph_hi;
#define OPAQUE_TID() int tid = threadIdx.x; asm volatile("" : "+v"(tid))
    unsigned char* ws = p.ws;
    LAS unsigned* slot = (LAS unsigned*)(lds + LDS_CTL);
    bf16_t* XB = (bf16_t*)(ws + WS_XB); bf16_t* PROJ = (bf16_t*)(ws + WS_PROJ); bf16_t* MIXN = (bf16_t*)(ws + WS_MIXN); bf16_t* HID = (bf16_t*)(ws + WS_HID);
    bf16_t* KC = (bf16_t*)(ws + WS_KC); bf16_t* VC = (bf16_t*)(ws + WS_VC); float* SS = (float*)(ws + WS_SS);
    if (threadIdx.x < 8) slot[4 + threadIdx.x] = 0u;
    __syncthreads();
    const XcdBarrier xbar = xcd_barrier_post((unsigned*)(ws + WS_BAR), (volatile LAS unsigned*)(slot + 4));
    int ph = 0;
#ifdef TIMING_PROBE
    unsigned long long tp0 = __builtin_amdgcn_s_memrealtime(), tcat[4] = {0ull, 0ull, 0ull, 0ull};
#define TCAT(c) do { const unsigned long long tn = __builtin_amdgcn_s_memrealtime(); tcat[c] += tn - tp0; tp0 = tn; } while (0)
#else
#define TCAT(c) do {} while (0)
#endif
#ifndef REP_FINAL
#define REP_FINAL 1
#endif
#ifndef REP_RES
#define REP_RES 1
#endif
#ifndef REP_P0
#define REP_P0 1
#endif
#ifndef REP_P2
#define REP_P2 1
#endif
#ifndef REP_P3
#define REP_P3 1
#endif
#ifndef REP_GEMM
#define REP_GEMM 1
#endif
#ifndef REP_SYNC
#define REP_SYNC 1
#endif
#define RUN() (lo <= ph && ph < hi)
#define SEAM(c) do { TCAT(c); if (RUN() && ph + 1 < hi) { for (int rs_ = 0; rs_ < REP_SYNC; ++rs_) { if (lo < 0) grid.sync(); else xcd_barrier(xbar); }     } TCAT(2); ++ph; } while (0)
    #ifndef SKIP_P0
    if (RUN()) for (int rep_ = 0; rep_ < REP_P0; ++rep_) { if (rep_) xcd_barrier(xbar); OPAQUE_TID(); prologue(p, lds, tid); }
#endif
    SEAM(3);
    for (int L_ = 0; L_ < DEPTH; ++L_) {
#ifndef SKIP_G1
        if (RUN()) if (const int L = opq_s(L_); true) for (int rep_ = 0; rep_ < REP_GEMM; ++rep_) { if (rep_) xcd_barrier(xbar); pg8::Gemm g{XB, (const bf16_t*)(ws + WS_WIN + L * SZ_WIN), MTOK, NPROJ, DM}; pg8::StaticOrder S; S.init(MTOK, NPROJ, (int)gridDim.x, (int)blockIdx.x);
            pg8::EpiProj E{PROJ, mx::LDP, SS};
            pg8::gemm_phase<pg8::EpiProj, pg8::StaticOrder, true, true>((PG8_LAS unsigned char*)lds, g, S, E); }
#endif
        SEAM(0);
#ifndef SKIP_P2
        if (RUN()) if (const int L = opq_s(L_); true) for (int rep_ = 0; rep_ < REP_P2; ++rep_) { if (rep_) xcd_barrier(xbar); OPAQUE_TID(); unsigned* ctr = (unsigned*)(ws + WS_CTR) + 64 * (ph + 32 * rep_);
            int u = q_next(ctr, slot, tid);
#ifdef CONV_IN_P0
            const int nq = 32 + 2048;
#else
            const int nq = 32 + 2048 + (L + 1 < DEPTH ? CONV_UNITS : 0);
#endif
            while (u < nq) {
                if (u < 32) {
#ifndef SKIP_CMP
 mx::unitCmp(PROJ, (const bf16_t*)(ws + WS_W1T + L * SZ_W1T), (const bf16_t*)(ws + WS_W2T + L * SZ_W2T), (const float*)(ws + WS_B1 + L * SZ_B1), KC, VC, u, tid);
#endif
 }
                else if (u < 32 + 1024) {
#ifndef SKIP_C
 const int k = u - 32; mx::unitC(lds, PROJ, MIXN, k & 31, 31 - (k >> 5), tid);
#endif
 }
#ifndef CONV_IN_P0
                else if (u >= 32 + 2048) { const int it = (u - 32 - 2048) * 8 + (tid >> 6); if (it < I_LAYER) convert_item(p, L + 1, it, (LAS float*)(lds + (tid >> 6) * 16384), tid & 63); }
#endif
                else {
#ifndef SKIP_A
 const int k = u - 32 - 1024; mx::unitA(lds, PROJ, MIXN, p.in[8] + L * 8, k & 31, 31 - (k >> 5), tid);
#endif
 }
                u = q_next(ctr, slot, tid); } }
#endif
        SEAM(1);
#ifndef SKIP_P3
        if (RUN()) if (const int L = opq_s(L_); true) for (int rep_ = 0; rep_ < REP_P3; ++rep_) { if (rep_) xcd_barrier(xbar); OPAQUE_TID(); unsigned* ctr = (unsigned*)(ws + WS_CTR) + 64 * (ph + 32 * rep_);
            int u = q_next(ctr, slot, tid);
            while (u < 1024) { unsigned nxt_ = 0u; if (tid == 0) nxt_ = atomicAdd(ctr, 1u); mx::unitB(lds, PROJ, KC, VC, MIXN, XB, SS, (const bf16_t*)(ws + WS_WG + L * SZ_WG), u & 31, 31 - (u >> 5), tid);
                __syncthreads(); if (tid == 0) *slot = nxt_; __syncthreads(); u = (int)*slot; } }
#endif
        SEAM(1);
#ifndef SKIP_G4
        if (RUN()) if (const int L = opq_s(L_); true) for (int rep_ = 0; rep_ < REP_RES; ++rep_) { if (rep_) xcd_barrier(xbar); pg8::Gemm g{MIXN, (const bf16_t*)(ws + WS_WOUT + L * SZ_WOUT), MTOK, DM, DM}; pg8::StaticOrder S; S.init(MTOK, DM, (int)gridDim.x, (int)blockIdx.x);
            pg8::EpiRes E{XB, rep_ + 1 < REP_RES ? (float*)(ws + WS_END + 256 * MiB) : SS, rep_ + 1 < REP_RES ? (bf16_t*)(ws + WS_END) : XB};
            pg8::gemm_phase<pg8::EpiRes, pg8::StaticOrder, true, true>((PG8_LAS unsigned char*)lds, g, S, E); }
#endif
        SEAM(0);
#ifndef SKIP_G5
        if (RUN()) if (const int L = opq_s(L_); true) for (int rep_ = 0; rep_ < REP_GEMM; ++rep_) { if (rep_) xcd_barrier(xbar); pg8::Gemm g{XB, (const bf16_t*)(ws + WS_WGU + L * SZ_WGU), MTOK, NGU, DM}; pg8::StaticOrder S; S.init(MTOK, NGU, (int)gridDim.x, (int)blockIdx.x);
            pg8::EpiGU E{HID, DFF, SS};
            pg8::gemm_phase<pg8::EpiGU, pg8::StaticOrder, true, true>((PG8_LAS unsigned char*)lds, g, S, E); }
#endif
        SEAM(0);
#ifndef SKIP_G6
        if (RUN()) if (const int L = opq_s(L_); true) for (int rep_ = 0; rep_ < REP_RES; ++rep_) { if (rep_) xcd_barrier(xbar); pg8::Gemm g{HID, (const bf16_t*)(ws + WS_WDN + L * SZ_WDN), MTOK, DM, DFF}; pg8::StaticOrder S; S.init(MTOK, DM, (int)gridDim.x, (int)blockIdx.x);
            pg8::EpiRes E{XB, rep_ + 1 < REP_RES ? (float*)(ws + WS_END + 256 * MiB) : SS, rep_ + 1 < REP_RES ? (bf16_t*)(ws + WS_END) : XB};
            pg8::gemm_phase<pg8::EpiRes, pg8::StaticOrder, true, true>((PG8_LAS unsigned char*)lds, g, S, E); }
#endif
        SEAM(0);
    }
    if (RUN()) for (int rep_ = 0; rep_ < REP_FINAL; ++rep_) { OPAQUE_TID(); final_norm(p, tid); }
#ifdef TIMING_PROBE
    TCAT(3);
    grid.sync();
    if (blockIdx.x == 0 && threadIdx.x == 0) {
        const float va = (float)(tcat[TIMING_PROBE / 10] / 100ull), vb = (float)(tcat[TIMING_PROBE % 10] / 100ull);
        asm volatile("s_waitcnt vmcnt(0)" ::: "memory");
        p.out[0] = va; for (int i = 0; i < 10000; ++i) p.out[2048 + i] = vb;
    }
#endif
#undef RUN
#undef SEAM
}

#ifndef MK_PER_PHASE
#define MK_PER_PHASE 0
#endif
extern "C" void kernel_launch(void* const* d_in, const int* in_sizes, int n_in, void* d_out, int out_size, void* d_ws, size_t ws_size, hipStream_t stream) {
    static int grid = 0;
    if (grid == 0) {
        if (n_in != 16 || out_size != MTOK * DM || ws_size < WS_END) { fprintf(stderr, "kernel_launch: unexpected shapes (n_in %d, out %d, ws %zu)\n", n_in, out_size, ws_size); grid = -1; return; }
        int dev = 0, cus = 0, per_cu = 0;
        hipGetDevice(&dev); hipDeviceGetAttribute(&cus, hipDeviceAttributeMultiprocessorCount, dev);
        if (hipFuncSetAttribute((const void*)mk_fwd, hipFuncAttributeMaxDynamicSharedMemorySize, LDS_BYTES) != hipSuccess) { fprintf(stderr, "kernel_launch: hipFuncSetAttribute failed\n"); grid = -1; return; }
        if (hipOccupancyMaxActiveBlocksPerMultiprocessor(&per_cu, (const void*)mk_fwd, 512, LDS_BYTES) != hipSuccess || per_cu < 1) { fprintf(stderr, "kernel_launch: occupancy query says %d\n", per_cu); per_cu = 1; }
        (void)hipGetLastError();
        grid = cus;
    }
    if (grid < 0) return;
    if (hipMemsetAsync(d_ws, 0, WS_ZERO_BYTES, stream) != hipSuccess) { fprintf(stderr, "kernel_launch: memset failed\n"); return; }
    Params p{};
    for (int i = 0; i < 16; ++i) p.in[i] = (const float*)d_in[i];
    p.out = (float*)d_out; p.ws = (unsigned char*)d_ws;
#if MK_PER_PHASE
    for (int ph = 0; ph < NPHASE; ++ph) { p.ph_lo = ph; p.ph_hi = ph + 1; hipLaunchKernelGGL(mk_fwd, dim3(grid), dim3(512), LDS_BYTES, stream, p); }
#else
    p.ph_lo = 0; p.ph_hi = NPHASE;
    void* args[] = {&p};
    hipError_t e = hipLaunchCooperativeKernel((const void*)mk_fwd, dim3(grid), dim3(512), args, LDS_BYTES, stream);
    if (e != hipSuccess) fprintf(stderr, "kernel_launch: cooperative launch failed: %s (grid %d)\n", hipGetErrorString(e), grid);
#endif
}
```

```cpp
#include <hip/hip_runtime.h>
#include <hip/hip_cooperative_groups.h>
#include <cstdio>
#include <cstdint>
namespace cg = cooperative_groups;
namespace pg8 {
#define PG8_LAS __attribute__((address_space(3)))
typedef unsigned short bf16_t;
typedef short bf16x8 __attribute__((ext_vector_type(8)));
typedef float f32x4 __attribute__((ext_vector_type(4)));
typedef unsigned u32x4 __attribute__((ext_vector_type(4)));
constexpr int BM = 256, BK = 64, HALF = 128, HTB = HALF * BK * 2  , STAGE_BYTES = 8 * HTB, NXCD = 8, WGM = 8;

__host__ __device__ __forceinline__ int lds_byte(int r, int c) { const int st = (r >> 4) * 2 + (c >> 5), rr = r & 15, cc = c & 31, ob = rr * 64 + cc * 2; return st * 1024 + (ob ^ (((ob >> 9) & 1) << 5)); }
__host__ __device__ __forceinline__ void stage_rc(int b, int& R, int& C) { const int st = b / 1024, sb = b % 1024, swz = sb ^ (((sb >> 9) & 1) << 5); R = (st >> 1) * 16 + swz / 64; C = (st & 1) * 32 + (swz % 64) / 2; }
__host__ __device__ __forceinline__ int perm32(int rho) { const int n = rho >> 4, i = rho & 15; return 8 * (i >> 2) + 4 * n + (i & 3); }

struct Unit { int pm, pn; };
struct Gemm { const bf16_t* A; const bf16_t* Bt; int M, N, K; };

struct StaticOrder {
    int nM, nN, nwg, G, c;
    __host__ __device__ void init(int M, int N, int G_, int c_) { nM = M / BM; nN = N / BM; nwg = nM * nN; G = G_; c = c_; }
    __host__ __device__ bool next(int i, Unit& u) const {
        const long L = (long)i * G + c; if (L >= nwg) return false;
        int wgid = (int)L; { const int q = nwg / NXCD, r = nwg % NXCD, xcd = wgid % NXCD, off = wgid / NXCD; wgid = (xcd < r ? xcd * (q + 1) : r * (q + 1) + (xcd - r) * q) + off; }
        const int nig = WGM * nN, gid = wgid / nig, fm = gid * WGM, gsz = (nM - fm) < WGM ? (nM - fm) : WGM;
        u.pm = fm + ((wgid % nig) % gsz); u.pn = (wgid % nig) / gsz; return true;
    }
    __device__ __forceinline__ void a_ready(const Unit&) const {}
    __device__ __forceinline__ void done(const Unit&) const {}
};

__device__ __forceinline__ unsigned cvt_pk_bf16(float lo, float hi) { unsigned r; asm volatile("v_cvt_pk_bf16_f32 %0, %1, %2" : "=v"(r) : "v"(lo), "v"(hi)); return r; }
typedef float f32x2 __attribute__((ext_vector_type(2)));
typedef unsigned u32x2 __attribute__((ext_vector_type(2)));
__device__ __forceinline__ float row_rstd(const float* ss, int row, int fq) {
    const f32x4 v = *(const f32x4*)(ss + (size_t)row * 16 + 4 * fq);
    float s = (v[0] + v[1]) + (v[2] + v[3]);
    s += __shfl_xor(s, 16); s += __shfl_xor(s, 32);
    return __builtin_amdgcn_rsqf(s * (1.0f / 1024.0f) + 1e-6f);
}
__device__ __forceinline__ void row_rstd8(const float* ss, int row0, int fq, float (&rs)[2][4]) {
    f32x4 v[2][4];
#pragma unroll
    for (int ai = 0; ai < 2; ++ai)
#pragma unroll
        for (int m = 0; m < 4; ++m) v[ai][m] = *(const f32x4*)(ss + (size_t)(row0 + ai * HALF + m * 16) * 16 + 4 * fq);
#pragma unroll
    for (int ai = 0; ai < 2; ++ai)
#pragma unroll
        for (int m = 0; m < 4; ++m) { float s = (v[ai][m][0] + v[ai][m][1]) + (v[ai][m][2] + v[ai][m][3]); s += __shfl_xor(s, 16); s += __shfl_xor(s, 32);
            rs[ai][m] = __builtin_amdgcn_rsqf(s * (1.0f / 1024.0f) + 1e-6f); }
}
struct EpiProj {
    static constexpr bool PERM = true, AFTER_DRAIN = false;
    bf16_t* O; int ldc; const float* ss;
    __device__ __forceinline__ void operator()(const f32x4 (&acc)[2][2][4][2], const Unit& u, int wr, int wc, int fr, int fq) const {
        const int row0 = u.pm * BM + wr * 64 + fr, col0 = u.pn * BM + wc * 32 + 8 * fq;
        float rsv[2][4]; row_rstd8(ss, row0, fq, rsv);
#pragma unroll
        for (int ai = 0; ai < 2; ++ai)
#pragma unroll
            for (int m = 0; m < 4; ++m) { const int row = row0 + ai * HALF + m * 16; const float rs = rsv[ai][m]; bf16_t* rowp = O + (size_t)row * ldc + col0;
#pragma unroll
                for (int bj = 0; bj < 2; ++bj) { const f32x4 v0 = acc[ai][bj][m][0] * rs, v1 = acc[ai][bj][m][1] * rs;
                    u32x4 w; w.x = cvt_pk_bf16(v0[0], v0[1]); w.y = cvt_pk_bf16(v0[2], v0[3]); w.z = cvt_pk_bf16(v1[0], v1[1]); w.w = cvt_pk_bf16(v1[2], v1[3]);
                    *(u32x4*)(rowp + bj * HALF) = w; }
                if (m & 1) asm volatile("" ::: "memory"); }
    }
};
__device__ __forceinline__ float silu_mul(float g, float u) { return g * __builtin_amdgcn_rcpf(1.0f + __expf(-g)) * u; }
struct EpiGU {
    static constexpr bool PERM = true, AFTER_DRAIN = false;
    bf16_t* O; int ldc; const float* ss;
    __device__ __forceinline__ void operator()(const f32x4 (&acc)[2][2][4][2], const Unit& u, int wr, int wc, int fr, int fq) const {
        const int row0 = u.pm * BM + wr * 64 + fr, col0 = u.pn * HALF + wc * 32 + 8 * fq;
        float rsv[2][4]; row_rstd8(ss, row0, fq, rsv);
#pragma unroll
        for (int ai = 0; ai < 2; ++ai)
#pragma unroll
            for (int m = 0; m < 4; ++m) { const int row = row0 + ai * HALF + m * 16; const float rs = rsv[ai][m];
                const f32x4 g0 = acc[ai][0][m][0] * rs, g1 = acc[ai][0][m][1] * rs, u0 = acc[ai][1][m][0] * rs, u1 = acc[ai][1][m][1] * rs;
                u32x4 w; w.x = cvt_pk_bf16(silu_mul(g0[0], u0[0]), silu_mul(g0[1], u0[1])); w.y = cvt_pk_bf16(silu_mul(g0[2], u0[2]), silu_mul(g0[3], u0[3]));
                w.z = cvt_pk_bf16(silu_mul(g1[0], u1[0]), silu_mul(g1[1], u1[1])); w.w = cvt_pk_bf16(silu_mul(g1[2], u1[2]), silu_mul(g1[3], u1[3]));
                *(u32x4*)(O + (size_t)row * ldc + col0) = w;
                if (m & 1) asm volatile("" ::: "memory"); }
    }
};
__device__ __forceinline__ float bflo(unsigned w) { return __uint_as_float(w << 16); }
__device__ __forceinline__ float bfhi(unsigned w) { return __uint_as_float(w & 0xffff0000u); }
struct EpiRes {
    static constexpr bool PERM = true, AFTER_DRAIN = false;
    bf16_t* xb; float* ss; bf16_t* xo_;
    __device__ __forceinline__ void operator()(const f32x4 (&acc)[2][2][4][2], const Unit& u, int wr, int wc, int fr, int fq) const {
        const int row0 = u.pm * BM + wr * 64 + fr, col0 = u.pn * BM + wc * 32 + 8 * fq;
#pragma unroll
        for (int ai = 0; ai < 2; ++ai) {
            u32x4 xi[4][2];
#pragma unroll
            for (int m = 0; m < 4; ++m)
#pragma unroll
                for (int bj = 0; bj < 2; ++bj) xi[m][bj] = *(const u32x4*)(xb + (size_t)(row0 + ai * HALF + m * 16) * 1024 + col0 + bj * HALF);
#pragma unroll
            for (int m = 0; m < 4; ++m) { const int row = row0 + ai * HALF + m * 16; float s = 0.f;
#pragma unroll
                for (int bj = 0; bj < 2; ++bj) { const u32x4 xw = xi[m][bj]; const f32x4 a0 = acc[ai][bj][m][0], a1 = acc[ai][bj][m][1];
                    const float v0 = bflo(xw.x) + a0[0], v1 = bfhi(xw.x) + a0[1], v2 = bflo(xw.y) + a0[2], v3 = bfhi(xw.y) + a0[3];
                    const float v4 = bflo(xw.z) + a1[0], v5 = bfhi(xw.z) + a1[1], v6 = bflo(xw.w) + a1[2], v7 = bfhi(xw.w) + a1[3];
                    u32x4 w; w.x = cvt_pk_bf16(v0, v1); w.y = cvt_pk_bf16(v2, v3); w.z = cvt_pk_bf16(v4, v5); w.w = cvt_pk_bf16(v6, v7);
                    *(u32x4*)(xo_ + (size_t)row * 1024 + col0 + bj * HALF) = w;
                    s += ((v0 * v0 + v1 * v1) + (v2 * v2 + v3 * v3)) + ((v4 * v4 + v5 * v5) + (v6 * v6 + v7 * v7)); }
                s += __shfl_xor(s, 16); s += __shfl_xor(s, 32);
                if (fq == 0) ss[(size_t)row * 16 + u.pn * 4 + wc] = s; }
            asm volatile("" ::: "memory"); }
    }
};
template <class Epi, class Sched, bool ALIGN_EPI = false, bool SP2 = false>
__device__ __forceinline__ void gemm_phase(PG8_LAS unsigned char* lds, const Gemm g, const Sched& S, const Epi& E) {
    int tid_ = threadIdx.x; asm volatile("" : "+v"(tid_)); const int tid = tid_, wid = __builtin_amdgcn_readfirstlane(tid >> 6), lane = tid & 63, wr = wid >> 2, wc = wid & 3, fr = lane & 15, fq = lane >> 4;
    const int K = g.K, nt = K / BK;
    unsigned voffA[2], voffB[2];
#pragma unroll
    for (int i = 0; i < 2; ++i) { int R, C; stage_rc(tid * 16 + i * 8192, R, C); const int Rb = Epi::PERM ? ((R & ~31) + perm32(R & 31)) : R;
        voffA[i] = (unsigned)(R * K + C) * 2u; voffB[i] = (unsigned)(Rb * K + C) * 2u; }
    const size_t kstep = (size_t)(BK * 2);
    const size_t hstep = (size_t)HALF * K * 2;
    const size_t tstep = 2 * hstep;
    const unsigned ldsw = (unsigned)wid * 1024u;
    const int aoff = lds_byte(wr * 64 + fr, fq * 8), boff = lds_byte(wc * 32 + fr, fq * 8);
#define PG8_SA(b, h) (((b) * 2 + (h)) * HTB)
#define PG8_SB(b, h) ((4 + (b) * 2 + (h)) * HTB)
#define PG8_STAGE(bufoff, gbase, voff) do { _Pragma("unroll") for (int _i = 0; _i < 2; ++_i) \
        __builtin_amdgcn_global_load_lds((const unsigned*)((const char*)(gbase) + (voff)[_i]), (PG8_LAS unsigned*)(lds + (bufoff) + ldsw + _i * 8192), 16, 0, 0); } while (0)
#define PG8_LDA(dst, b, h) do { _Pragma("unroll") for (int m = 0; m < 4; ++m) _Pragma("unroll") for (int k = 0; k < 2; ++k) dst[m][k] = *(const PG8_LAS bf16x8*)(lds + PG8_SA(b, h) + aoff + m * 2048 + k * 1024); } while (0)
#define PG8_LDB(dst, b, h) do { _Pragma("unroll") for (int n = 0; n < 2; ++n) _Pragma("unroll") for (int k = 0; k < 2; ++k) dst[n][k] = *(const PG8_LAS bf16x8*)(lds + PG8_SB(b, h) + boff + n * 2048 + k * 1024); } while (0)
#define PG8_MMA(ai, bj, At, Bt) do { __builtin_amdgcn_s_setprio(1); _Pragma("unroll") for (int m = 0; m < 4; ++m) _Pragma("unroll") for (int n = 0; n < 2; ++n) _Pragma("unroll") for (int k = 0; k < 2; ++k) \
        acc[ai][bj][m][n] = __builtin_amdgcn_mfma_f32_16x16x32_bf16(Bt[n][k], At[m][k], acc[ai][bj][m][n], 0, 0, 0); __builtin_amdgcn_s_setprio(0); } while (0)
#define PG8_WAIT_V(n) asm volatile("s_waitcnt vmcnt(" #n ")" ::: "memory")
#define PG8_WAIT_L(n) asm volatile("s_waitcnt lgkmcnt(" #n ")" ::: "memory")
#define PG8_BAR __builtin_amdgcn_s_barrier()
#define PG8_SCHED __builtin_amdgcn_sched_barrier(0)
    Unit cur, nxt; int ui = 0;
    if (!S.next(0, cur)) return;
    f32x4 acc[2][2][4][2];
#pragma unroll
    for (int a = 0; a < 2; ++a)
#pragma unroll
        for (int b = 0; b < 2; ++b)
#pragma unroll
            for (int m = 0; m < 4; ++m)
#pragma unroll
                for (int n = 0; n < 2; ++n) acc[a][b][m][n] = (f32x4){0.f, 0.f, 0.f, 0.f};
    bf16x8 At[4][2], B0[2][2], B1[2][2];
    const char* cA = (const char*)g.A + (size_t)cur.pm * tstep; const char* cB = (const char*)g.Bt + (size_t)cur.pn * tstep;
    S.a_ready(cur);
    if constexpr (SP2) {
        PG8_STAGE(PG8_SB(0, 0), cB, voffB); PG8_STAGE(PG8_SB(0, 1), cB + hstep, voffB); PG8_STAGE(PG8_SA(0, 0), cA, voffA); PG8_STAGE(PG8_SA(0, 1), cA + hstep, voffA);
        if (wr == 1) PG8_BAR;
        PG8_WAIT_V(2); PG8_BAR;
        PG8_STAGE(PG8_SB(1, 0), cB + kstep, voffB); PG8_STAGE(PG8_SA(1, 0), cA + kstep, voffA); PG8_STAGE(PG8_SB(1, 1), cB + hstep + kstep, voffB);
        PG8_WAIT_V(6); PG8_BAR;
    } else {
        PG8_STAGE(PG8_SB(0, 0), cB, voffB); PG8_STAGE(PG8_SA(0, 0), cA, voffA); PG8_STAGE(PG8_SB(0, 1), cB + hstep, voffB); PG8_STAGE(PG8_SA(0, 1), cA + hstep, voffA);
        if (wr == 1) PG8_BAR;
        PG8_WAIT_V(4); PG8_BAR;
        PG8_STAGE(PG8_SB(1, 0), cB + kstep, voffB); PG8_STAGE(PG8_SA(1, 0), cA + kstep, voffA); PG8_STAGE(PG8_SB(1, 1), cB + hstep + kstep, voffB);
        PG8_WAIT_V(6); PG8_BAR;
    }
    for (;;) {
        const bool has_next = S.next(ui + 1, nxt);
        const char* nA = has_next ? (const char*)g.A + (size_t)nxt.pm * tstep : cA; const char* nB = has_next ? (const char*)g.Bt + (size_t)nxt.pn * tstep : cB;
        for (int t = 0; t < nt; t += 2) {
            const bool last = (t == nt - 2);
            const char* a1 = cA + (size_t)(t + 1) * kstep;
            const char* a2 = last ? nA : cA + (size_t)(t + 2) * kstep; const char* b2 = last ? nB : cB + (size_t)(t + 2) * kstep;
            const char* a3 = a2 + kstep; const char* b3 = b2 + kstep;
            if (last && has_next) S.a_ready(nxt);
            if constexpr (SP2) {
            PG8_LDB(B0, 0, 0); PG8_LDB(B1, 0, 1); PG8_SCHED; PG8_LDA(At, 0, 0); PG8_STAGE(PG8_SA(1, 1), a1 + hstep, voffA);
            PG8_WAIT_V(8); PG8_WAIT_L(0); PG8_BAR; PG8_MMA(0, 0, At, B0); PG8_MMA(0, 1, At, B1); PG8_BAR; PG8_SCHED;
            PG8_LDA(At, 0, 1); PG8_STAGE(PG8_SB(0, 0), b2, voffB); PG8_STAGE(PG8_SB(0, 1), b2 + hstep, voffB); PG8_STAGE(PG8_SA(0, 0), a2, voffA);
            PG8_WAIT_V(8); PG8_WAIT_L(0); PG8_BAR; PG8_MMA(1, 0, At, B0); PG8_MMA(1, 1, At, B1); PG8_BAR; PG8_SCHED;
            PG8_LDB(B0, 1, 0); PG8_LDB(B1, 1, 1); PG8_SCHED; PG8_LDA(At, 1, 0); PG8_STAGE(PG8_SA(0, 1), a2 + hstep, voffA);
            PG8_WAIT_V(8); PG8_WAIT_L(0); PG8_BAR; PG8_MMA(0, 0, At, B0); PG8_MMA(0, 1, At, B1); PG8_BAR; PG8_SCHED;
            PG8_LDA(At, 1, 1); PG8_STAGE(PG8_SB(1, 0), b3, voffB); PG8_STAGE(PG8_SB(1, 1), b3 + hstep, voffB); PG8_STAGE(PG8_SA(1, 0), a3, voffA);
            PG8_WAIT_V(8); PG8_WAIT_L(0); PG8_BAR; PG8_MMA(1, 0, At, B0); PG8_MMA(1, 1, At, B1); PG8_BAR; PG8_SCHED;
            } else {
            PG8_LDB(B0, 0, 0); PG8_SCHED; PG8_LDA(At, 0, 0); PG8_STAGE(PG8_SA(1, 1), a1 + hstep, voffA);
            PG8_WAIT_L(8); PG8_BAR; PG8_WAIT_L(0); PG8_MMA(0, 0, At, B0); PG8_BAR; PG8_SCHED;
            PG8_LDB(B1, 0, 1); PG8_STAGE(PG8_SB(0, 0), b2, voffB);
            PG8_BAR; PG8_WAIT_L(0); PG8_MMA(0, 1, At, B1); PG8_BAR;
            PG8_LDA(At, 0, 1); PG8_STAGE(PG8_SA(0, 0), a2, voffA);
            PG8_BAR; PG8_WAIT_L(0); PG8_MMA(1, 0, At, B0); PG8_BAR; PG8_SCHED;
            PG8_STAGE(PG8_SB(0, 1), b2 + hstep, voffB);
            PG8_WAIT_V(6); PG8_BAR; PG8_MMA(1, 1, At, B1); PG8_BAR;
            PG8_LDB(B0, 1, 0); PG8_SCHED; PG8_LDA(At, 1, 0); PG8_STAGE(PG8_SA(0, 1), a2 + hstep, voffA);
            PG8_WAIT_L(8); PG8_BAR; PG8_WAIT_L(0); PG8_MMA(0, 0, At, B0); PG8_BAR; PG8_SCHED;
            PG8_LDB(B1, 1, 1); PG8_STAGE(PG8_SB(1, 0), b3, voffB);
            PG8_BAR; PG8_WAIT_L(0); PG8_MMA(0, 1, At, B1); PG8_BAR;
            PG8_LDA(At, 1, 1); PG8_STAGE(PG8_SA(1, 0), a3, voffA);
            PG8_BAR; PG8_WAIT_L(0); PG8_MMA(1, 0, At, B0); PG8_BAR; PG8_SCHED;
            PG8_STAGE(PG8_SB(1, 1), b3 + hstep, voffB);
            PG8_WAIT_V(6); PG8_BAR; PG8_MMA(1, 1, At, B1); PG8_BAR;
            }
        }
        if constexpr (ALIGN_EPI) { if (wr == 0) PG8_BAR; }
        if constexpr (!Epi::AFTER_DRAIN) { E(acc, cur, wr, wc, fr, fq); S.done(cur); }
        if (!has_next) break;
#pragma unroll
        for (int a = 0; a < 2; ++a)
#pragma unroll
            for (int b = 0; b < 2; ++b)
#pragma unroll
                for (int m = 0; m < 4; ++m)
#pragma unroll
                    for (int n = 0; n < 2; ++n) acc[a][b][m][n] = (f32x4){0.f, 0.f, 0.f, 0.f};
        cur = nxt; cA = nA; cB = nB; ++ui;
        if constexpr (ALIGN_EPI) { if (wr == 1) PG8_BAR; }
    }
    PG8_WAIT_V(0);
    if constexpr (!ALIGN_EPI) { if (wr == 0) PG8_BAR; }
    PG8_BAR;
    if constexpr (Epi::AFTER_DRAIN) { E.fused(acc, cur, wr, wc, fr, fq, lds, wid, lane); S.done(cur); }
#undef PG8_SA
#undef PG8_SB
#undef PG8_STAGE
#undef PG8_LDA
#undef PG8_LDB
#undef PG8_MMA
#undef PG8_WAIT_V
#undef PG8_WAIT_L
#undef PG8_BAR
#undef PG8_SCHED
}
}
namespace mx {
#define LAS __attribute__((address_space(3)))
typedef unsigned short bf16_t;
typedef short bf16x8 __attribute__((ext_vector_type(8)));
typedef short s16x4 __attribute__((ext_vector_type(4)));
typedef float f32x16 __attribute__((ext_vector_type(16)));
typedef float f32x2v __attribute__((ext_vector_type(2)));
typedef float f32x4v __attribute__((ext_vector_type(4)));
typedef __bf16 bf16x2v __attribute__((ext_vector_type(2)));
typedef unsigned u32x4 __attribute__((ext_vector_type(4)));
typedef unsigned u32x2 __attribute__((ext_vector_type(2)));
typedef LAS unsigned char* ldsp;
constexpr int TP = 144, TILE_B = 64 * TP;
constexpr int LDP = 2304, SEQ = 2048, DM = 1024;
constexpr float LOG2E = 1.4426950408889634f, KSC2 = 0.125f * 1.4426950408889634f, NEG = -1e30f;
constexpr int C_QA = 0, C_KA = 512, C_VA = 576, C_QB = 640, C_KCB = 896, C_VCB = 960, C_KSB = 1024, C_VSB = 1088, C_KWB = 1152, C_VWB = 1216, C_QC = 1280, C_KC = 1536, C_VC = 1792, C_GB = 2048;

__device__ __forceinline__ unsigned pk2(float lo, float hi) { f32x2v v = {lo, hi}; bf16x2v b = __builtin_convertvector(v, bf16x2v); return __builtin_bit_cast(unsigned, b); }
__device__ __forceinline__ float ex2(float x) { return __builtin_amdgcn_exp2f(x); }
__device__ __forceinline__ float bf2f(bf16_t v) { return __uint_as_float((unsigned)v << 16); }
__device__ __forceinline__ f32x16 zero16() { f32x16 z;
#pragma unroll
    for (int i = 0; i < 16; ++i) z[i] = 0.f; return z; }

__device__ __forceinline__ u32x4 tile_ld(const bf16_t* row0, size_t pitch, int tid) { return *(const u32x4*)(row0 + (size_t)(tid >> 3) * pitch + (tid & 7) * 8); }
__device__ __forceinline__ void tile_st(ldsp tile, int tid, u32x4 v) { *(LAS u32x4*)(tile + (tid >> 3) * TP + (tid & 7) * 16) = v; }

__device__ __forceinline__ void qk_tile(ldsp Kt, const bf16x8 (&qf)[4], int lane, f32x16& p0, f32x16& p1) {
    const int rho = lane & 31, h = lane >> 5;
    const int krow = 16 * ((rho >> 2) & 1) + (rho & 3) + 4 * (rho >> 3);
    ldsp kb = Kt + krow * TP + h * 16;
    p0 = zero16(); p1 = zero16();
#pragma unroll
    for (int s = 0; s < 4; ++s) {
        const bf16x8 a0 = *(const LAS bf16x8*)(kb + s * 32);
        const bf16x8 a1 = *(const LAS bf16x8*)(kb + 32 * TP + s * 32);
        p0 = __builtin_amdgcn_mfma_f32_32x32x16_bf16(a0, qf[s], p0, 0, 0, 0);
        p1 = __builtin_amdgcn_mfma_f32_32x32x16_bf16(a1, qf[s], p1, 0, 0, 0);
    }
}
__device__ __forceinline__ void qk_tile_pre(ldsp Kt, const bf16x8 (&qf)[4], int lane, f32x16& p0, f32x16& p1) {
    const int rho = lane & 31, h = lane >> 5;
    const int krow = 16 * ((rho >> 2) & 1) + (rho & 3) + 4 * (rho >> 3);
    ldsp kb = Kt + krow * TP + h * 16;
    bf16x8 a0[4], a1[4];
#pragma unroll
    for (int s = 0; s < 4; ++s) { a0[s] = *(const LAS bf16x8*)(kb + s * 32); a1[s] = *(const LAS bf16x8*)(kb + 32 * TP + s * 32); }
    asm volatile("" ::: "memory");
    p0 = zero16(); p1 = zero16();
#pragma unroll
    for (int s = 0; s < 4; ++s) { p0 = __builtin_amdgcn_mfma_f32_32x32x16_bf16(a0[s], qf[s], p0, 0, 0, 0); p1 = __builtin_amdgcn_mfma_f32_32x32x16_bf16(a1[s], qf[s], p1, 0, 0, 0); }
}
__device__ __forceinline__ s16x4 vtr(ldsp p) { return __builtin_bit_cast(s16x4, __builtin_amdgcn_ds_read_tr16_b64_v4i16((LAS s16x4*)p)); }
__device__ __forceinline__ void pv_tile(ldsp Vt, const f32x16& w0, const f32x16& w1, int lane, f32x16& o0, f32x16& o1) {
    const int i = lane & 15, g16 = lane >> 4, D0 = 16 * (g16 & 1), h = g16 >> 1;
    ldsp vb = Vt + (16 * h + (i >> 2)) * TP + (D0 + 4 * (i & 3)) * 2;
#pragma unroll
    for (int sp = 0; sp < 4; ++sp) {
        u32x4 pw;
        if (sp < 2) { const int rb = (sp & 1) * 8; pw.x = pk2(w0[rb], w0[rb + 1]); pw.y = pk2(w0[rb + 2], w0[rb + 3]); pw.z = pk2(w0[rb + 4], w0[rb + 5]); pw.w = pk2(w0[rb + 6], w0[rb + 7]); }
        else        { const int rb = (sp & 1) * 8; pw.x = pk2(w1[rb], w1[rb + 1]); pw.y = pk2(w1[rb + 2], w1[rb + 3]); pw.z = pk2(w1[rb + 4], w1[rb + 5]); pw.w = pk2(w1[rb + 6], w1[rb + 7]); }
        const bf16x8 pb = __builtin_bit_cast(bf16x8, pw);
        const int key0 = 32 * (sp >> 1) + 8 * (sp & 1);
        {   const s16x4 lo = vtr(vb + key0 * TP), hi = vtr(vb + (key0 + 4) * TP);
            const bf16x8 a = {lo[0], lo[1], lo[2], lo[3], hi[0], hi[1], hi[2], hi[3]};
            o0 = __builtin_amdgcn_mfma_f32_32x32x16_bf16(a, pb, o0, 0, 0, 0); }
        {   const s16x4 lo = vtr(vb + key0 * TP + 64), hi = vtr(vb + (key0 + 4) * TP + 64);
            const bf16x8 a = {lo[0], lo[1], lo[2], lo[3], hi[0], hi[1], hi[2], hi[3]};
            o1 = __builtin_amdgcn_mfma_f32_32x32x16_bf16(a, pb, o1, 0, 0, 0); }
    }
}
__device__ __forceinline__ void softmax_step(f32x16& p0, f32x16& p1, float& m, float& l, f32x16& o0, f32x16& o1) {
    float mx = fmaxf(p0[0], p1[0]);
#pragma unroll
    for (int r = 1; r < 16; ++r) mx = fmaxf(mx, fmaxf(p0[r], p1[r]));
    mx = fmaxf(mx, __shfl_xor(mx, 32));
    const float mn = fmaxf(m, mx), alpha = ex2(m - mn);
    float ls = 0.f;
#pragma unroll
    for (int r = 0; r < 16; ++r) { p0[r] = p0[r] > -1e29f ? ex2(p0[r] - mn) : 0.f; p1[r] = p1[r] > -1e29f ? ex2(p1[r] - mn) : 0.f; ls += p0[r] + p1[r]; }
    ls += __shfl_xor(ls, 32);
    l = l * alpha + ls; m = mn; o0 *= alpha; o1 *= alpha;
}
__device__ __forceinline__ void prep_band(f32x16& p0, f32x16& p1, int tq, int tk0, int h, float slope2, int window, bool sel) {
#pragma unroll
    for (int r = 0; r < 16; ++r) {
        const int d0 = tq - (tk0 + 16 * h + r), d1 = d0 - 32;
        p0[r] = (sel && d0 >= 0 && d0 < window) ? p0[r] * KSC2 - slope2 * (float)d0 : NEG;
        p1[r] = (sel && d1 >= 0 && d1 < window) ? p1[r] * KSC2 - slope2 * (float)d1 : NEG;
    }
}
__device__ __forceinline__ void store_o(bf16_t* dst, const f32x16& o0, const f32x16& o1, float sc, int h) {
#pragma unroll
    for (int g = 0; g < 4; ++g) {
        u32x2 a; a.x = pk2(o0[4 * g] * sc, o0[4 * g + 1] * sc); a.y = pk2(o0[4 * g + 2] * sc, o0[4 * g + 3] * sc);
        u32x2 b; b.x = pk2(o1[4 * g] * sc, o1[4 * g + 1] * sc); b.y = pk2(o1[4 * g + 2] * sc, o1[4 * g + 3] * sc);
        *(u32x2*)(dst + 8 * g + 4 * h) = a; *(u32x2*)(dst + 32 + 8 * g + 4 * h) = b;
    }
}
__device__ __forceinline__ float sumsq(const f32x16& o0, const f32x16& o1) { float s = 0.f;
#pragma unroll
    for (int r = 0; r < 16; ++r) s += o0[r] * o0[r] + o1[r] * o1[r]; return s; }

__device__ __forceinline__ void unitA(ldsp lds, const bf16_t* proj, bf16_t* mixn, const float* sinks, int b, int T, int tid) {
    const int lane = tid & 63, w = tid >> 6, c = lane & 31, h = lane >> 5, head = c & 7;
    const float slope2 = exp2f(-8.0f * (float)(head + 1) / 12.0f) * LOG2E, sink2 = sinks[head] * LOG2E;
    const bf16_t* P = proj + (size_t)b * SEQ * LDP;
    const int t0 = 64 * T, j0 = T >= 2 ? T - 2 : 0, nT = T - j0 + 1;
    u32x4 rk[3], rv[3];
#pragma unroll
    for (int i = 0; i < 3; ++i) if (i < nT) { rk[i] = tile_ld(P + (size_t)(64 * (j0 + i)) * LDP + C_KA, LDP, tid); rv[i] = tile_ld(P + (size_t)(64 * (j0 + i)) * LDP + C_VA, LDP, tid); }
    __syncthreads();
#pragma unroll
    for (int i = 0; i < 3; ++i) if (i < nT) { tile_st(lds + (2 * i) * TILE_B, tid, rk[i]); tile_st(lds + (2 * i + 1) * TILE_B, tid, rv[i]); }
    __syncthreads();
#pragma unroll 1
    for (int k = 0; k < 2; ++k) {
        const int tq = t0 + 8 * w + 4 * k + (c >> 3);
        bf16x8 qf[4];
        { const bf16_t* qp = P + (size_t)tq * LDP + C_QA + head * 64 + 8 * h;
#pragma unroll
          for (int s = 0; s < 4; ++s) qf[s] = *(const bf16x8*)(qp + 16 * s); }
        float m = sink2, l = 1.0f; f32x16 o0 = zero16(), o1 = zero16();
#pragma unroll 1
        for (int i = 0; i < nT; ++i) {
            ldsp Kt = lds + (2 * i) * TILE_B, Vt = Kt + TILE_B;
            f32x16 p0, p1; qk_tile(Kt, qf, lane, p0, p1); prep_band(p0, p1, tq, 64 * (j0 + i), h, slope2, 128, true);
            softmax_step(p0, p1, m, l, o0, o1); pv_tile(Vt, p0, p1, lane, o0, o1);
        }
        const float inv = 1.0f / l; float ss = sumsq(o0, o1) * inv * inv;
        ss += __shfl_xor(ss, 32); ss += __shfl_xor(ss, 1); ss += __shfl_xor(ss, 2); ss += __shfl_xor(ss, 4);
        const float sc = inv * __builtin_amdgcn_rsqf(ss * (1.0f / 512.0f) + 1e-6f);
        store_o(mixn + (size_t)(b * SEQ + tq) * DM + head * 64, o0, o1, sc, h);
    }
}

__device__ __forceinline__ float neg_softplus(float z) { const float az = fabsf(z); return -(fmaxf(z, 0.f) + 0.6931471805599453f * __builtin_amdgcn_logf(1.0f + ex2(-az * LOG2E))); }
__device__ __forceinline__ void stick_step(f32x16& p0, f32x16& p1, int tq, int tk0, int h, float& carry) {
    float run1 = 0.f, run0 = 0.f;
#pragma unroll
    for (int r = 15; r >= 0; --r) { const bool past = (tk0 + 32 + 16 * h + r) < tq; const float z = p1[r] * 0.125f; run1 += past ? neg_softplus(z) : 0.f; p1[r] = past ? z + run1 : NEG; }
#pragma unroll
    for (int r = 15; r >= 0; --r) { const bool past = (tk0 + 16 * h + r) < tq; const float z = p0[r] * 0.125f; run0 += past ? neg_softplus(z) : 0.f; p0[r] = past ? z + run0 : NEG; }
    const float ot1 = __shfl_xor(run1, 32), ot0 = __shfl_xor(run0, 32);
    const float off1 = carry + (h == 0 ? ot1 : 0.f);
    const float off0 = carry + run1 + ot1 + (h == 0 ? ot0 : 0.f);
    carry += (run0 + ot0) + (run1 + ot1);
#pragma unroll
    for (int r = 0; r < 16; ++r) { p1[r] = p1[r] > -1e29f ? ex2((p1[r] + off1) * LOG2E) : 0.f; p0[r] = p0[r] > -1e29f ? ex2((p0[r] + off0) * LOG2E) : 0.f; }
}
constexpr int C_SS_OFF = 8 * TILE_B;
__device__ __forceinline__ void unitC(ldsp lds, const bf16_t* proj, bf16_t* mixn, int b, int T, int tid) {
    const int lane = tid & 63, w = tid >> 6, c = lane & 31, h = lane >> 5, hd = w >> 1, ql = 32 * (w & 1) + c, tq = 64 * T + ql;
    const bf16_t* P = proj + (size_t)b * SEQ * LDP;
    bf16x8 qf[4];
    { const bf16_t* qp = P + (size_t)tq * LDP + C_QC + hd * 64 + 8 * h;
#pragma unroll
      for (int s = 0; s < 4; ++s) qf[s] = *(const bf16x8*)(qp + 16 * s); }
    f32x16 o0 = zero16(), o1 = zero16(); float carry = 0.f;
    u32x4 rg[8];
#pragma unroll
    for (int i = 0; i < 8; ++i) rg[i] = tile_ld(P + (size_t)(64 * T) * LDP + (i < 4 ? C_KC + i * 64 : C_VC + (i - 4) * 64), LDP, tid);
    LAS float* CF = (LAS float*)(lds + C_SS_OFF + 1024);
    for (int jt = T; jt >= 0; --jt) {
        __syncthreads();
        if (jt < T) {
            const float mc = fmaxf(fmaxf(fmaxf(CF[0], CF[1]), fmaxf(CF[2], CF[3])), fmaxf(fmaxf(CF[4], CF[5]), fmaxf(CF[6], CF[7])));
            if (mc < -40.0f) break;
        }
#pragma unroll
        for (int i = 0; i < 8; ++i) tile_st(lds + ((i & 3) * 2 + (i >> 2)) * TILE_B, tid, rg[i]);
        __syncthreads();
        if (jt > 0) {
#pragma unroll
            for (int i = 0; i < 8; ++i) rg[i] = tile_ld(P + (size_t)(64 * (jt - 1)) * LDP + (i < 4 ? C_KC + i * 64 : C_VC + (i - 4) * 64), LDP, tid); }
        f32x16 p0, p1; qk_tile(lds + hd * 2 * TILE_B, qf, lane, p0, p1);
        stick_step(p0, p1, tq, 64 * jt, h, carry);
        { float wc = carry;
#pragma unroll
          for (int o = 1; o < 64; o <<= 1) wc = fmaxf(wc, __shfl_xor(wc, o));
          if (lane == 0) CF[w] = wc; }
        pv_tile(lds + hd * 2 * TILE_B + TILE_B, p0, p1, lane, o0, o1);
    }
    float ss = sumsq(o0, o1); ss += __shfl_xor(ss, 32);
    LAS float* SS = (LAS float*)(lds + C_SS_OFF);
    if (h == 0) SS[ql * 4 + hd] = ss;
    __syncthreads();
    const float tot = (SS[ql * 4 + 0] + SS[ql * 4 + 1]) + (SS[ql * 4 + 2] + SS[ql * 4 + 3]);
    const float sc = __builtin_amdgcn_rsqf(tot * (1.0f / 256.0f) + 1e-6f);
    store_o(mixn + (size_t)(b * SEQ + tq) * DM + 768 + hd * 64, o0, o1, sc, h);
}

template <int MODE, bool INTERIOR>
__device__ __forceinline__ void kv_range(ldsp lds, const bf16_t* Kg, const bf16_t* Vg, int jlo, int jhi, int jend, u32x4& rka, u32x4& rva, ldsp qs_, int tq, float slope2, unsigned sel,
                                         int tid, int lane, int h, float& m, float& l, f32x16& o0, f32x16& o1) {
    const float qs = slope2 * (1.0f / KSC2);
    for (int jt = jlo; jt <= jhi; ++jt) {
        u32x4 rkb = rka, rvb = rva;
        if (jt + 2 <= jend) { rkb = tile_ld(Kg + (size_t)(64 * (jt + 2)) * LDP, LDP, tid); rvb = tile_ld(Vg + (size_t)(64 * (jt + 2)) * LDP, LDP, tid); }
        ldsp Kt = lds + (jt & 1) * 2 * TILE_B, Vt = Kt + TILE_B;
        const bool mine = MODE == 0 ? ((sel >> jt) & 1u) != 0u : true;
        if (MODE == 1 || __any(mine ? 1 : 0)) {
            ldsp qsl = qs_; asm volatile("" : "+v"(qsl));
            bf16x8 qf[4];
#pragma unroll
            for (int s = 0; s < 4; ++s) qf[s] = *(const LAS bf16x8*)(qsl + s * 1024);
            f32x16 p0, p1; if (INTERIOR) qk_tile_pre(Kt, qf, lane, p0, p1); else qk_tile(Kt, qf, lane, p0, p1);
            if (INTERIOR) {
                const float A0 = mine ? -slope2 * (float)(tq - 64 * jt - 16 * h) : NEG, A1 = mine ? A0 + 32.0f * slope2 : NEG;
                float mx0 = NEG, mx1 = NEG;
#pragma unroll
                for (int r = 0; r < 16; ++r) { p0[r] = __builtin_fmaf(qs, (float)r, p0[r]); mx0 = fmaxf(mx0, p0[r]); p1[r] = __builtin_fmaf(qs, (float)r, p1[r]); mx1 = fmaxf(mx1, p1[r]); }
                float mxv = fmaxf(__builtin_fmaf(mx0, KSC2, A0), __builtin_fmaf(mx1, KSC2, A1)); mxv = fmaxf(mxv, __shfl_xor(mxv, 32));
                const float mn = fmaxf(m, mxv), alpha = ex2(m - mn);
                const float c0 = mine ? A0 - mn : -3e38f, c1 = mine ? A1 - mn : -3e38f;
                float ls = 0.f;
#pragma unroll
                for (int r = 0; r < 16; ++r) { p0[r] = ex2(__builtin_fmaf(p0[r], KSC2, c0)); p1[r] = ex2(__builtin_fmaf(p1[r], KSC2, c1)); ls += p0[r] + p1[r]; }
                ls += __shfl_xor(ls, 32);
                l = l * alpha + ls; m = mn; o0 *= alpha; o1 *= alpha;
            } else {
                prep_band(p0, p1, tq, 64 * jt, h, slope2, MODE == 0 ? 4096 : 512, mine);
                softmax_step(p0, p1, m, l, o0, o1);
            }
            pv_tile(Vt, p0, p1, lane, o0, o1);
        }
        if (jt + 1 <= jend) { ldsp Kn = lds + ((jt + 1) & 1) * 2 * TILE_B; tile_st(Kn, tid, rka); tile_st(Kn + TILE_B, tid, rva); }
        __syncthreads();
        rka = rkb; rva = rvb;
    }
}
__device__ __forceinline__ void kv_start(ldsp lds, const bf16_t* Kg, const bf16_t* Vg, int jlo, int jend, u32x4& rka, u32x4& rva, int tid) {
    const u32x4 k0 = tile_ld(Kg + (size_t)(64 * jlo) * LDP, LDP, tid), v0 = tile_ld(Vg + (size_t)(64 * jlo) * LDP, LDP, tid);
    rka = k0; rva = v0;
    if (jlo + 1 <= jend) { rka = tile_ld(Kg + (size_t)(64 * (jlo + 1)) * LDP, LDP, tid); rva = tile_ld(Vg + (size_t)(64 * (jlo + 1)) * LDP, LDP, tid); }
    __syncthreads();
    ldsp Kt = lds + (jlo & 1) * 2 * TILE_B; tile_st(Kt, tid, k0); tile_st(Kt + TILE_B, tid, v0);
    __syncthreads();
}
constexpr int B_CK = 4 * TILE_B, B_CV = 6 * TILE_B, B_IMP = 8 * TILE_B, B_MASK = B_IMP + 16384;
constexpr int B_GL = B_MASK + 256;
__device__ __forceinline__ void unitB(ldsp lds, const bf16_t* proj, const bf16_t* kc, const bf16_t* vc, bf16_t* mixn, const bf16_t* xb, const float* ssq, const bf16_t* wg, int b, int T, int tid) {
    const int lane = tid & 63, w = tid >> 6, c = lane & 31, h = lane >> 5, hd = c & 3, qloc = c >> 2, tq = 64 * T + 8 * w + qloc;
    const float slope2 = exp2f(-8.0f * (float)(hd + 9) / 12.0f) * LOG2E;
    const bf16_t* P = proj + (size_t)b * SEQ * LDP;
    bf16x8 qf[4];
    { const bf16_t* qp = P + (size_t)tq * LDP + C_QB + hd * 64 + 8 * h;
#pragma unroll
      for (int s = 0; s < 4; ++s) qf[s] = *(const bf16x8*)(qp + 16 * s); }
    LAS float* GL = (LAS float*)(lds + B_GL); LAS float* GP = GL + 768;
    u32x4 ckr[2], cvr[2];
#pragma unroll
    for (int t = 0; t < 2; ++t) { int n = 64 * t + (tid >> 3); n = n > 126 ? 126 : n; const size_t off = ((size_t)b * 128 + n) * 64 + (tid & 7) * 8;
        ckr[t] = *(const u32x4*)(kc + off); cvr[t] = *(const u32x4*)(vc + off); }
    { const int th = w & 1, kq = w >> 1, gc = c < 12 ? c : 11;
      const bf16_t* xa = xb + ((size_t)b * SEQ + 64 * T + 32 * th + c) * DM + 256 * kq + 8 * h;
      const bf16_t* wb = wg + (size_t)gc * 1024 + 256 * kq + 8 * h;
      f32x16 ga = zero16();
#pragma unroll 8
      for (int s = 0; s < 16; ++s) { const bf16x8 xa8 = *(const bf16x8*)(xa + 16 * s), wb8 = *(const bf16x8*)(wb + 16 * s); ga = __builtin_amdgcn_mfma_f32_32x32x16_bf16(xa8, wb8, ga, 0, 0, 0); }
      if (c < 12) {
#pragma unroll
          for (int r = 0; r < 16; ++r) GP[(kq * 64 + 32 * th + (r & 3) + 8 * (r >> 2) + 4 * h) * 12 + c] = ga[r]; } }
#define B_GATE(i) (GL[(8 * w + qloc) * 12 + hd * 3 + (i)])
    f32x16 ob0 = zero16(), ob1 = zero16();
    const int ntc = T >= 16 ? 2 : 1;
    __syncthreads();
    { int t2 = tid; asm volatile("" : "+v"(t2));
#pragma unroll 1
      for (; t2 < 768; t2 += 512) { const int tk = t2 / 12; const size_t row = (size_t)b * SEQ + 64 * T + tk;
        const f32x4v* sp = (const f32x4v*)(ssq + row * 16); const f32x4v s0 = sp[0], s1 = sp[1], s2 = sp[2], s3 = sp[3];
        const float sq = ((s0[0] + s0[1]) + (s0[2] + s0[3])) + ((s1[0] + s1[1]) + (s1[2] + s1[3])) + ((s2[0] + s2[1]) + (s2[2] + s2[3])) + ((s3[0] + s3[1]) + (s3[2] + s3[3]));
        const float rs = __builtin_amdgcn_rsqf(sq * (1.0f / 1024.0f) + 1e-6f);
        const float gv = (GP[t2] + GP[768 + t2]) + (GP[1536 + t2] + GP[2304 + t2]);
        GL[t2] = 1.0f / (1.0f + __expf(-gv * rs)); } }
#pragma unroll
    for (int t = 0; t < 2; ++t) { tile_st(lds + B_CK + t * TILE_B, tid, ckr[t]); tile_st(lds + B_CV + t * TILE_B, tid, cvr[t]); }
    __syncthreads();
    unsigned sel;
    {
        f32x16 pa0, pa1, pb0, pb1;
        qk_tile(lds + B_CK, qf, lane, pa0, pa1);
        if (ntc == 2) qk_tile(lds + B_CK + TILE_B, qf, lane, pb0, pb1); else { pb0 = zero16(); pb1 = zero16(); }
        float mxv = NEG;
#pragma unroll
        for (int r = 0; r < 16; ++r) {
            const int n0 = 16 * h + r; const int d0 = tq - (16 * n0 + 31), d1 = d0 - 512, d2 = d0 - 1024, d3 = d0 - 1536;
            pa0[r] = d0 >= 0 ? pa0[r] * KSC2 - slope2 * (float)d0 : NEG; pa1[r] = d1 >= 0 ? pa1[r] * KSC2 - slope2 * (float)d1 : NEG;
            pb0[r] = d2 >= 0 ? pb0[r] * KSC2 - slope2 * (float)d2 : NEG; pb1[r] = d3 >= 0 ? pb1[r] * KSC2 - slope2 * (float)d3 : NEG;
            mxv = fmaxf(fmaxf(mxv, fmaxf(pa0[r], pa1[r])), fmaxf(pb0[r], pb1[r]));
        }
        mxv = fmaxf(mxv, __shfl_xor(mxv, 32));
        float ls = 0.f;
#pragma unroll
        for (int r = 0; r < 16; ++r) {
            pa0[r] = pa0[r] > -1e29f ? ex2(pa0[r] - mxv) : 0.f; pa1[r] = pa1[r] > -1e29f ? ex2(pa1[r] - mxv) : 0.f;
            pb0[r] = pb0[r] > -1e29f ? ex2(pb0[r] - mxv) : 0.f; pb1[r] = pb1[r] > -1e29f ? ex2(pb1[r] - mxv) : 0.f;
            ls += (pa0[r] + pa1[r]) + (pb0[r] + pb1[r]);
        }
        ls += __shfl_xor(ls, 32);
        const float inv = ls > 0.f ? 1.0f / ls : 0.f;
        f32x16 oc0 = zero16(), oc1 = zero16();
        pv_tile(lds + B_CV, pa0, pa1, lane, oc0, oc1);
        if (ntc == 2) pv_tile(lds + B_CV + TILE_B, pb0, pb1, lane, oc0, oc1);
        const float gs = B_GATE(0) * inv;
        ob0 += oc0 * gs; ob1 += oc1 * gs;
        LAS float* IA = (LAS float*)(lds + B_IMP) + w * 512 + qloc * 32;
        LAS float* IB = IA + 256;
#pragma unroll
        for (int g = 0; g < 4; ++g) {
            float a0 = (2.0f * (pa0[4 * g] + pa0[4 * g + 1] + pa0[4 * g + 2]) + pa0[4 * g + 3]) * inv, b0 = pa0[4 * g + 3] * inv;
            float a1 = (2.0f * (pa1[4 * g] + pa1[4 * g + 1] + pa1[4 * g + 2]) + pa1[4 * g + 3]) * inv, b1 = pa1[4 * g + 3] * inv;
            float a2 = (2.0f * (pb0[4 * g] + pb0[4 * g + 1] + pb0[4 * g + 2]) + pb0[4 * g + 3]) * inv, b2 = pb0[4 * g + 3] * inv;
            float a3 = (2.0f * (pb1[4 * g] + pb1[4 * g + 1] + pb1[4 * g + 2]) + pb1[4 * g + 3]) * inv, b3 = pb1[4 * g + 3] * inv;
            a0 += __shfl_xor(a0, 1); a0 += __shfl_xor(a0, 2); b0 += __shfl_xor(b0, 1); b0 += __shfl_xor(b0, 2);
            a1 += __shfl_xor(a1, 1); a1 += __shfl_xor(a1, 2); b1 += __shfl_xor(b1, 1); b1 += __shfl_xor(b1, 2);
            a2 += __shfl_xor(a2, 1); a2 += __shfl_xor(a2, 2); b2 += __shfl_xor(b2, 1); b2 += __shfl_xor(b2, 2);
            a3 += __shfl_xor(a3, 1); a3 += __shfl_xor(a3, 2); b3 += __shfl_xor(b3, 1); b3 += __shfl_xor(b3, 2);
            if (hd == 0) { const int j = 4 * h + g; IA[j] = a0; IB[j] = b0; IA[8 + j] = a1; IB[8 + j] = b1; IA[16 + j] = a2; IB[16 + j] = b2; IA[24 + j] = a3; IB[24 + j] = b3; }
        }
        asm volatile("s_waitcnt lgkmcnt(0)" ::: "memory"); __builtin_amdgcn_wave_barrier();
        LAS unsigned* MK = (LAS unsigned*)(lds + B_MASK) + w * 8;
        if (lane < 8) {
            const LAS float* SA = (const LAS float*)(lds + B_IMP) + w * 512 + lane * 32; const LAS float* SB = SA + 256;
            float iv[32];
#pragma unroll
            for (int j = 1; j < 32; ++j) iv[j] = SA[j] + SB[j - 1];
            unsigned mk = 1u | (1u << T) | (T >= 1 ? (1u << (T - 1)) : 0u);
            const int need = 8 - __popc(mk);
#pragma unroll
            for (int j = 1; j < 32; ++j) if (j > T || ((mk >> j) & 1u)) iv[j] = -1.0f;
#pragma unroll 1
            for (int it = 0; it < need; ++it) {
                int best = 0; float bv = -0.5f;
#pragma unroll
                for (int j = 1; j < 32; ++j) { const bool gt = iv[j] > bv; bv = gt ? iv[j] : bv; best = gt ? j : best; }
                if (best == 0) break;
                mk |= 1u << best;
#pragma unroll
                for (int j = 1; j < 32; ++j) iv[j] = (j == best) ? -1.0f : iv[j];
            }
            MK[lane] = mk;
        }
        asm volatile("s_waitcnt lgkmcnt(0)" ::: "memory"); __builtin_amdgcn_wave_barrier();
        sel = MK[qloc];
    }
    ldsp qpB = lds + B_GL + 3072 + w * 4096 + lane * 16;
#pragma unroll
    for (int s = 0; s < 4; ++s) *(LAS bf16x8*)(qpB + s * 1024) = qf[s];
    { float m = NEG, l = 0.f; f32x16 o0 = zero16(), o1 = zero16();
      const bf16_t* Kg = P + C_KSB; const bf16_t* Vg = P + C_VSB; u32x4 rk, rv;
      kv_start(lds, Kg, Vg, 0, T, rk, rv, tid);
      if (T > 0) kv_range<0, true>(lds, Kg, Vg, 0, T - 1, T, rk, rv, qpB, tq, slope2, sel, tid, lane, h, m, l, o0, o1);
      kv_range<0, false>(lds, Kg, Vg, T, T, T, rk, rv, qpB, tq, slope2, sel, tid, lane, h, m, l, o0, o1);
      const float gs = B_GATE(1) / l; ob0 += o0 * gs; ob1 += o1 * gs; }
    { float m = NEG, l = 0.f; f32x16 o0 = zero16(), o1 = zero16();
      const bf16_t* Kg = P + C_KWB; const bf16_t* Vg = P + C_VWB; u32x4 rk, rv;
      const int jlo = T >= 8 ? T - 8 : 0;
      kv_start(lds, Kg, Vg, jlo, T, rk, rv, tid);
      if (T >= 8) kv_range<1, false>(lds, Kg, Vg, T - 8, T - 8, T, rk, rv, qpB, tq, slope2, 0u, tid, lane, h, m, l, o0, o1);
      if (T >= 1) kv_range<1, true>(lds, Kg, Vg, T >= 7 ? T - 7 : 0, T - 1, T, rk, rv, qpB, tq, slope2, 0u, tid, lane, h, m, l, o0, o1);
      kv_range<1, false>(lds, Kg, Vg, T, T, T, rk, rv, qpB, tq, slope2, 0u, tid, lane, h, m, l, o0, o1);
      const float gs = B_GATE(2) / l; ob0 += o0 * gs; ob1 += o1 * gs; }
    float ss = sumsq(ob0, ob1); ss += __shfl_xor(ss, 32); ss += __shfl_xor(ss, 1); ss += __shfl_xor(ss, 2);
    const float sc = __builtin_amdgcn_rsqf(ss * (1.0f / 256.0f) + 1e-6f);
    store_o(mixn + (size_t)(b * SEQ + tq) * DM + 512 + hd * 64, ob0, ob1, sc, h);
}

__device__ __forceinline__ float gelu_tanh(float x) { const float u = 0.7978845608028654f * (x + 0.044715f * x * x * x); const float e = __expf(2.0f * u); return 0.5f * x * (1.0f + (1.0f - 2.0f / (e + 1.0f))); }
__device__ __forceinline__ void unitCmp(const bf16_t* proj, const bf16_t* w1t, const bf16_t* w2t, const float* bias1, bf16_t* kc, bf16_t* vc, int b, int tid) {
    const int lane = tid & 63, w = tid >> 6, c = lane & 31, h = lane >> 5, g = w >> 1, kv = w & 1;
    const int n = 32 * g + c, nn = n > 126 ? 126 : n;
    const bf16_t* src = proj + ((size_t)b * SEQ + 16 * nn) * LDP + (kv ? C_VCB : C_KCB) + 8 * h;
    const bf16_t* wa = w1t + (size_t)kv * 128 * 2048 + (size_t)lane * 8;
    f32x16 acc[4] = {zero16(), zero16(), zero16(), zero16()};
#pragma unroll 4
    for (int s = 0; s < 128; ++s) {
        const bf16x8 bq = *(const bf16x8*)(src + (size_t)(s >> 2) * LDP + (s & 3) * 16);
#pragma unroll
        for (int fb = 0; fb < 4; ++fb) { const bf16x8 a = *(const bf16x8*)(wa + ((size_t)fb * 128 + s) * 512); acc[fb] = __builtin_amdgcn_mfma_f32_32x32x16_bf16(a, bq, acc[fb], 0, 0, 0); }
    }
    f32x16 y0 = zero16(), y1 = zero16();
    const bf16_t* w2a = w2t + ((size_t)kv * 64 + c) * 128;
#pragma unroll
    for (int fb = 0; fb < 4; ++fb) {
#pragma unroll
        for (int r = 0; r < 16; ++r) acc[fb][r] = gelu_tanh(acc[fb][r] + bias1[kv * 128 + 32 * fb + (r & 3) + 8 * (r >> 2) + 4 * h]);
#pragma unroll
        for (int s2 = 0; s2 < 2; ++s2) {
            u32x4 pw; const int rb = 8 * s2; pw.x = pk2(acc[fb][rb], acc[fb][rb + 1]); pw.y = pk2(acc[fb][rb + 2], acc[fb][rb + 3]); pw.z = pk2(acc[fb][rb + 4], acc[fb][rb + 5]); pw.w = pk2(acc[fb][rb + 6], acc[fb][rb + 7]);
            const bf16x8 hb = __builtin_bit_cast(bf16x8, pw);
            const int f0 = 32 * fb + 16 * s2 + 4 * h;
            { const u32x2 lo = *(const u32x2*)(w2a + f0), hi = *(const u32x2*)(w2a + f0 + 8); u32x4 av; av.x = lo.x; av.y = lo.y; av.z = hi.x; av.w = hi.y;
              y0 = __builtin_amdgcn_mfma_f32_32x32x16_bf16(__builtin_bit_cast(bf16x8, av), hb, y0, 0, 0, 0); }
            { const u32x2 lo = *(const u32x2*)(w2a + 32 * 128 + f0), hi = *(const u32x2*)(w2a + 32 * 128 + f0 + 8); u32x4 av; av.x = lo.x; av.y = lo.y; av.z = hi.x; av.w = hi.y;
              y1 = __builtin_amdgcn_mfma_f32_32x32x16_bf16(__builtin_bit_cast(bf16x8, av), hb, y1, 0, 0, 0); }
        }
    }
    if (n < 127) store_o((kv ? vc : kc) + ((size_t)b * 128 + n) * 64, y0, y1, 1.0f, h);
}
}
using mx::ldsp; using mx::bf16_t;
typedef float f32x4 __attribute__((ext_vector_type(4)));
typedef unsigned u32x4 __attribute__((ext_vector_type(4)));
typedef unsigned u32x2 __attribute__((ext_vector_type(2)));
constexpr int BATCH = 32, SEQ = 2048, DM = 1024, DEPTH = 4, MTOK = BATCH * SEQ, NPROJ = 2048, INW = 2060, DFF = 2816, NGU = 2 * DFF;
constexpr size_t MiB = 1u << 20;
constexpr size_t WS_BAR = 64 * 1024, WS_ZERO_BYTES = 128 * 1024;
constexpr size_t WS_CTR = 0;
constexpr size_t WS_WIN = 1 * MiB, SZ_WIN = (size_t)NPROJ * DM * 2;
constexpr size_t WS_WOUT = 19 * MiB, SZ_WOUT = (size_t)DM * DM * 2;
constexpr size_t WS_WGU = 27 * MiB, SZ_WGU = (size_t)NGU * DM * 2;
constexpr size_t WS_WDN = 71 * MiB, SZ_WDN = (size_t)DM * DFF * 2;
constexpr size_t WS_W1T = 93 * MiB, SZ_W1T = (size_t)2 * 128 * 2048 * 2;
constexpr size_t WS_W2T = 97 * MiB, SZ_W2T = (size_t)2 * 64 * 128 * 2;
constexpr size_t WS_B1 = 97 * MiB + 512 * 1024, SZ_B1 = 2 * 128 * 4;
constexpr size_t WS_WG = 97 * MiB + 768 * 1024, SZ_WG = 32 * 1024;
constexpr size_t WS_KC = 98 * MiB, WS_VC = 98 * MiB + 512 * 1024;
constexpr size_t WS_SS = 100 * MiB;
constexpr size_t WS_XB = 104 * MiB;
constexpr size_t WS_PROJ = 232 * MiB;
constexpr size_t WS_MIXN = 520 * MiB;
constexpr size_t WS_HID = 232 * MiB;
constexpr size_t WS_END = 648 * MiB;
static_assert(WS_WIN + 4 * SZ_WIN <= WS_WOUT && WS_WOUT + 4 * SZ_WOUT <= WS_WGU && WS_WGU + 4 * SZ_WGU <= WS_WDN && WS_WDN + 4 * SZ_WDN <= WS_W1T && WS_W1T + 4 * SZ_W1T <= WS_W2T, "ws map");
static_assert(WS_HID + (size_t)MTOK * DFF * 2 <= WS_END && WS_PROJ + (size_t)MTOK * mx::LDP * 2 <= WS_MIXN && WS_XB + (size_t)MTOK * DM * 2 <= WS_PROJ, "ws map 2");
constexpr int LDS_BYTES = 143360, LDS_CTL = 131072;
constexpr int NPHASE = 2 + 6 * DEPTH;

#define RLX_AGENT __ATOMIC_RELAXED, __HIP_MEMORY_SCOPE_AGENT
#define XB_TMO      128
#define XB_XCNT(j)  (256  + 64 * (j))
#define XB_XSUB(j)  (1280 + 64 * (j))
#define XB_XGEN(j)  (2304 + 64 * (j))
#define XB_TOP      3328
#define XB_TOPGEN   3392
#define XCD_BAR_WORDS 3456
#define XB_SPIN_CAP (1u << 18)

__device__ __forceinline__ unsigned xb_ld(unsigned* p)              { return __hip_atomic_load(p, __ATOMIC_RELAXED, __HIP_MEMORY_SCOPE_AGENT); }
__device__ __forceinline__ unsigned xb_add(unsigned* p, unsigned v) { return __hip_atomic_fetch_add(p, v, __ATOMIC_RELAXED, __HIP_MEMORY_SCOPE_AGENT); }
__device__ __forceinline__ unsigned xb_xcc_id() { return (unsigned)__builtin_amdgcn_s_getreg((3 << 11) | 20) & 0xFu; }
#define XB_SPIN(cond, bar) do { unsigned _sp = 0; while (cond) { __builtin_amdgcn_s_sleep(1); \
    if ((++_sp & 255u) == 0u) { if (xb_ld(&(bar)[XB_TMO])) break; if (_sp > XB_SPIN_CAP) { atomicAdd(&(bar)[XB_TMO], 1u); break; } } } } while (0)

struct XcdBarrier {
    unsigned* bar; unsigned x;
    volatile LAS unsigned* st;
};

__device__ __forceinline__ XcdBarrier xcd_barrier_post(unsigned* bar, volatile LAS unsigned* st) {
    XcdBarrier b; b.bar = bar; b.x = xb_xcc_id(); b.st = st;
    if (threadIdx.x == 0) (void)xb_add(&bar[XB_XCNT(b.x)], 1u);
    return b;
}
__device__ __forceinline__ void xcd_barrier_complete(unsigned* bar, unsigned x, unsigned& nloc, unsigned& nx) {
    const unsigned G = gridDim.x * gridDim.y * gridDim.z;
    unsigned sum, cnt, mine, sp = 0u;
    for (;;) {
        sum = 0u; cnt = 0u; mine = 0u;
#pragma unroll
        for (unsigned j = 0; j < 16; ++j) { const unsigned c = xb_ld(&bar[XB_XCNT(j)]); sum += c; cnt += (c > 0u) ? 1u : 0u; mine = (j == x) ? c : mine; }
        if (sum == G) break;
        __builtin_amdgcn_s_sleep(1);
        if ((++sp & 255u) == 0u) { if (xb_ld(&bar[XB_TMO])) break; if (sp > XB_SPIN_CAP) { atomicAdd(&bar[XB_TMO], 1u); break; } }
    }
    nloc = mine > 0u ? mine : 1u; nx = cnt > 0u ? cnt : 1u;
}

__device__ __forceinline__ void xcd_barrier(const XcdBarrier& b) {
    asm volatile("s_waitcnt vmcnt(0)" ::: "memory");
    __syncthreads();
    if (threadIdx.x == 0) {
        unsigned* bar = b.bar; asm volatile("" : "+s"(bar));
        __builtin_amdgcn_s_waitcnt(0);
        unsigned nloc = b.st[0], nx = b.st[1];
        if (nloc == 0u) { xcd_barrier_complete(bar, b.x, nloc, nx); b.st[0] = nloc; b.st[1] = nx; }
        const unsigned old = xb_add(&bar[XB_XSUB(b.x)], 1u);
        const unsigned gen = old / nloc;
        if (old + 1u == (gen + 1u) * nloc) {
            __builtin_amdgcn_fence(__ATOMIC_RELEASE, "agent");
            asm volatile("s_waitcnt vmcnt(0)" ::: "memory");
            const unsigned og = xb_add(&bar[XB_TOP], 1u);
            const unsigned tg = og / nx;
            if (og + 1u == (tg + 1u) * nx) xb_add(&bar[XB_TOPGEN], 1u);
            else XB_SPIN(xb_ld(&bar[XB_TOPGEN]) == tg, bar);
            __builtin_amdgcn_fence(__ATOMIC_ACQUIRE, "agent");
            xb_add(&bar[XB_XGEN(b.x)], 1u);
            asm volatile("s_waitcnt vmcnt(0)" ::: "memory");
        } else {
            XB_SPIN(xb_ld(&bar[XB_XGEN(b.x)]) == gen, bar);
            __builtin_amdgcn_fence(__ATOMIC_ACQUIRE, "agent");
            asm volatile("s_waitcnt vmcnt(0)" ::: "memory");
        }
    }
    __syncthreads();
}

struct Params { const float* in[16]; float* out; unsigned char* ws; int ph_lo, ph_hi; };

__device__ __forceinline__ float wave_sum(float v) {
#pragma unroll
    for (int o = 1; o < 64; o <<= 1) v += __shfl_xor(v, o);
    return v;
}
template <class RowMap>
__device__ __forceinline__ void transpose_item(const float* W, int K, int N, const float* gk0  , bf16_t* WT, RowMap rm, LAS float* scr, int kb, int nb, int lane) {
    const int k0 = 64 * kb, n0 = 32 * nb, nl = n0 + (lane & 31);
#pragma unroll 4
    for (int i = 0; i < 32; ++i) { const int kk = 2 * i + (lane >> 5); float v = nl < N ? W[(size_t)(k0 + kk) * N + nl] : 0.f; if (gk0) v *= gk0[kk]; scr[kk * 33 + (lane & 31)] = v; }
    asm volatile("s_waitcnt lgkmcnt(0)" ::: "memory"); __builtin_amdgcn_wave_barrier();
    const int c = lane & 7;
#pragma unroll
    for (int j = 0; j < 4; ++j) { const int n = (lane >> 3) + 8 * j; const LAS float* s = scr + (8 * c) * 33 + n;
        u32x4 o; o.x = mx::pk2(s[0 * 33], s[1 * 33]); o.y = mx::pk2(s[2 * 33], s[3 * 33]); o.z = mx::pk2(s[4 * 33], s[5 * 33]); o.w = mx::pk2(s[6 * 33], s[7 * 33]);
        if (n0 + n < N) *(u32x4*)(WT + rm(n0 + n, k0 + 8 * c)) = o; }
    asm volatile("s_waitcnt lgkmcnt(0)" ::: "memory"); __builtin_amdgcn_wave_barrier();
}
struct RmId { int K; __device__ size_t operator()(int n, int k) const { return (size_t)n * K + k; } };
struct RmW1 { __device__ size_t operator()(int f, int k) const { return ((size_t)((f >> 5) * 128 + (k >> 4)) * 64 + (((k >> 3) & 1) * 32 + (f & 31))) * 8; } };
struct RmIn { size_t gdelta; __device__ size_t operator()(int n, int k) const { return n < 1280 ? (size_t)n * 1024 + k : (n < 1292 ? gdelta + (size_t)(n - 1280) * 1024 + k : (size_t)(n - 12) * 1024 + k); } };
struct RmGU { int up; __device__ size_t operator()(int n, int k) const { return (size_t)(256 * (n >> 7) + 128 * up + (n & 127)) * 1024 + k; } };

constexpr int I_IN = 16 * 65, I_OUT = 16 * 32, I_G = 16 * 88, I_DN = 44 * 32, I_W1 = 2 * 32 * 4, I_W2 = 2 * 2 * 2;
constexpr int I_LAYER = I_IN + I_OUT + 2 * I_G + I_DN + I_W1 + I_W2, CONV_UNITS = (I_LAYER + 7) / 8;
__device__ __forceinline__ void convert_item(const Params& p, int L, int r, LAS float* scr, int lane) {
    unsigned char* ws = p.ws;
    const float *w_in = p.in[1], *w_out = p.in[2], *g_attn = p.in[3], *g_ffn = p.in[4], *g_oa = p.in[5], *g_ob = p.in[6], *g_oc = p.in[7];
    const float *cmp_w1 = p.in[10], *cmp_w2 = p.in[11], *w_gate = p.in[12], *w_up = p.in[13], *w_down = p.in[14];
    if (r < I_IN) { const int kb = r / 65, nb = r % 65; transpose_item(w_in + (size_t)L * DM * INW, DM, INW, g_attn + L * DM + 64 * kb, (bf16_t*)(ws + WS_WIN + L * SZ_WIN), RmIn{((WS_WG + L * SZ_WG) - (WS_WIN + L * SZ_WIN)) / 2}, scr, kb, nb, lane); return; } r -= I_IN;
    if (r < I_OUT) { const int kb = r / 32, nb = r % 32, k0 = 64 * kb;
        const float* g = k0 < 512 ? g_oa + L * 512 + k0 : (k0 < 768 ? g_ob + L * 256 + (k0 - 512) : g_oc + L * 256 + (k0 - 768));
        transpose_item(w_out + (size_t)L * DM * DM, DM, DM, g, (bf16_t*)(ws + WS_WOUT + L * SZ_WOUT), RmId{DM}, scr, kb, nb, lane); return; } r -= I_OUT;
    if (r < I_G) { const int kb = r / 88, nb = r % 88; transpose_item(w_gate + (size_t)L * DM * DFF, DM, DFF, g_ffn + L * DM + 64 * kb, (bf16_t*)(ws + WS_WGU + L * SZ_WGU), RmGU{0}, scr, kb, nb, lane); return; } r -= I_G;
    if (r < I_G) { const int kb = r / 88, nb = r % 88; transpose_item(w_up + (size_t)L * DM * DFF, DM, DFF, g_ffn + L * DM + 64 * kb, (bf16_t*)(ws + WS_WGU + L * SZ_WGU), RmGU{1}, scr, kb, nb, lane); return; } r -= I_G;
    if (r < I_DN) { const int kb = r / 32, nb = r % 32; transpose_item(w_down + (size_t)L * DFF * DM, DFF, DM, nullptr, (bf16_t*)(ws + WS_WDN + L * SZ_WDN), RmId{DFF}, scr, kb, nb, lane); return; } r -= I_DN;
    if (r < I_W1) { const int kv = r / 128, r2 = r % 128, kb = r2 / 4, nb = r2 % 4;
        transpose_item(cmp_w1 + ((size_t)L * 2 + kv) * 2048 * 128, 2048, 128, nullptr, (bf16_t*)(ws + WS_W1T + L * SZ_W1T) + (size_t)kv * 128 * 2048, RmW1(), scr, kb, nb, lane); return; } r -= I_W1;
    { const int kv = r / 4, r2 = r % 4, kb = r2 / 2, nb = r2 % 2;
        transpose_item(cmp_w2 + ((size_t)L * 2 + kv) * 128 * 64, 128, 64, nullptr, (bf16_t*)(ws + WS_W2T + L * SZ_W2T) + (size_t)kv * 64 * 128, RmId{128}, scr, kb, nb, lane); }
}
__device__ __forceinline__ void prologue(const Params& p, ldsp lds, int tid) {
    const int lane = tid & 63, wave = tid >> 6, gw = blockIdx.x * 8 + wave, NGW = gridDim.x * 8;
    LAS float* scr = (LAS float*)(lds + wave * 16384);
    unsigned char* ws = p.ws;
    const float *cmp_pos = p.in[9], *cmp_w1 = p.in[10];
#ifdef CONV_IN_P0
    for (int it = gw; it < DEPTH * I_LAYER; it += NGW) convert_item(p, it / I_LAYER, it % I_LAYER, scr, lane);
#else
    for (int it = gw; it < I_LAYER; it += NGW) convert_item(p, 0, it, scr, lane);
#endif
    for (int o = gw; o < DEPTH * 256; o += NGW) { const int L = o / 256, kv = (o >> 7) & 1, fo = o & 127;
        const float* pos = cmp_pos + ((size_t)L * 2 + kv) * 2048 + lane; const float* w1 = cmp_w1 + ((size_t)L * 2 + kv) * 2048 * 128 + (size_t)lane * 128 + fo;
        float s = 0.f;
#pragma unroll 8
        for (int j = 0; j < 32; ++j) s += pos[64 * j] * w1[(size_t)64 * j * 128];
        s = wave_sum(s);
        if (lane == 0) ((float*)(ws + WS_B1 + L * SZ_B1))[kv * 128 + fo] = s; }
    { const float* x = p.in[0]; bf16_t* xb = (bf16_t*)(ws + WS_XB); float* ss = (float*)(ws + WS_SS);
      for (int row0 = 2 * gw; row0 < MTOK; row0 += 2 * NGW) { f32x4 v[2][4];
#pragma unroll
          for (int q = 0; q < 2; ++q)
#pragma unroll
              for (int j = 0; j < 2; ++j) { const float* xr = x + (size_t)(row0 + q) * DM + 512 * j + 8 * lane; v[q][2 * j] = *(const f32x4*)xr; v[q][2 * j + 1] = *(const f32x4*)(xr + 4); }
#pragma unroll
          for (int q = 0; q < 2; ++q) { float s = 0.f;
#pragma unroll
              for (int j = 0; j < 2; ++j) { const f32x4 a = v[q][2 * j], b = v[q][2 * j + 1];
                  s += ((a[0] * a[0] + a[1] * a[1]) + (a[2] * a[2] + a[3] * a[3])) + ((b[0] * b[0] + b[1] * b[1]) + (b[2] * b[2] + b[3] * b[3]));
                  u32x4 o; o.x = mx::pk2(a[0], a[1]); o.y = mx::pk2(a[2], a[3]); o.z = mx::pk2(b[0], b[1]); o.w = mx::pk2(b[2], b[3]);
                  *(u32x4*)(xb + (size_t)(row0 + q) * DM + 512 * j + 8 * lane) = o; }
              s = wave_sum(s);
              if (lane < 16) ss[(size_t)(row0 + q) * 16 + lane] = lane == 0 ? s : 0.f; } } }
}
__device__ __forceinline__ void final_norm(const Params& p, int tid) {
    const int lane = tid & 63, wave = tid >> 6, gw = blockIdx.x * 8 + wave, NGW = gridDim.x * 8;
    const float* ss = (const float*)(p.ws + WS_SS); const float* g = p.in[15]; float* out = p.out; const bf16_t* xb = (const bf16_t*)(p.ws + WS_XB);
    f32x4 gv[4];
#pragma unroll
    for (int j = 0; j < 2; ++j) { gv[2 * j] = *(const f32x4*)(g + 512 * j + 8 * lane); gv[2 * j + 1] = *(const f32x4*)(g + 512 * j + 8 * lane + 4); }
    for (int row0 = 2 * gw; row0 < MTOK; row0 += 2 * NGW) {
        float s[2]; u32x4 w[2][2];
#pragma unroll
        for (int q = 0; q < 2; ++q) { const int row = row0 + q; s[q] = lane < 16 ? ss[(size_t)row * 16 + lane] : 0.f;
#pragma unroll
            for (int j = 0; j < 2; ++j) w[q][j] = *(const u32x4*)(xb + (size_t)row * DM + 512 * j + 8 * lane); }
#pragma unroll
        for (int q = 0; q < 2; ++q) { const int row = row0 + q; const float rs = 1.0f / sqrtf(wave_sum(s[q]) * (1.0f / 1024.0f) + 1e-6f);
#pragma unroll
            for (int j = 0; j < 2; ++j) { const u32x4 ww = w[q][j]; float* o = out + (size_t)row * DM + 512 * j + 8 * lane;
                f32x4 a, b; a[0] = __uint_as_float(ww.x << 16); a[1] = __uint_as_float(ww.x & 0xffff0000u); a[2] = __uint_as_float(ww.y << 16); a[3] = __uint_as_float(ww.y & 0xffff0000u);
                b[0] = __uint_as_float(ww.z << 16); b[1] = __uint_as_float(ww.z & 0xffff0000u); b[2] = __uint_as_float(ww.w << 16); b[3] = __uint_as_float(ww.w & 0xffff0000u);
                *(f32x4*)o = a * rs * gv[2 * j]; *(f32x4*)(o + 4) = b * rs * gv[2 * j + 1]; } }
    }
}
__device__ __forceinline__ int opq_s(int v) { asm volatile("" : "+s"(v)); return v; }
__device__ __forceinline__ int q_next(unsigned* ctr, LAS unsigned* slot, int tid) {
    __syncthreads();
    if (tid == 0) *slot = atomicAdd(ctr, 1u);
    __syncthreads();
    return (int)*slot;
}

__global__ void __launch_bounds__(512, 2) mk_fwd(Params p) {
    extern __shared__ __attribute__((aligned(16))) unsigned char lds_raw[];
    ldsp lds = (ldsp)lds_raw;
    cg::grid_group grid = cg::this_grid();
    const int lo = p.ph_lo, hi = p.ph_hi;
#define OPAQUE_TID() int tid = threadIdx.x; asm volatile("" : "+v"(tid))
    unsigned char* ws = p.ws;
    LAS unsigned* slot = (LAS unsigned*)(lds + LDS_CTL);
    bf16_t* XB = (bf16_t*)(ws + WS_XB); bf16_t* PROJ = (bf16_t*)(ws + WS_PROJ); bf16_t* MIXN = (bf16_t*)(ws + WS_MIXN); bf16_t* HID = (bf16_t*)(ws + WS_HID);
    bf16_t* KC = (bf16_t*)(ws + WS_KC); bf16_t* VC = (bf16_t*)(ws + WS_VC); float* SS = (float*)(ws + WS_SS);
    if (threadIdx.x < 8) slot[4 + threadIdx.x] = 0u;
    __syncthreads();
    const XcdBarrier xbar = xcd_barrier_post((unsigned*)(ws + WS_BAR), (volatile LAS unsigned*)(slot + 4));
    int ph = 0;
#ifdef TIMING_PROBE
    unsigned long long tp0 = __builtin_amdgcn_s_memrealtime(), tcat[4] = {0ull, 0ull, 0ull, 0ull};
#define TCAT(c) do { const unsigned long long tn = __builtin_amdgcn_s_memrealtime(); tcat[c] += tn - tp0; tp0 = tn; } while (0)
#else
#define TCAT(c) do {} while (0)
#endif
#ifndef REP_FINAL
#define REP_FINAL 1
#endif
#ifndef REP_RES
#define REP_RES 1
#endif
#ifndef REP_P0
#define REP_P0 1
#endif
#ifndef REP_P2
#define REP_P2 1
#endif
#ifndef REP_P3
#define REP_P3 1
#endif
#ifndef REP_GEMM
#define REP_GEMM 1
#endif
#ifndef REP_SYNC
#define REP_SYNC 1
#endif
#define RUN() (lo <= ph && ph < hi)
#define SEAM(c) do { TCAT(c); if (RUN() && ph + 1 < hi) { for (int rs_ = 0; rs_ < REP_SYNC; ++rs_) { if (lo < 0) grid.sync(); else xcd_barrier(xbar); }     } TCAT(2); ++ph; } while (0)
    #ifndef SKIP_P0
    if (RUN()) for (int rep_ = 0; rep_ < REP_P0; ++rep_) { if (rep_) xcd_barrier(xbar); OPAQUE_TID(); prologue(p, lds, tid); }
#endif
    SEAM(3);
    for (int L_ = 0; L_ < DEPTH; ++L_) {
#ifndef SKIP_G1
        if (RUN()) if (const int L = opq_s(L_); true) for (int rep_ = 0; rep_ < REP_GEMM; ++rep_) { if (rep_) xcd_barrier(xbar); pg8::Gemm g{XB, (const bf16_t*)(ws + WS_WIN + L * SZ_WIN), MTOK, NPROJ, DM}; pg8::StaticOrder S; S.init(MTOK, NPROJ, (int)gridDim.x, (int)blockIdx.x);
            pg8::EpiProj E{PROJ, mx::LDP, SS};
            pg8::gemm_phase<pg8::EpiProj, pg8::StaticOrder, true, true>((PG8_LAS unsigned char*)lds, g, S, E); }
#endif
        SEAM(0);
#ifndef SKIP_P2
        if (RUN()) if (const int L = opq_s(L_); true) for (int rep_ = 0; rep_ < REP_P2; ++rep_) { if (rep_) xcd_barrier(xbar); OPAQUE_TID(); unsigned* ctr = (unsigned*)(ws + WS_CTR) + 64 * (ph + 32 * rep_);
            int u = q_next(ctr, slot, tid);
#ifdef CONV_IN_P0
            const int nq = 32 + 2048;
#else
            const int nq = 32 + 2048 + (L + 1 < DEPTH ? CONV_UNITS : 0);
#endif
            while (u < nq) {
                if (u < 32) {
#ifndef SKIP_CMP
 mx::unitCmp(PROJ, (const bf16_t*)(ws + WS_W1T + L * SZ_W1T), (const bf16_t*)(ws + WS_W2T + L * SZ_W2T), (const float*)(ws + WS_B1 + L * SZ_B1), KC, VC, u, tid);
#endif
 }
                else if (u < 32 + 1024) {
#ifndef SKIP_C
 const int k = u - 32; mx::unitC(lds, PROJ, MIXN, k & 31, 31 - (k >> 5), tid);
#endif
 }
#ifndef CONV_IN_P0
                else if (u >= 32 + 2048) { const int it = (u - 32 - 2048) * 8 + (tid >> 6); if (it < I_LAYER) convert_item(p, L + 1, it, (LAS float*)(lds + (tid >> 6) * 16384), tid & 63); }
#endif
                else {
#ifndef SKIP_A
 const int k = u - 32 - 1024; mx::unitA(lds, PROJ, MIXN, p.in[8] + L * 8, k & 31, 31 - (k >> 5), tid);
#endif
 }
                u = q_next(ctr, slot, tid); } }
#endif
        SEAM(1);
#ifndef SKIP_P3
        if (RUN()) if (const int L = opq_s(L_); true) for (int rep_ = 0; rep_ < REP_P3; ++rep_) { if (rep_) xcd_barrier(xbar); OPAQUE_TID(); unsigned* ctr = (unsigned*)(ws + WS_CTR) + 64 * (ph + 32 * rep_);
            int u = q_next(ctr, slot, tid);
            while (u < 1024) { unsigned nxt_ = 0u; if (tid == 0) nxt_ = atomicAdd(ctr, 1u); mx::unitB(lds, PROJ, KC, VC, MIXN, XB, SS, (const bf16_t*)(ws + WS_WG + L * SZ_WG), u & 31, 31 - (u >> 5), tid);
                __syncthreads(); if (tid == 0) *slot = nxt_; __syncthreads(); u = (int)*slot; } }
#endif
        SEAM(1);
#ifndef SKIP_G4
        if (RUN()) if (const int L = opq_s(L_); true) for (int rep_ = 0; rep_ < REP_RES; ++rep_) { if (rep_) xcd_barrier(xbar); pg8::Gemm g{MIXN, (const bf16_t*)(ws + WS_WOUT + L * SZ_WOUT), MTOK, DM, DM}; pg8::StaticOrder S; S.init(MTOK, DM, (int)gridDim.x, (int)blockIdx.x);
            pg8::EpiRes E{XB, rep_ + 1 < REP_RES ? (float*)(ws + WS_END + 256 * MiB) : SS, rep_ + 1 < REP_RES ? (bf16_t*)(ws + WS_END) : XB};
            pg8::gemm_phase<pg8::EpiRes, pg8::StaticOrder, true, true>((PG8_LAS unsigned char*)lds, g, S, E); }
#endif
        SEAM(0);
#ifndef SKIP_G5
        if (RUN()) if (const int L = opq_s(L_); true) for (int rep_ = 0; rep_ < REP_GEMM; ++rep_) { if (rep_) xcd_barrier(xbar); pg8::Gemm g{XB, (const bf16_t*)(ws + WS_WGU + L * SZ_WGU), MTOK, NGU, DM}; pg8::StaticOrder S; S.init(MTOK, NGU, (int)gridDim.x, (int)blockIdx.x);
            pg8::EpiGU E{HID, DFF, SS};
            pg8::gemm_phase<pg8::EpiGU, pg8::StaticOrder, true, true>((PG8_LAS unsigned char*)lds, g, S, E); }
#endif
        SEAM(0);
#ifndef SKIP_G6
        if (RUN()) if (const int L = opq_s(L_); true) for (int rep_ = 0; rep_ < REP_RES; ++rep_) { if (rep_) xcd_barrier(xbar); pg8::Gemm g{HID, (const bf16_t*)(ws + WS_WDN + L * SZ_WDN), MTOK, DM, DFF}; pg8::StaticOrder S; S.init(MTOK, DM, (int)gridDim.x, (int)blockIdx.x);
            pg8::EpiRes E{XB, rep_ + 1 < REP_RES ? (float*)(ws + WS_END + 256 * MiB) : SS, rep_ + 1 < REP_RES ? (bf16_t*)(ws + WS_END) : XB};
            pg8::gemm_phase<pg8::EpiRes, pg8::StaticOrder, true, true>((PG8_LAS unsigned char*)lds, g, S, E); }
#endif
        SEAM(0);
    }
    if (RUN()) for (int rep_ = 0; rep_ < REP_FINAL; ++rep_) { OPAQUE_TID(); final_norm(p, tid); }
#ifdef TIMING_PROBE
    TCAT(3);
    grid.sync();
    if (blockIdx.x == 0 && threadIdx.x == 0) {
        const float va = (float)(tcat[TIMING_PROBE / 10] / 100ull), vb = (float)(tcat[TIMING_PROBE % 10] / 100ull);
        asm volatile("s_waitcnt vmcnt(0)" ::: "memory");
        p.out[0] = va; for (int i = 0; i < 10000; ++i) p.out[2048 + i] = vb;
    }
#endif
#undef RUN
#undef SEAM
}

#ifndef MK_PER_PHASE
#define MK_PER_PHASE 0
#endif
extern "C" void kernel_launch(void* const* d_in, const int* in_sizes, int n_in, void* d_out, int out_size, void* d_ws, size_t ws_size, hipStream_t stream) {
    static int grid = 0;
    if (grid == 0) {
        if (n_in != 16 || out_size != MTOK * DM || ws_size < WS_END) { fprintf(stderr, "kernel_launch: unexpected shapes (n_in %d, out %d, ws %zu)\n", n_in, out_size, ws_size); grid = -1; return; }
        int dev = 0, cus = 0, per_cu = 0;
        hipGetDevice(&dev); hipDeviceGetAttribute(&cus, hipDeviceAttributeMultiprocessorCount, dev);
        if (hipFuncSetAttribute((const void*)mk_fwd, hipFuncAttributeMaxDynamicSharedMemorySize, LDS_BYTES) != hipSuccess) { fprintf(stderr, "kernel_launch: hipFuncSetAttribute failed\n"); grid = -1; return; }
        if (hipOccupancyMaxActiveBlocksPerMultiprocessor(&per_cu, (const void*)mk_fwd, 512, LDS_BYTES) != hipSuccess || per_cu < 1) { fprintf(stderr, "kernel_launch: occupancy query says %d\n", per_cu); per_cu = 1; }
        (void)hipGetLastError();
        grid = cus;
    }
    if (grid < 0) return;
    if (hipMemsetAsync(d_ws, 0, WS_ZERO_BYTES, stream) != hipSuccess) { fprintf(stderr, "kernel_launch: memset failed\n"); return; }
    Params p{};
    for (int i = 0; i < 16; ++i) p.in[i] = (const float*)d_in[i];
    p.out = (float*)d_out; p.ws = (unsigned char*)d_ws;
#if MK_PER_PHASE
    for (int ph = 0; ph < NPHASE; ++ph) { p.ph_lo = ph; p.ph_hi = ph + 1; hipLaunchKernelGGL(mk_fwd, dim3(grid), dim3(512), LDS_BYTES, stream, p); }
#else
    p.ph_lo = 0; p.ph_hi = NPHASE;
    void* args[] = {&p};
    hipError_t e = hipLaunchCooperativeKernel((const void*)mk_fwd, dim3(grid), dim3(512), args, LDS_BYTES, stream);
    if (e != hipSuccess) fprintf(stderr, "kernel_launch: cooperative launch failed: %s (grid %d)\n", hipGetErrorString(e), grid);
#endif
}
```
